# Optimizing an MI355X kernel written in HIP

```python
import jax, jax.numpy as jnp
from jax import lax
import numpy as np

D_MODEL = 1024
BATCH = 4
SEQ = 8192
DEPTH = 1

MIX_WIDTH = D_MODEL
POOL_WIDTH = MIX_WIDTH // 2
SGU_WIDTH = MIX_WIDTH - POOL_WIDTH
POOL_WINDOWS = (2, 4, 8, 16)
POOL_GROUPS = len(POOL_WINDOWS)
POOL_GROUP_DIM = POOL_WIDTH // POOL_GROUPS
SGU_CHUNK = 128
SGU_HEADS = 4
SGU_HEAD_DIM = SGU_WIDTH // SGU_HEADS
IN_PROJ_WIDTH = POOL_WIDTH + 2 * SGU_WIDTH
PEER_HEADS = 8
PEER_N_KEYS = 128
PEER_N_EXPERTS = PEER_N_KEYS * PEER_N_KEYS
PEER_D_KEY = 256
PEER_HALF = PEER_D_KEY // 2
PEER_TOPK = 16
PEER_TOKEN_BLOCK = 128
N_MOD = 6
EPS = 1e-6

kernel_name = "hybrid_pool_sgu_peer_adaln"


def rms_norm(x, g):
    xf = x.astype(jnp.float32)
    y = xf * lax.rsqrt(jnp.mean(xf * xf, axis=-1, keepdims=True) + EPS)
    return (y * g.astype(jnp.float32)).astype(x.dtype)


def layer_norm(x, g, b):
    xf = x.astype(jnp.float32)
    mu = jnp.mean(xf, axis=-1, keepdims=True)
    xc = xf - mu
    y = xc * lax.rsqrt(jnp.mean(xc * xc, axis=-1, keepdims=True) + EPS)
    return (y * g.astype(jnp.float32) + b.astype(jnp.float32)).astype(x.dtype)


def modulate(h, shift, scale):
    return h * (1 + scale) + shift


def pool_mixer(a, w_pool, pool_scale):
    B, S, _ = a.shape
    af = a.astype(jnp.float32).reshape(B, S, POOL_GROUPS, POOL_GROUP_DIM)
    cs = jnp.cumsum(af, axis=1)
    pos = jnp.arange(1, S + 1, dtype=jnp.float32)
    outs = []
    for g, w in enumerate(POOL_WINDOWS):
        c_g = cs[:, :, g]
        prev = jnp.pad(c_g, ((0, 0), (w, 0), (0, 0)))[:, :S]
        mean = (c_g - prev) / jnp.minimum(pos, float(w))[None, :, None]
        outs.append(mean - af[:, :, g])
    pooled = jnp.stack(outs, axis=2)
    y = jnp.einsum('bsgc,gcd->bsgd', pooled, w_pool.astype(jnp.float32))
    y = y.reshape(B, S, POOL_WIDTH) * pool_scale.astype(jnp.float32)
    return y.astype(a.dtype)


def spatial_gating(u, v, ln_g, ln_b, w_spatial, b_spatial):
    B, S, _ = u.shape
    n = S // SGU_CHUNK
    vn = layer_norm(v, ln_g, ln_b).astype(jnp.float32)
    vn = vn.reshape(B, n, SGU_CHUNK, SGU_HEADS, SGU_HEAD_DIM)
    mask = jnp.tril(jnp.ones((SGU_CHUNK, SGU_CHUNK), dtype=bool))
    w = jnp.where(mask[None], w_spatial.astype(jnp.float32), 0.0)
    mixed = jnp.einsum('hts,bnshc->bnthc', w, vn)
    mixed = mixed + b_spatial.astype(jnp.float32).T[None, None, :, :, None]
    uf = u.astype(jnp.float32).reshape(B, n, SGU_CHUNK, SGU_HEADS, SGU_HEAD_DIM)
    return (uf * mixed).reshape(B, S, SGU_WIDTH).astype(u.dtype)


def peer_ffn(h, w_query, sub_keys, expert_down, expert_up):
    B, S, D = h.shape
    tokens = h.reshape(-1, PEER_TOKEN_BLOCK, D)

    def block(xb):
        T = xb.shape[0]
        q = (xb @ w_query).astype(jnp.float32).reshape(T, PEER_HEADS, 2, PEER_HALF)
        scores = jnp.einsum('thpd,hpkd->thpk', q, sub_keys.astype(jnp.float32))
        s_top, i_top = lax.top_k(scores, PEER_TOPK)
        cand = s_top[:, :, 0, :, None] + s_top[:, :, 1, None, :]
        cand_idx = i_top[:, :, 0, :, None] * PEER_N_KEYS + i_top[:, :, 1, None, :]
        cand = cand.reshape(T, PEER_HEADS, PEER_TOPK * PEER_TOPK)
        cand_idx = cand_idx.reshape(T, PEER_HEADS, PEER_TOPK * PEER_TOPK)
        best, sel = lax.top_k(cand, PEER_TOPK)
        idx = jnp.take_along_axis(cand_idx, sel, axis=-1)
        gate = jax.nn.softmax(best, axis=-1)
        u_e = expert_down[idx]
        v_e = expert_up[idx]
        act = jax.nn.gelu(jnp.einsum('thkd,td->thk', u_e, xb).astype(jnp.float32), approximate=False)
        return jnp.einsum('thk,thkd->td', (gate * act).astype(xb.dtype), v_e)

    return lax.map(block, tokens).reshape(B, S, D)


def setup_inputs(seed: int = 0) -> dict:
    key = jax.random.key(seed)
    ks = jax.random.split(key, 20)
    f = jnp.float32
    D = D_MODEL
    L = DEPTH
    nrm = lambda k, shape, s: jax.random.normal(k, shape, f) * s
    return {
        "x": nrm(ks[0], (BATCH, SEQ, D), 1.0),
        "c": nrm(ks[1], (BATCH, D), 1.0),
        "w_ada": nrm(ks[2], (L, D, N_MOD * D), 0.5 * D ** -0.5),
        "b_ada": nrm(ks[3], (L, N_MOD * D), 0.02),
        "g_norm1": 1.0 + nrm(ks[4], (L, D), 0.05),
        "w_in": nrm(ks[5], (L, D, IN_PROJ_WIDTH), D ** -0.5),
        "w_pool": nrm(ks[6], (L, POOL_GROUPS, POOL_GROUP_DIM, POOL_GROUP_DIM), POOL_GROUP_DIM ** -0.5),
        "pool_scale": 1.0 + nrm(ks[7], (L, POOL_WIDTH), 0.1),
        "sgu_ln_g": 1.0 + nrm(ks[8], (L, SGU_WIDTH), 0.05),
        "sgu_ln_b": nrm(ks[9], (L, SGU_WIDTH), 0.02),
        "w_spatial": nrm(ks[10], (L, SGU_HEADS, SGU_CHUNK, SGU_CHUNK), SGU_CHUNK ** -0.5),
        "b_spatial": 1.0 + nrm(ks[11], (L, SGU_HEADS, SGU_CHUNK), 0.05),
        "w_out": nrm(ks[12], (L, MIX_WIDTH, D), MIX_WIDTH ** -0.5),
        "g_norm2": 1.0 + nrm(ks[13], (L, D), 0.05),
        "w_query": nrm(ks[14], (L, D, PEER_HEADS * PEER_D_KEY), D ** -0.5),
        "sub_keys": nrm(ks[15], (L, PEER_HEADS, 2, PEER_N_KEYS, PEER_HALF), PEER_HALF ** -0.5),
        "expert_down": nrm(ks[16], (L, PEER_N_EXPERTS, D), D ** -0.5),
        "expert_up": nrm(ks[17], (L, PEER_N_EXPERTS, D), PEER_HEADS ** -0.5),
        "g_final": 1.0 + nrm(ks[18], (D,), 0.05),
    }


def reference(x, c, w_ada, b_ada, g_norm1, w_in, w_pool, pool_scale, sgu_ln_g, sgu_ln_b, w_spatial, b_spatial, w_out, g_norm2, w_query, sub_keys, expert_down, expert_up, g_final):
    c_act = jax.nn.silu(c)
    for l in range(DEPTH):
        mod = jnp.einsum('bd,de->be', c_act, w_ada[l]) + b_ada[l]
        shift1, scale1, gate1, shift2, scale2, gate2 = jnp.split(mod[:, None, :], N_MOD, axis=-1)
        h = modulate(rms_norm(x, g_norm1[l]), shift1, scale1)
        proj = h @ w_in[l]
        a = proj[..., :POOL_WIDTH]
        u = proj[..., POOL_WIDTH:POOL_WIDTH + SGU_WIDTH]
        v = proj[..., POOL_WIDTH + SGU_WIDTH:]
        mixed = jnp.concatenate([
            pool_mixer(a, w_pool[l], pool_scale[l]),
            spatial_gating(u, v, sgu_ln_g[l], sgu_ln_b[l], w_spatial[l], b_spatial[l]),
        ], axis=-1)
        x = x + gate1 * (mixed @ w_out[l])
        h = modulate(rms_norm(x, g_norm2[l]), shift2, scale2)
        x = x + gate2 * peer_ffn(h, w_query[l], sub_keys[l], expert_down[l], expert_up[l])
    return rms_norm(x, g_final)
```

```cpp
#include <hip/hip_runtime.h>
#include <cstdio>
#include <cstdint>

#ifndef MK_N_LAUNCHES
#define MK_N_LAUNCHES 8
#endif

#define LAS __attribute__((address_space(3)))
#define GAS __attribute__((address_space(1)))
typedef unsigned short f16_t;
typedef _Float16 f16x8 __attribute__((ext_vector_type(8)));
typedef _Float16 f16x4 __attribute__((ext_vector_type(4)));
typedef _Float16 f16x2 __attribute__((ext_vector_type(2)));
typedef float f32x4 __attribute__((ext_vector_type(4)));
typedef unsigned u32x4 __attribute__((ext_vector_type(4)));
typedef unsigned u32x2 __attribute__((ext_vector_type(2)));

__device__ __forceinline__ f16x2 as_h2(unsigned u) { return __builtin_bit_cast(f16x2, u); }
__device__ __forceinline__ float as_f(unsigned u) { return __builtin_bit_cast(float, u); }
__device__ __forceinline__ unsigned as_u(float f) { return __builtin_bit_cast(unsigned, f); }
__device__ __forceinline__ unsigned pk_f16(float lo, float hi) { f16x2 v = {(_Float16)lo, (_Float16)hi}; return __builtin_bit_cast(unsigned, v); }

namespace pg8 {
constexpr int BM = 256, BK = 64, HALF = 128, HTB = HALF * BK * 2, STAGE_BYTES = 8 * HTB, NXCD = 8, WGM = 8;
__host__ __device__ __forceinline__ int lds_byte(int r, int c) { const int st = (r >> 4) * 2 + (c >> 5), rr = r & 15, cc = c & 31, ob = rr * 64 + cc * 2; return st * 1024 + (ob ^ (((ob >> 9) & 1) << 5)); }
__host__ __device__ __forceinline__ void stage_rc(int b, int& R, int& C) { const int st = b / 1024, sb = b % 1024, swz = sb ^ (((sb >> 9) & 1) << 5); R = (st >> 1) * 16 + swz / 64; C = (st & 1) * 32 + (swz % 64) / 2; }
__host__ __device__ __forceinline__ int perm32(int rho) { const int n = rho >> 4, i = rho & 15; return 8 * (i >> 2) + 4 * n + (i & 3); }
struct Unit { int pm, pn; };
struct Gemm { const f16_t* A; const f16_t* Bt; int M, N, K; };
struct StaticOrder {
    int nM, nN, nwg, G, c;
    __host__ __device__ void init(int M, int N, int G_, int c_) { nM = M / BM; nN = N / BM; nwg = nM * nN; G = G_; c = c_; }
    __host__ __device__ bool next(int i, Unit& u) const {
        const long L = (long)i * G + c; if (L >= nwg) return false;
        int wgid = (int)L; { const int q = nwg / NXCD, r = nwg % NXCD, xcd = wgid % NXCD, off = wgid / NXCD; wgid = (xcd < r ? xcd * (q + 1) : r * (q + 1) + (xcd - r) * q) + off; }
        const int nig = WGM * nN, gid = wgid / nig, fm = gid * WGM, gsz = (nM - fm) < WGM ? (nM - fm) : WGM;
        u.pm = fm + ((wgid % nig) % gsz); u.pn = (wgid % nig) / gsz; return true;
    }
    __device__ __forceinline__ void a_ready(const Unit&) const {}
    __device__ __forceinline__ void done(const Unit&) const {}
};
struct EpiF16 {
    static constexpr bool PERM = true, AFTER_DRAIN = false;
    f16_t* O; int ldc;
    __device__ __forceinline__ void operator()(const f32x4 (&acc)[2][2][4][2], const Unit& u, int wr, int wc, int fr, int fq) const {
        const int row0 = u.pm * BM + wr * 64 + fr, col0 = u.pn * BM + wc * 32 + 8 * fq;
#pragma unroll
        for (int ai = 0; ai < 2; ++ai)
#pragma unroll
            for (int m = 0; m < 4; ++m) { f16_t* rowp = O + (size_t)(row0 + ai * HALF + m * 16) * ldc + col0;
#pragma unroll
                for (int bj = 0; bj < 2; ++bj) { const f32x4 v0 = acc[ai][bj][m][0], v1 = acc[ai][bj][m][1];
                    u32x4 w; w.x = pk_f16(v0[0], v0[1]); w.y = pk_f16(v0[2], v0[3]); w.z = pk_f16(v1[0], v1[1]); w.w = pk_f16(v1[2], v1[3]);
                    *(u32x4*)(rowp + bj * HALF) = w; } }
    }
};
struct EpiF32 {
    static constexpr bool PERM = false, AFTER_DRAIN = false;
    float* C; int ldc;
    __device__ __forceinline__ void operator()(const f32x4 (&acc)[2][2][4][2], const Unit& u, int wr, int wc, int fr, int fq) const {
        const int row0 = u.pm * BM + wr * 64 + fr, col0 = u.pn * BM + wc * 32 + 4 * fq;
#pragma unroll
        for (int ai = 0; ai < 2; ++ai)
#pragma unroll
            for (int m = 0; m < 4; ++m) { float* rowp = C + (size_t)(row0 + ai * HALF + m * 16) * ldc + col0;
#pragma unroll
                for (int bj = 0; bj < 2; ++bj)
#pragma unroll
                    for (int n = 0; n < 2; ++n) *(f32x4*)(rowp + bj * HALF + n * 16) = acc[ai][bj][m][n]; }
    }
};
struct EpiRes {
    static constexpr bool PERM = false, AFTER_DRAIN = false;
    const float* X; float* O; const float* gate; int ldc;
    __device__ __forceinline__ void operator()(const f32x4 (&acc)[2][2][4][2], const Unit& u, int wr, int wc, int fr, int fq) const {
        const int row0 = u.pm * BM + wr * 64 + fr, col0 = u.pn * BM + wc * 32 + 4 * fq;
        const float* g = gate + (size_t)((u.pm * BM) >> 13) * 6144;
        f32x4 gv[2][2];
#pragma unroll
        for (int bj = 0; bj < 2; ++bj)
#pragma unroll
            for (int n = 0; n < 2; ++n) gv[bj][n] = *(const f32x4*)(g + col0 + bj * HALF + n * 16);
#pragma unroll
        for (int ai = 0; ai < 2; ++ai)
#pragma unroll
            for (int m = 0; m < 4; ++m) { const size_t off = (size_t)(row0 + ai * HALF + m * 16) * ldc + col0;
#pragma unroll
                for (int bj = 0; bj < 2; ++bj)
#pragma unroll
                    for (int n = 0; n < 2; ++n) { const f32x4 xv = *(const f32x4*)(X + off + bj * HALF + n * 16); *(f32x4*)(O + off + bj * HALF + n * 16) = xv + gv[bj][n] * acc[ai][bj][m][n]; }
                if (m & 1) asm volatile("" ::: "memory"); }
    }
};

template <class Epi, class Sched, bool ALIGN_EPI = false, bool SP2 = false>
__device__ __forceinline__ void gemm_phase(LAS unsigned char* lds, const Gemm g, const Sched& S, const Epi& E) {
    const int tid = threadIdx.x, wid = __builtin_amdgcn_readfirstlane(tid >> 6), lane = tid & 63, wr = wid >> 2, wc = wid & 3, fr = lane & 15, fq = lane >> 4;
    const int K = g.K, nt = K / BK;
    unsigned voffA[2], voffB[2];
#pragma unroll
    for (int i = 0; i < 2; ++i) { int R, C; stage_rc(tid * 16 + i * 8192, R, C); const int Rb = Epi::PERM ? ((R & ~31) + perm32(R & 31)) : R;
        voffA[i] = (unsigned)(R * K + C) * 2u; voffB[i] = (unsigned)(Rb * K + C) * 2u; }
    const size_t kstep = (size_t)(BK * 2);
    const size_t hstep = (size_t)HALF * K * 2;
    const size_t tstep = 2 * hstep;
    const unsigned ldsw = (unsigned)wid * 1024u;
    const int aoff = lds_byte(wr * 64 + fr, fq * 8), boff = lds_byte(wc * 32 + fr, fq * 8);
#define PG8_SA(b, h) (((b) * 2 + (h)) * HTB)
#define PG8_SB(b, h) ((4 + (b) * 2 + (h)) * HTB)
#define PG8_STAGE(bufoff, gbase, voff) do { _Pragma("unroll") for (int _i = 0; _i < 2; ++_i) \
        __builtin_amdgcn_global_load_lds((const unsigned*)((const char*)(gbase) + (voff)[_i]), (LAS unsigned*)(lds + (bufoff) + ldsw + _i * 8192), 16, 0, 0); } while (0)
#define PG8_LDA(dst, b, h) do { _Pragma("unroll") for (int m = 0; m < 4; ++m) _Pragma("unroll") for (int k = 0; k < 2; ++k) dst[m][k] = *(const LAS f16x8*)(lds + PG8_SA(b, h) + aoff + m * 2048 + k * 1024); } while (0)
#define PG8_LDB(dst, b, h) do { _Pragma("unroll") for (int n = 0; n < 2; ++n) _Pragma("unroll") for (int k = 0; k < 2; ++k) dst[n][k] = *(const LAS f16x8*)(lds + PG8_SB(b, h) + boff + n * 2048 + k * 1024); } while (0)
#define PG8_MMA(ai, bj, At, Bt) do { __builtin_amdgcn_s_setprio(1); _Pragma("unroll") for (int m = 0; m < 4; ++m) _Pragma("unroll") for (int n = 0; n < 2; ++n) _Pragma("unroll") for (int k = 0; k < 2; ++k) \
        acc[ai][bj][m][n] = __builtin_amdgcn_mfma_f32_16x16x32_f16(Bt[n][k], At[m][k], acc[ai][bj][m][n], 0, 0, 0); __builtin_amdgcn_s_setprio(0); } while (0)
#define PG8_WAIT_V(n) asm volatile("s_waitcnt vmcnt(" #n ")" ::: "memory")
#define PG8_WAIT_L(n) asm volatile("s_waitcnt lgkmcnt(" #n ")" ::: "memory")
#define PG8_BAR __builtin_amdgcn_s_barrier()
#define PG8_SCHED __builtin_amdgcn_sched_barrier(0)
    Unit cur, nxt; int ui = 0;
    if (!S.next(0, cur)) return;
    f32x4 acc[2][2][4][2];
#pragma unroll
    for (int a = 0; a < 2; ++a)
#pragma unroll
        for (int b = 0; b < 2; ++b)
#pragma unroll
            for (int m = 0; m < 4; ++m)
#pragma unroll
                for (int n = 0; n < 2; ++n) acc[a][b][m][n] = (f32x4){0.f, 0.f, 0.f, 0.f};
    f16x8 At[4][2], B0[2][2], B1[2][2];
    const char* cA = (const char*)g.A + (size_t)cur.pm * tstep; const char* cB = (const char*)g.Bt + (size_t)cur.pn * tstep;
    S.a_ready(cur);
    if constexpr (SP2) {
        PG8_STAGE(PG8_SB(0, 0), cB, voffB); PG8_STAGE(PG8_SB(0, 1), cB + hstep, voffB); PG8_STAGE(PG8_SA(0, 0), cA, voffA); PG8_STAGE(PG8_SA(0, 1), cA + hstep, voffA);
        if (wr == 1) PG8_BAR;
        PG8_WAIT_V(2); PG8_BAR;
        PG8_STAGE(PG8_SB(1, 0), cB + kstep, voffB); PG8_STAGE(PG8_SA(1, 0), cA + kstep, voffA); PG8_STAGE(PG8_SB(1, 1), cB + hstep + kstep, voffB);
        PG8_WAIT_V(6); PG8_BAR;
    } else {
        PG8_STAGE(PG8_SB(0, 0), cB, voffB); PG8_STAGE(PG8_SA(0, 0), cA, voffA); PG8_STAGE(PG8_SB(0, 1), cB + hstep, voffB); PG8_STAGE(PG8_SA(0, 1), cA + hstep, voffA);
        if (wr == 1) PG8_BAR;
        PG8_WAIT_V(4); PG8_BAR;
        PG8_STAGE(PG8_SB(1, 0), cB + kstep, voffB); PG8_STAGE(PG8_SA(1, 0), cA + kstep, voffA); PG8_STAGE(PG8_SB(1, 1), cB + hstep + kstep, voffB);
        PG8_WAIT_V(6); PG8_BAR;
    }
    for (;;) {
        const bool has_next = S.next(ui + 1, nxt);
        const char* nA = has_next ? (const char*)g.A + (size_t)nxt.pm * tstep : cA; const char* nB = has_next ? (const char*)g.Bt + (size_t)nxt.pn * tstep : cB;
        for (int t = 0; t < nt; t += 2) {
            const bool last = (t == nt - 2);
            const char* a1 = cA + (size_t)(t + 1) * kstep;
            const char* a2 = last ? nA : cA + (size_t)(t + 2) * kstep; const char* b2 = last ? nB : cB + (size_t)(t + 2) * kstep;
            const char* a3 = a2 + kstep; const char* b3 = b2 + kstep;
            if (last && has_next) S.a_ready(nxt);
            if constexpr (SP2) {
            PG8_LDB(B0, 0, 0); PG8_LDB(B1, 0, 1); PG8_SCHED; PG8_LDA(At, 0, 0); PG8_STAGE(PG8_SA(1, 1), a1 + hstep, voffA);
            PG8_WAIT_V(8); PG8_WAIT_L(0); PG8_BAR; PG8_MMA(0, 0, At, B0); PG8_MMA(0, 1, At, B1); PG8_BAR; PG8_SCHED;
            PG8_LDA(At, 0, 1); PG8_STAGE(PG8_SB(0, 0), b2, voffB); PG8_STAGE(PG8_SB(0, 1), b2 + hstep, voffB); PG8_STAGE(PG8_SA(0, 0), a2, voffA);
            PG8_WAIT_V(8); PG8_WAIT_L(0); PG8_BAR; PG8_MMA(1, 0, At, B0); PG8_MMA(1, 1, At, B1); PG8_BAR; PG8_SCHED;
            PG8_LDB(B0, 1, 0); PG8_LDB(B1, 1, 1); PG8_SCHED; PG8_LDA(At, 1, 0); PG8_STAGE(PG8_SA(0, 1), a2 + hstep, voffA);
            PG8_WAIT_V(8); PG8_WAIT_L(0); PG8_BAR; PG8_MMA(0, 0, At, B0); PG8_MMA(0, 1, At, B1); PG8_BAR; PG8_SCHED;
            PG8_LDA(At, 1, 1); PG8_STAGE(PG8_SB(1, 0), b3, voffB); PG8_STAGE(PG8_SB(1, 1), b3 + hstep, voffB); PG8_STAGE(PG8_SA(1, 0), a3, voffA);
            PG8_WAIT_V(8); PG8_WAIT_L(0); PG8_BAR; PG8_MMA(1, 0, At, B0); PG8_MMA(1, 1, At, B1); PG8_BAR; PG8_SCHED;
            } else {
            PG8_LDB(B0, 0, 0); PG8_SCHED; PG8_LDA(At, 0, 0); PG8_STAGE(PG8_SA(1, 1), a1 + hstep, voffA);
            PG8_WAIT_L(8); PG8_BAR; PG8_WAIT_L(0); PG8_MMA(0, 0, At, B0); PG8_BAR; PG8_SCHED;
            PG8_LDB(B1, 0, 1); PG8_STAGE(PG8_SB(0, 0), b2, voffB);
            PG8_BAR; PG8_WAIT_L(0); PG8_MMA(0, 1, At, B1); PG8_BAR;
            PG8_LDA(At, 0, 1); PG8_STAGE(PG8_SA(0, 0), a2, voffA);
            PG8_BAR; PG8_WAIT_L(0); PG8_MMA(1, 0, At, B0); PG8_BAR; PG8_SCHED;
            PG8_STAGE(PG8_SB(0, 1), b2 + hstep, voffB);
            PG8_WAIT_V(6); PG8_BAR; PG8_MMA(1, 1, At, B1); PG8_BAR;
            PG8_LDB(B0, 1, 0); PG8_SCHED; PG8_LDA(At, 1, 0); PG8_STAGE(PG8_SA(0, 1), a2 + hstep, voffA);
            PG8_WAIT_L(8); PG8_BAR; PG8_WAIT_L(0); PG8_MMA(0, 0, At, B0); PG8_BAR; PG8_SCHED;
            PG8_LDB(B1, 1, 1); PG8_STAGE(PG8_SB(1, 0), b3, voffB);
            PG8_BAR; PG8_WAIT_L(0); PG8_MMA(0, 1, At, B1); PG8_BAR;
            PG8_LDA(At, 1, 1); PG8_STAGE(PG8_SA(1, 0), a3, voffA);
            PG8_BAR; PG8_WAIT_L(0); PG8_MMA(1, 0, At, B0); PG8_BAR; PG8_SCHED;
            PG8_STAGE(PG8_SB(1, 1), b3 + hstep, voffB);
            PG8_WAIT_V(6); PG8_BAR; PG8_MMA(1, 1, At, B1); PG8_BAR;
            }
        }
        if constexpr (ALIGN_EPI) { if (wr == 0) PG8_BAR; }
        if constexpr (!Epi::AFTER_DRAIN) { E(acc, cur, wr, wc, fr, fq); S.done(cur); }
        if (!has_next) break;
#pragma unroll
        for (int a = 0; a < 2; ++a)
#pragma unroll
            for (int b = 0; b < 2; ++b)
#pragma unroll
                for (int m = 0; m < 4; ++m)
#pragma unroll
                    for (int n = 0; n < 2; ++n) acc[a][b][m][n] = (f32x4){0.f, 0.f, 0.f, 0.f};
        cur = nxt; cA = nA; cB = nB; ++ui;
        if constexpr (ALIGN_EPI) { if (wr == 1) PG8_BAR; }
    }
    PG8_WAIT_V(0);
    if constexpr (!ALIGN_EPI) { if (wr == 0) PG8_BAR; }
    PG8_BAR;
#undef PG8_SA
#undef PG8_SB
#undef PG8_STAGE
#undef PG8_LDA
#undef PG8_LDB
#undef PG8_MMA
#undef PG8_WAIT_V
#undef PG8_WAIT_L
#undef PG8_BAR
#undef PG8_SCHED
}
}

constexpr int NWAVES = 8, NTHR = NWAVES * 64;
constexpr int N_LAUNCHES = MK_N_LAUNCHES, N_PHASES = 8;
constexpr int BATCH = 4, SEQ = 8192, DM = 1024, M = BATCH * SEQ;
constexpr int NPROJ = 1536, NQK = 2048, NEXP = 16384, NMOD = 6 * DM;
constexpr float EPS = 1e-6f;

constexpr size_t MiB = 1u << 20;
constexpr size_t WS_CTL = 0, CTL_ZERO_BYTES = 64 * 1024;
constexpr size_t WS_MOD = 256 * 1024;
constexpr size_t WS_MODP = 1 * MiB;
constexpr size_t WS_WIN = 2 * MiB;
constexpr size_t WS_WOUT = 5 * MiB;
constexpr size_t WS_WQK = 7 * MiB;
constexpr size_t WS_WPOOL = 11 * MiB;
constexpr size_t WS_WSP = 11 * MiB + 256 * 1024;
constexpr size_t WS_ED = 16 * MiB, WS_EU = 48 * MiB;
constexpr size_t WS_H2 = 80 * MiB;
constexpr size_t WS_SC = 144 * MiB;
constexpr size_t WS_H1 = 144 * MiB, WS_PROJ = 208 * MiB, WS_MIX = 304 * MiB;
constexpr size_t WS_END = 400 * MiB;
constexpr int CW_BAR = 1024;

constexpr int RING_BYTES = 131072;
constexpr int MISC_OFF = 160 * 1024 - 256;
constexpr int LDS_BYTES = 160 * 1024;

#define RLX_AGENT __ATOMIC_RELAXED, __HIP_MEMORY_SCOPE_AGENT
#define LDS_WAIT() asm volatile("s_waitcnt lgkmcnt(0)" ::: "memory")
#define VM_WAIT() asm volatile("s_waitcnt vmcnt(0)" ::: "memory")

#define XB_TMO      128
#define XB_XCNT(j)  (256  + 64 * (j))
#define XB_XSUB(j)  (1280 + 64 * (j))
#define XB_XGEN(j)  (2304 + 64 * (j))
#define XB_TOP      3328
#define XB_TOPGEN   3392
#define XCD_BAR_WORDS 3456
#define XB_SPIN_CAP (1u << 22)
__device__ __forceinline__ unsigned xb_ld(unsigned* p)              { return __hip_atomic_load(p, __ATOMIC_RELAXED, __HIP_MEMORY_SCOPE_AGENT); }
__device__ __forceinline__ unsigned xb_add(unsigned* p, unsigned v) { return __hip_atomic_fetch_add(p, v, __ATOMIC_RELAXED, __HIP_MEMORY_SCOPE_AGENT); }
__device__ __forceinline__ unsigned xb_xcc_id() { return (unsigned)__builtin_amdgcn_s_getreg((3 << 11) | 20) & 0xFu; }
#define XB_SPIN(cond, bar) do { unsigned _sp = 0; while (cond) { __builtin_amdgcn_s_sleep(1); \
    if ((++_sp & 255u) == 0u) { if (xb_ld(&(bar)[XB_TMO])) break; if (_sp > XB_SPIN_CAP) { atomicAdd(&(bar)[XB_TMO], 1u); break; } } } } while (0)
struct XcdBarrier { unsigned* bar; unsigned x; volatile LAS unsigned* st; };
__device__ __forceinline__ XcdBarrier xcd_barrier_post(unsigned* bar, volatile LAS unsigned* st) {
    XcdBarrier b; b.bar = bar; b.x = xb_xcc_id(); b.st = st;
    if (threadIdx.x == 0) (void)xb_add(&bar[XB_XCNT(b.x)], 1u);
    return b;
}
__device__ __forceinline__ void xcd_barrier_complete(unsigned* bar, unsigned x, unsigned& nloc, unsigned& nx) {
    const unsigned G = gridDim.x * gridDim.y * gridDim.z;
    unsigned sum, cnt, mine, sp = 0u;
    for (;;) {
        sum = 0u; cnt = 0u; mine = 0u;
#pragma unroll
        for (unsigned j = 0; j < 16; ++j) { const unsigned c = xb_ld(&bar[XB_XCNT(j)]); sum += c; cnt += (c > 0u) ? 1u : 0u; mine = (j == x) ? c : mine; }
        if (sum == G) break;
        __builtin_amdgcn_s_sleep(1);
        if ((++sp & 255u) == 0u) { if (xb_ld(&bar[XB_TMO])) break; if (sp > XB_SPIN_CAP) { atomicAdd(&bar[XB_TMO], 1u); break; } }
    }
    nloc = mine > 0u ? mine : 1u; nx = cnt > 0u ? cnt : 1u;
}
__device__ __forceinline__ void xcd_barrier(const XcdBarrier& b) {
    asm volatile("s_waitcnt vmcnt(0)" ::: "memory");
    __syncthreads();
    if (threadIdx.x == 0) {
        unsigned* bar = b.bar;
        __builtin_amdgcn_s_waitcnt(0);
        unsigned nloc = b.st[0], nx = b.st[1];
        if (nloc == 0u) { xcd_barrier_complete(bar, b.x, nloc, nx); b.st[0] = nloc; b.st[1] = nx; }
        const unsigned old = xb_add(&bar[XB_XSUB(b.x)], 1u);
        const unsigned gen = old / nloc;
        if (old + 1u == (gen + 1u) * nloc) {
            __builtin_amdgcn_fence(__ATOMIC_RELEASE, "agent");
            asm volatile("s_waitcnt vmcnt(0)" ::: "memory");
            const unsigned og = xb_add(&bar[XB_TOP], 1u);
            const unsigned tg = og / nx;
            if (og + 1u == (tg + 1u) * nx) xb_add(&bar[XB_TOPGEN], 1u);
            else XB_SPIN(xb_ld(&bar[XB_TOPGEN]) == tg, bar);
            __builtin_amdgcn_fence(__ATOMIC_ACQUIRE, "agent");
            xb_add(&bar[XB_XGEN(b.x)], 1u);
            asm volatile("s_waitcnt vmcnt(0)" ::: "memory");
        } else {
            XB_SPIN(xb_ld(&bar[XB_XGEN(b.x)]) == gen, bar);
            __builtin_amdgcn_fence(__ATOMIC_ACQUIRE, "agent");
            asm volatile("s_waitcnt vmcnt(0)" ::: "memory");
        }
    }
    __syncthreads();
}

__device__ __forceinline__ float wave_sum(float v) {
#pragma unroll
    for (int o = 1; o < 64; o <<= 1) v += __shfl_xor(v, o);
    return v;
}
template <int CTRL> __device__ __forceinline__ unsigned dppu(unsigned x) { return (unsigned)__builtin_amdgcn_update_dpp((int)x, (int)x, CTRL, 0xF, 0xF, false); }
template <int CTRL> __device__ __forceinline__ float dppf(float x) { return __builtin_bit_cast(float, __builtin_amdgcn_update_dpp(__builtin_bit_cast(int, x), __builtin_bit_cast(int, x), CTRL, 0xF, 0xF, false)); }
__device__ __forceinline__ unsigned umax_(unsigned a, unsigned b) { return a > b ? a : b; }
__device__ __forceinline__ unsigned umin_(unsigned a, unsigned b) { return a < b ? a : b; }
__device__ __forceinline__ unsigned rowmax16u(unsigned x) {
    x = umax_(x, dppu<0xB1>(x)); x = umax_(x, dppu<0x4E>(x)); x = umax_(x, dppu<0x141>(x)); x = umax_(x, dppu<0x140>(x)); return x; }
__device__ __forceinline__ float rowmax16f(float x) {
    x = fmaxf(x, dppf<0xB1>(x)); x = fmaxf(x, dppf<0x4E>(x)); x = fmaxf(x, dppf<0x141>(x)); x = fmaxf(x, dppf<0x140>(x)); return x; }
__device__ __forceinline__ float rowsum16f(float x) {
    x += dppf<0xB1>(x); x += dppf<0x4E>(x); x += dppf<0x141>(x); x += dppf<0x140>(x); return x; }
__device__ __forceinline__ unsigned fkey(float f) { const unsigned u = __builtin_bit_cast(unsigned, f); return (u & 0x80000000u) ? ~u : (u | 0x80000000u); }
__device__ __forceinline__ float fval(unsigned k, unsigned lowmask) {
    unsigned u = (k & 0x80000000u) ? (k & 0x7fffffffu) : ~k; u &= ~lowmask; return __builtin_bit_cast(float, u); }
#define CE_DESC(a, b) do { const unsigned _hi = umax_(a, b), _lo = umin_(a, b); a = _hi; b = _lo; } while (0)

struct Args { const float* in[19]; float* out; unsigned char* ws; int ph_lo, ph_hi; };

__device__ __forceinline__ void p0_transpose_item(const float* W, int K, int N, f16_t* WT, LAS float* scr, int item, int lane) {
    const int nblk = N / 32, kb = item / nblk, nb = item % nblk, k0 = 64 * kb, n0 = 32 * nb;
#pragma unroll 8
    for (int i = 0; i < 32; ++i) { const int kk = 2 * i + (lane >> 5); scr[kk * 33 + (lane & 31)] = W[(size_t)(k0 + kk) * N + n0 + (lane & 31)]; }
    LDS_WAIT(); asm volatile("" ::: "memory");
    const int c = lane & 7;
#pragma unroll
    for (int j = 0; j < 4; ++j) { const int n = (lane >> 3) + 8 * j; const LAS float* s = scr + (8 * c) * 33 + n;
        u32x4 o; o.x = pk_f16(s[0 * 33], s[1 * 33]); o.y = pk_f16(s[2 * 33], s[3 * 33]); o.z = pk_f16(s[4 * 33], s[5 * 33]); o.w = pk_f16(s[6 * 33], s[7 * 33]);
        *(u32x4*)(WT + (size_t)(n0 + n) * K + k0 + 8 * c) = o; }
    LDS_WAIT(); asm volatile("" ::: "memory");
}

__device__ __forceinline__ void norm_rows(const float* src, f16_t* dst, const LAS float* A, const LAS float* S, int row0, int nrows, int wave, int lane) {
    for (int r = wave; r < nrows; r += NWAVES) {
        const f32x4* xr = (const f32x4*)(src + (size_t)(row0 + r) * DM) + lane;
        f32x4 v[4]; float s = 0.f;
#pragma unroll
        for (int j = 0; j < 4; ++j) { v[j] = xr[64 * j]; s += (v[j].x * v[j].x + v[j].y * v[j].y) + (v[j].z * v[j].z + v[j].w * v[j].w); }
        const float rstd = rsqrtf(wave_sum(s) * (1.f / DM) + EPS);
        unsigned long long* o8 = (unsigned long long*)(dst + (size_t)(row0 + r) * DM) + lane;
#pragma unroll
        for (int j = 0; j < 4; ++j) { const f32x4 a = *(const LAS f32x4*)(A + 4 * (64 * j + lane)), sh = *(const LAS f32x4*)(S + 4 * (64 * j + lane));
            const f32x4 h = v[j] * rstd * a + sh;
            o8[64 * j] = (unsigned long long)pk_f16(h.x, h.y) | ((unsigned long long)pk_f16(h.z, h.w) << 32); }
    }
}

__global__ void __launch_bounds__(NTHR, 2) fwd_kernel(Args args) {
    extern __shared__ __attribute__((aligned(16))) unsigned char lds_raw[];
    LAS unsigned char* lds = (LAS unsigned char*)lds_raw;
    volatile LAS unsigned* MISC = (volatile LAS unsigned*)(lds + MISC_OFF);
    const int tid = threadIdx.x, lane = tid & 63, wave = __builtin_amdgcn_readfirstlane(tid >> 6);
    const int G = gridDim.x, wg = blockIdx.x;
    unsigned char* ws = args.ws;
    unsigned* ctl = (unsigned*)(ws + WS_CTL);

    const float* x = args.in[0]; const float* cvec = args.in[1]; const float* w_ada = args.in[2]; const float* b_ada = args.in[3];
    const float* g_norm1 = args.in[4]; const float* w_in = args.in[5]; const float* w_pool = args.in[6]; const float* pool_scale = args.in[7];
    const float* sgu_ln_g = args.in[8]; const float* sgu_ln_b = args.in[9]; const float* w_spatial = args.in[10]; const float* b_spatial = args.in[11];
    const float* w_out = args.in[12]; const float* g_norm2 = args.in[13]; const float* w_query = args.in[14]; const float* sub_keys = args.in[15];
    const float* expert_down = args.in[16]; const float* expert_up = args.in[17]; const float* g_final = args.in[18];
    float* out = args.out;
    float* mod = (float*)(ws + WS_MOD); float* modp = (float*)(ws + WS_MODP);
    f16_t* WinT = (f16_t*)(ws + WS_WIN); f16_t* WoutT = (f16_t*)(ws + WS_WOUT); f16_t* WqkT = (f16_t*)(ws + WS_WQK);
    f16_t* WpoolT = (f16_t*)(ws + WS_WPOOL); f16_t* Wsp = (f16_t*)(ws + WS_WSP);
    f16_t* Ed = (f16_t*)(ws + WS_ED); f16_t* Eu = (f16_t*)(ws + WS_EU);
    f16_t* H1 = (f16_t*)(ws + WS_H1); f16_t* PROJ = (f16_t*)(ws + WS_PROJ); f16_t* MIX = (f16_t*)(ws + WS_MIX); f16_t* H2 = (f16_t*)(ws + WS_H2);
    float* SC = (float*)(ws + WS_SC);

    if (tid < 64) MISC[tid] = 0u;
    __syncthreads();
    XcdBarrier bar; bar.bar = ctl + CW_BAR; bar.x = 0; bar.st = MISC + 8;
    if (N_LAUNCHES == 1) bar = xcd_barrier_post(ctl + CW_BAR, MISC + 8);
#define GRID_BAR() do { if (N_LAUNCHES == 1) xcd_barrier(bar); } while (0)
    const int lo = args.ph_lo, hi = args.ph_hi;
#define IN(k) (lo <= (k) && (k) < hi)
#define BOTH(k) (IN(k) && IN((k) + 1))

    if (IN(0)) {
        LAS float* cact = (LAS float*)lds;
        for (int i = tid; i < BATCH * DM; i += NTHR) { const float v = cvec[i]; cact[i] = v / (1.f + __expf(-v)); }
        __syncthreads();
        const int gw = wg * NWAVES + wave, NGW = G * NWAVES;
        for (int it = gw; it < 96 * 8; it += NGW) {
            const int cc = it % 96, ks = it / 96, e = cc * 64 + lane;
            const float* wp = w_ada + (size_t)(ks * 128) * NMOD + e; const LAS float* ca = cact + ks * 128;
            float a0 = 0.f, a1 = 0.f, a2 = 0.f, a3 = 0.f;
#pragma unroll 8
            for (int k = 0; k < 128; ++k) { const float w = wp[(size_t)k * NMOD]; a0 += ca[k] * w; a1 += ca[DM + k] * w; a2 += ca[2 * DM + k] * w; a3 += ca[3 * DM + k] * w; }
            float* mp = modp + (size_t)(ks * 4) * NMOD + e; mp[0] = a0; mp[NMOD] = a1; mp[2 * NMOD] = a2; mp[3 * NMOD] = a3;
        }
        { LAS float* scr = (LAS float*)(lds + 16384 + wave * 12288);
          constexpr int I_IN = (DM / 64) * (NPROJ / 32), I_OUT = (DM / 64) * (DM / 32), I_POOL = (128 / 64) * (128 / 32);
          for (int it = gw; it < I_IN + I_OUT + 4 * I_POOL; it += NGW) {
              int r = it;
              if (r < I_IN) { p0_transpose_item(w_in, DM, NPROJ, WinT, scr, r, lane); continue; } r -= I_IN;
              if (r < I_OUT) { p0_transpose_item(w_out, DM, DM, WoutT, scr, r, lane); continue; } r -= I_OUT;
              const int g = r / I_POOL; p0_transpose_item(w_pool + g * 16384, 128, 128, WpoolT + g * 16384, scr, r % I_POOL, lane);
          } }
        { const int gt = wg * NTHR + tid, NGT = G * NTHR;
          for (int i = gt; i < 8192; i += NGT) { const int base = i * 8, t = (base >> 7) & 127, s0 = base & 127;
              const f32x4 a = *(const f32x4*)(w_spatial + base), b = *(const f32x4*)(w_spatial + base + 4);
              float v[8] = {a.x, a.y, a.z, a.w, b.x, b.y, b.z, b.w};
#pragma unroll
              for (int e = 0; e < 8; ++e) v[e] = (s0 + e <= t) ? v[e] : 0.f;
              u32x4 o; o.x = pk_f16(v[0], v[1]); o.y = pk_f16(v[2], v[3]); o.z = pk_f16(v[4], v[5]); o.w = pk_f16(v[6], v[7]);
              *(u32x4*)(Wsp + base) = o; }
          const int NIT = NEXP * DM / 8;
          for (int i = gt; i < 2 * NIT; i += NGT) { const int tb = i >= NIT; const size_t j = (size_t)(tb ? i - NIT : i) * 8;
              const float* src = (tb ? expert_up : expert_down) + j; f16_t* dst = (tb ? Eu : Ed) + j;
              const f32x4 a = *(const f32x4*)src, b = *(const f32x4*)(src + 4);
              u32x4 o; o.x = pk_f16(a.x, a.y); o.y = pk_f16(a.z, a.w); o.z = pk_f16(b.x, b.y); o.w = pk_f16(b.z, b.w);
              *(u32x4*)dst = o; } }
        __syncthreads();
        for (int item = wg; item < 256; item += G) {
            const int hp = item >> 4, D0 = (item & 15) * 64;
            LAS float* SKs = (LAS float*)lds;
            LAS float* WQs = (LAS float*)(lds + 128 * 129 * 4);
            for (int i = tid; i < 128 * 32; i += NTHR) { const int k = i >> 5, d4 = (i & 31) * 4; const f32x4 v = *(const f32x4*)(sub_keys + (size_t)(hp * 128 + k) * 128 + d4);
                LAS float* p = SKs + k * 129 + d4; p[0] = v.x; p[1] = v.y; p[2] = v.z; p[3] = v.w; }
            for (int i = tid; i < 64 * 32; i += NTHR) { const int dd = i >> 5, d4 = (i & 31) * 4; const f32x4 v = *(const f32x4*)(w_query + (size_t)(D0 + dd) * NQK + hp * 128 + d4);
                LAS float* p = WQs + dd * 129 + d4; p[0] = v.x; p[1] = v.y; p[2] = v.z; p[3] = v.w; }
            __syncthreads();
            const int tk = tid >> 4, td = tid & 15;
            float acc[4][4];
#pragma unroll
            for (int i = 0; i < 4; ++i)
#pragma unroll
                for (int j = 0; j < 4; ++j) acc[i][j] = 0.f;
            for (int d = 0; d < 128; ++d) { float a[4], b[4];
#pragma unroll
                for (int i = 0; i < 4; ++i) { a[i] = SKs[(4 * tk + i) * 129 + d]; b[i] = WQs[(4 * td + i) * 129 + d]; }
#pragma unroll
                for (int i = 0; i < 4; ++i)
#pragma unroll
                    for (int j = 0; j < 4; ++j) acc[i][j] += a[i] * b[j]; }
#pragma unroll
            for (int i = 0; i < 4; ++i) { u32x2 o; o.x = pk_f16(acc[i][0], acc[i][1]); o.y = pk_f16(acc[i][2], acc[i][3]);
                *(u32x2*)(WqkT + (size_t)(hp * 128 + 4 * tk + i) * DM + D0 + 4 * td) = o; }
            __syncthreads();
        }
        if (BOTH(0)) GRID_BAR();
    }

    if (IN(1)) {
        LAS float* A = (LAS float*)lds; LAS float* S = A + DM;
        for (int i = wg * NTHR + tid; i < BATCH * NMOD; i += G * NTHR) { const int b = i / NMOD, e = i % NMOD; float s = b_ada[e];
#pragma unroll
            for (int ks = 0; ks < 8; ++ks) s += modp[(size_t)(ks * 4 + b) * NMOD + e];
            mod[i] = s; }
        for (int tile = wg; tile < M / 128; tile += G) {
            const int b = tile >> 6;
            __syncthreads();
            for (int c = tid; c < DM; c += NTHR) { float sh = b_ada[c], sc = b_ada[DM + c];
#pragma unroll
                for (int ks = 0; ks < 8; ++ks) { sh += modp[(size_t)(ks * 4 + b) * NMOD + c]; sc += modp[(size_t)(ks * 4 + b) * NMOD + DM + c]; }
                A[c] = g_norm1[c] * (1.f + sc); S[c] = sh; }
            __syncthreads();
            norm_rows(x, H1, A, S, tile * 128, 128, wave, lane);
        }
        if (BOTH(1)) GRID_BAR();
    }

    if (IN(2)) {
        pg8::Gemm g{H1, WinT, M, NPROJ, DM}; pg8::StaticOrder S; S.init(M, NPROJ, G, wg);
        pg8::EpiF16 E{PROJ, NPROJ};
        pg8::gemm_phase<pg8::EpiF16, pg8::StaticOrder, true, true>(lds, g, S, E);
        if (BOTH(2)) GRID_BAR();
    }

#if defined(DBG_NAIVE_P3)
    if (IN(3)) {
        LAS float* stats = (LAS float*)lds;
        for (int tile = wg; tile < M / 128; tile += G) {
            const int row0 = tile * 128;
            __syncthreads();
            for (int r = wave; r < 128; r += NWAVES) {
                const f16x8 v = *(const f16x8*)(PROJ + (size_t)(row0 + r) * NPROJ + 1024 + lane * 8);
                float s = 0.f;
                for (int e = 0; e < 8; ++e) s += (float)v[e];
                const float mean = wave_sum(s) * (1.f / 512.f); float q = 0.f;
                for (int e = 0; e < 8; ++e) { const float d = (float)v[e] - mean; q += d * d; }
                const float rstd = rsqrtf(wave_sum(q) * (1.f / 512.f) + EPS);
                if (lane == 0) { stats[2 * r] = mean; stats[2 * r + 1] = rstd; }
            }
            __syncthreads();
            const _Float16* PH = (const _Float16*)PROJ;
            for (int i = tid; i < 128 * DM; i += NTHR) {
                const int t = i >> 10, col = i & 1023, row = row0 + t, pos = row & 8191;
                float outv;
                if (col < 512) { const int g = col >> 7, d = col & 127, w = 2 << g; const int cnt = (pos + 1 < w) ? pos + 1 : w; float acc = 0.f;
                    for (int c = 0; c < 128; ++c) { float sm = 0.f; for (int j = 0; j < cnt; ++j) sm += (float)PH[(size_t)(row - j) * NPROJ + g * 128 + c];
                        const float pooled = sm / (float)cnt - (float)PH[(size_t)row * NPROJ + g * 128 + c]; acc += pooled * w_pool[(g * 128 + c) * 128 + d]; }
                    outv = acc * pool_scale[col]; }
                else { const int cc = col - 512, h = cc >> 7; float acc = 0.f;
                    for (int s2 = 0; s2 <= t; ++s2) { const float vn = ((float)PH[(size_t)(row0 + s2) * NPROJ + 1024 + cc] - stats[2 * s2]) * stats[2 * s2 + 1] * sgu_ln_g[cc] + sgu_ln_b[cc];
                        acc += w_spatial[(h * 128 + t) * 128 + s2] * vn; }
                    acc += b_spatial[h * 128 + t];
                    outv = (float)PH[(size_t)row * NPROJ + 512 + cc] * acc; }
                ((_Float16*)MIX)[(size_t)row * DM + col] = (_Float16)outv;
            }
        }
        if (BOTH(3)) GRID_BAR();
    }
#else
    if (IN(3)) {
        constexpr int PITCH = 272;
        LAS unsigned char* img = lds;
        LAS float* stats = (LAS float*)(lds + 512 * PITCH);
        const int fr = lane & 15, fq = lane >> 4;
        for (int tile = wg; tile < M / 128; tile += G) {
            const int row0 = tile * 128;
            __syncthreads();
            for (int r = wave; r < 128; r += NWAVES) {
                const f16x8 v = *(const f16x8*)(PROJ + (size_t)(row0 + r) * NPROJ + 1024 + lane * 8);
                float s = 0.f;
#pragma unroll
                for (int e = 0; e < 8; ++e) s += (float)v[e];
                const float mean = wave_sum(s) * (1.f / 512.f); float q = 0.f;
#pragma unroll
                for (int e = 0; e < 8; ++e) { const float d = (float)v[e] - mean; q += d * d; }
                const float rstd = rsqrtf(wave_sum(q) * (1.f / 512.f) + EPS);
                if (lane == 0) { stats[2 * r] = mean; stats[2 * r + 1] = rstd; }
            }
            __syncthreads();
            { const int cp = tid & 255; const float g0 = sgu_ln_g[2 * cp], g1 = sgu_ln_g[2 * cp + 1], b0 = sgu_ln_b[2 * cp], b1 = sgu_ln_b[2 * cp + 1];
              for (int sb = tid >> 8; sb < 16; sb += 2) {
                  float v0[8], v1[8];
#pragma unroll
                  for (int e = 0; e < 8; ++e) { const int s = sb * 8 + e; const f16x2 hv = *(const f16x2*)(PROJ + (size_t)(row0 + s) * NPROJ + 1024 + 2 * cp);
                      const float mean = stats[2 * s], rstd = stats[2 * s + 1];
                      v0[e] = ((float)hv.x - mean) * rstd * g0 + b0; v1[e] = ((float)hv.y - mean) * rstd * g1 + b1; }
                  u32x4 o0, o1; o0.x = pk_f16(v0[0], v0[1]); o0.y = pk_f16(v0[2], v0[3]); o0.z = pk_f16(v0[4], v0[5]); o0.w = pk_f16(v0[6], v0[7]);
                  o1.x = pk_f16(v1[0], v1[1]); o1.y = pk_f16(v1[2], v1[3]); o1.z = pk_f16(v1[4], v1[5]); o1.w = pk_f16(v1[6], v1[7]);
                  *(LAS u32x4*)(img + (2 * cp) * PITCH + sb * 16) = o0; *(LAS u32x4*)(img + (2 * cp + 1) * PITCH + sb * 16) = o1; } }
            __syncthreads();
            { const int h = wave >> 1, th = wave & 1, t0 = 64 * th;
              const int nks = th ? 4 : 2;
#pragma unroll 1
              for (int ch = 0; ch < 2; ++ch) {
                  f32x4 acc[4][4];
#pragma unroll
                  for (int m = 0; m < 4; ++m)
#pragma unroll
                      for (int n = 0; n < 4; ++n) acc[m][n] = (f32x4){0.f, 0.f, 0.f, 0.f};
                  const f16_t* wbase = Wsp + (size_t)(h * 128 + t0 + fr) * 128 + 8 * fq;
                  const LAS unsigned char* vbase = img + (h * 128 + 64 * ch + fr) * PITCH + 16 * fq;
#pragma unroll 1
                  for (int ks = 0; ks < nks; ++ks) {
                      f16x8 wf[4], vf[4];
#pragma unroll
                      for (int m = 0; m < 4; ++m) wf[m] = *(const f16x8*)(wbase + (16 * m) * 128 + 32 * ks);
#pragma unroll
                      for (int n = 0; n < 4; ++n) vf[n] = *(const LAS f16x8*)(vbase + (16 * n) * PITCH + 64 * ks);
#pragma unroll
                      for (int m = 0; m < 4; ++m)
#pragma unroll
                          for (int n = 0; n < 4; ++n) acc[m][n] = __builtin_amdgcn_mfma_f32_16x16x32_f16(vf[n], wf[m], acc[m][n], 0, 0, 0);
                  }
#pragma unroll
                  for (int m = 0; m < 4; ++m) { const int t = t0 + 16 * m + fr; const float bs = b_spatial[h * 128 + t];
                      const int cb0 = h * 128 + 64 * ch + 4 * fq;
                      const f16_t* up = PROJ + (size_t)(row0 + t) * NPROJ + 512 + cb0; f16_t* op = MIX + (size_t)(row0 + t) * DM + 512 + cb0;
#pragma unroll
                      for (int n = 0; n < 4; ++n) {
                          const f16x4 u = *(const f16x4*)(up + 16 * n);
                          u32x2 o; o.x = pk_f16((float)u[0] * (acc[m][n][0] + bs), (float)u[1] * (acc[m][n][1] + bs)); o.y = pk_f16((float)u[2] * (acc[m][n][2] + bs), (float)u[3] * (acc[m][n][3] + bs));
                          *(u32x2*)(op + 16 * n) = o; } }
              } }
            __syncthreads();
            { const int cp = tid & 255, thh = tid >> 8, g = cp >> 6, w = 2 << g, cl = (2 * cp) & 127;
              const int p0 = (tile & 63) * 128;
              const f16_t* ap = PROJ + (size_t)row0 * NPROJ + 2 * cp;
              float s0 = 0.f, s1 = 0.f;
              const int tt0 = 64 * thh;
              for (int j = 1; j <= w; ++j) { if (p0 + tt0 - j >= 0) { const f16x2 hv = *(const f16x2*)(ap + (ptrdiff_t)(tt0 - j) * NPROJ); s0 += (float)hv.x; s1 += (float)hv.y; } }
              for (int tb = 0; tb < 64; tb += 8) {
                  f16x2 cur[8], old[8];
#pragma unroll
                  for (int e = 0; e < 8; ++e) { const int tt = tt0 + tb + e; cur[e] = *(const f16x2*)(ap + (ptrdiff_t)tt * NPROJ);
                      const bool ok = (p0 + tt - w >= 0); old[e] = ok ? *(const f16x2*)(ap + (ptrdiff_t)(tt - w) * NPROJ) : (f16x2){(_Float16)0.f, (_Float16)0.f}; }
#pragma unroll
                  for (int e = 0; e < 8; ++e) { const int tt = tt0 + tb + e; const int pos = p0 + tt + 1;
                      s0 += (float)cur[e].x; s1 += (float)cur[e].y; s0 -= (float)old[e].x; s1 -= (float)old[e].y;
                      const float inv = 1.f / (float)(pos < w ? pos : w);
                      *(LAS unsigned*)(img + (g * 128 + tt) * PITCH + cl * 2) = pk_f16(s0 * inv - (float)cur[e].x, s1 * inv - (float)cur[e].y); }
              } }
            __syncthreads();
            { const int g = wave >> 1, th = wave & 1, t0 = 64 * th;
#pragma unroll 1
              for (int ch = 0; ch < 2; ++ch) {
                  f32x4 acc[4][4];
#pragma unroll
                  for (int m = 0; m < 4; ++m)
#pragma unroll
                      for (int n = 0; n < 4; ++n) acc[m][n] = (f32x4){0.f, 0.f, 0.f, 0.f};
                  const LAS unsigned char* pbase = img + (g * 128 + t0 + fr) * PITCH + 16 * fq;
                  const f16_t* wbase = WpoolT + (size_t)(g * 128 + 64 * ch + fr) * 128 + 8 * fq;
#pragma unroll 1
                  for (int ks = 0; ks < 4; ++ks) {
                      f16x8 pf[4], wf[4];
#pragma unroll
                      for (int m = 0; m < 4; ++m) pf[m] = *(const LAS f16x8*)(pbase + (16 * m) * PITCH + 64 * ks);
#pragma unroll
                      for (int n = 0; n < 4; ++n) wf[n] = *(const f16x8*)(wbase + (16 * n) * 128 + 32 * ks);
#pragma unroll
                      for (int m = 0; m < 4; ++m)
#pragma unroll
                          for (int n = 0; n < 4; ++n) acc[m][n] = __builtin_amdgcn_mfma_f32_16x16x32_f16(wf[n], pf[m], acc[m][n], 0, 0, 0);
                  }
                  const int cb0 = g * 128 + 64 * ch + 4 * fq;
#pragma unroll
                  for (int m = 0; m < 4; ++m) { const int t = t0 + 16 * m + fr; f16_t* op = MIX + (size_t)(row0 + t) * DM + cb0;
#pragma unroll
                      for (int n = 0; n < 4; ++n) { const f32x4 ps = *(const f32x4*)(pool_scale + cb0 + 16 * n);
                          u32x2 o; o.x = pk_f16(acc[m][n][0] * ps.x, acc[m][n][1] * ps.y); o.y = pk_f16(acc[m][n][2] * ps.z, acc[m][n][3] * ps.w);
                          *(u32x2*)(op + 16 * n) = o; } }
              } }
        }
        if (BOTH(3)) GRID_BAR();
    }
#endif

    if (IN(4)) {
        pg8::Gemm g{MIX, WoutT, M, DM, DM}; pg8::StaticOrder S; S.init(M, DM, G, wg);
        pg8::EpiRes E{x, out, mod + 2 * DM, DM};
        pg8::gemm_phase<pg8::EpiRes, pg8::StaticOrder, true, true>(lds, g, S, E);
        if (BOTH(4)) GRID_BAR();
    }

    if (IN(5)) {
        LAS float* A = (LAS float*)lds; LAS float* S = A + DM;
        for (int tile = wg; tile < M / 128; tile += G) {
            const int b = tile >> 6;
            __syncthreads();
            for (int c = tid; c < DM; c += NTHR) { A[c] = g_norm2[c] * (1.f + mod[b * NMOD + 4 * DM + c]); S[c] = mod[b * NMOD + 3 * DM + c]; }
            __syncthreads();
            norm_rows(out, H2, A, S, tile * 128, 128, wave, lane);
        }
        if (BOTH(5)) GRID_BAR();
    }

    if (IN(6)) {
        pg8::Gemm g{H2, WqkT, M, NQK, DM}; pg8::StaticOrder S; S.init(M, NQK, G, wg);
        pg8::EpiF32 E{SC, NQK};
        pg8::gemm_phase<pg8::EpiF32, pg8::StaticOrder, true, true>(lds, g, S, E);
        if (BOTH(6)) GRID_BAR();
    }

    if (IN(7)) {
        LAS float* G2 = (LAS float*)lds; LAS float* GF = G2 + DM;
        LAS unsigned* wl = (LAS unsigned*)(lds + 8192 + wave * 2048);
        LAS unsigned* tk = wl; LAS unsigned* pe_idx = wl + 64; LAS float* pe_gate = (LAS float*)(wl + 192);
        const int l16 = lane & 15, row = lane >> 4, hsel = lane >> 5;
        for (int tile = wg; tile < M / 128; tile += G) {
            const int b = tile >> 6;
            __syncthreads();
            for (int c = tid; c < DM; c += NTHR) { G2[c] = mod[b * NMOD + 5 * DM + c]; GF[c] = g_final[c]; }
            __syncthreads();
            for (int r = wave; r < 128; r += NWAVES) {
                const int tok = tile * 128 + r;
                const float* sc = SC + (size_t)tok * NQK;
                for (int ps = 0; ps < 4; ++ps) {
                    const f32x4 sa = *(const f32x4*)(sc + ps * 512 + lane * 8), sb = *(const f32x4*)(sc + ps * 512 + lane * 8 + 4);
                    unsigned k0 = fkey(sa.x), k1 = fkey(sa.y), k2 = fkey(sa.z), k3 = fkey(sa.w), k4 = fkey(sb.x), k5 = fkey(sb.y), k6 = fkey(sb.z), k7 = fkey(sb.w);
                    const unsigned ib = 127u - (unsigned)(l16 * 8);
                    k0 = (k0 & ~127u) | (ib - 0u); k1 = (k1 & ~127u) | (ib - 1u); k2 = (k2 & ~127u) | (ib - 2u); k3 = (k3 & ~127u) | (ib - 3u);
                    k4 = (k4 & ~127u) | (ib - 4u); k5 = (k5 & ~127u) | (ib - 5u); k6 = (k6 & ~127u) | (ib - 6u); k7 = (k7 & ~127u) | (ib - 7u);
                    CE_DESC(k0, k1); CE_DESC(k2, k3); CE_DESC(k4, k5); CE_DESC(k6, k7);
                    CE_DESC(k0, k2); CE_DESC(k1, k3); CE_DESC(k4, k6); CE_DESC(k5, k7);
                    CE_DESC(k1, k2); CE_DESC(k5, k6);
                    CE_DESC(k0, k4); CE_DESC(k1, k5); CE_DESC(k2, k6); CE_DESC(k3, k7);
                    CE_DESC(k2, k4); CE_DESC(k3, k5);
                    CE_DESC(k1, k2); CE_DESC(k3, k4); CE_DESC(k5, k6);
                    unsigned top = 0u;
#pragma unroll
                    for (int rr = 0; rr < 16; ++rr) {
                        const unsigned m = rowmax16u(k0);
                        top = (l16 == rr) ? m : top;
                        const bool pop = (k0 == m);
                        k0 = pop ? k1 : k0; k1 = pop ? k2 : k1; k2 = pop ? k3 : k2; k3 = pop ? k4 : k3; k4 = pop ? k5 : k4; k5 = pop ? k6 : k5; k6 = pop ? k7 : k6; k7 = pop ? 0u : k7;
                    }
                    tk[lane] = top;
                    __builtin_amdgcn_wave_barrier(); LDS_WAIT();
                    const LAS unsigned* ab = tk + 32 * hsel; const LAS unsigned* bb = ab + 16;
                    const unsigned aik = ab[l16], a0k = ab[0], bik = bb[l16];
                    const u32x4 bq0 = *(const LAS u32x4*)bb, bq1 = *(const LAS u32x4*)(bb + 4);
                    const float vai = fval(aik, 127u), va0 = fval(a0k, 127u), vbi = fval(bik, 127u);
                    const unsigned bk[8] = {bq0.x, bq0.y, bq0.z, bq0.w, bq1.x, bq1.y, bq1.z, bq1.w};
                    unsigned L[8];
#pragma unroll
                    for (int e = 0; e < 8; ++e) { const float sv = vai + fval(bk[e], 127u); const unsigned kk = (fkey(sv) & ~255u) | (255u - (unsigned)(l16 * 16 + e));
                        L[e] = ((l16 + 1) * (e + 1) <= 16) ? kk : 0u; }
                    { const float sv = va0 + vbi; const unsigned kk = (fkey(sv) & ~255u) | (255u - (unsigned)l16); L[1] = (l16 >= 8) ? kk : L[1]; }
                    CE_DESC(L[0], L[1]);
                    unsigned best = 0u;
#pragma unroll
                    for (int rr = 0; rr < 16; ++rr) {
                        const unsigned m = rowmax16u(L[0]);
                        best = (l16 == rr) ? m : best;
                        const bool pop = (L[0] == m);
                        L[0] = pop ? L[1] : L[0]; L[1] = pop ? L[2] : L[1]; L[2] = pop ? L[3] : L[2]; L[3] = pop ? L[4] : L[3]; L[4] = pop ? L[5] : L[4]; L[5] = pop ? L[6] : L[5]; L[6] = pop ? L[7] : L[6]; L[7] = pop ? 0u : L[7];
                    }
                    const unsigned flat = 255u - (best & 255u), ci = flat >> 4, cj = flat & 15u;
                    const unsigned ak = ab[ci], bk2 = bb[cj];
                    const float sval = fval(ak, 127u) + fval(bk2, 127u);
                    const unsigned eidx = (127u - (ak & 127u)) * 128u + (127u - (bk2 & 127u));
                    const float mx = rowmax16f(sval), ex = __expf(sval - mx), sm = rowsum16f(ex), gt = ex / sm;
                    if ((row & 1) == 0) { const int hd = 2 * ps + hsel; pe_idx[hd * 16 + l16] = eidx; pe_gate[hd * 16 + l16] = gt; }
                    __builtin_amdgcn_wave_barrier(); LDS_WAIT();
                }
                const unsigned idxA = pe_idx[lane], idxB = pe_idx[64 + lane];
                const float gA = pe_gate[lane], gB = pe_gate[64 + lane];
                const u32x4 hA = *(const u32x4*)(H2 + (size_t)tok * DM + lane * 8), hB = *(const u32x4*)(H2 + (size_t)tok * DM + 512 + lane * 8);
#if defined(DBG_CHECK)
                { unsigned* DI = (unsigned*)(ws + 400 * MiB); float* DG = (float*)(ws + 416 * MiB); DI[(size_t)tok * 128 + lane] = idxA; DI[(size_t)tok * 128 + 64 + lane] = idxB; DG[(size_t)tok * 128 + lane] = gA; DG[(size_t)tok * 128 + 64 + lane] = gB; }
#endif
                float coefA, coefB;
#pragma unroll 1
                for (int grp = 0; grp < 2; ++grp) {
                    const unsigned idxv = grp ? idxB : idxA;
                    float p[64];
#pragma unroll
                    for (int sub = 0; sub < 8; ++sub) {
                        u32x4 ra[8], rb[8];
#pragma unroll
                        for (int i = 0; i < 8; ++i) { const unsigned e = (unsigned)__builtin_amdgcn_readlane((int)idxv, sub * 8 + i);
                            const f16_t* rp = Ed + (size_t)e * DM; ra[i] = *(const u32x4*)(rp + lane * 8); rb[i] = *(const u32x4*)(rp + 512 + lane * 8); }
#pragma unroll
                        for (int i = 0; i < 8; ++i) { float s = 0.f;
                            s = __builtin_amdgcn_fdot2(as_h2(ra[i].x), as_h2(hA.x), s, false);
                            s = __builtin_amdgcn_fdot2(as_h2(ra[i].y), as_h2(hA.y), s, false);
                            s = __builtin_amdgcn_fdot2(as_h2(ra[i].z), as_h2(hA.z), s, false);
                            s = __builtin_amdgcn_fdot2(as_h2(ra[i].w), as_h2(hA.w), s, false);
                            s = __builtin_amdgcn_fdot2(as_h2(rb[i].x), as_h2(hB.x), s, false);
                            s = __builtin_amdgcn_fdot2(as_h2(rb[i].y), as_h2(hB.y), s, false);
                            s = __builtin_amdgcn_fdot2(as_h2(rb[i].z), as_h2(hB.z), s, false);
                            s = __builtin_amdgcn_fdot2(as_h2(rb[i].w), as_h2(hB.w), s, false);
                            p[sub * 8 + i] = s; }
                    }
#pragma unroll
                    for (int j = 0; j < 32; ++j) { const auto sw = __builtin_amdgcn_permlane32_swap(as_u(p[j]), as_u(p[j + 32]), false, false);
                        p[j] = as_f(sw[0]) + as_f(sw[1]); }
#pragma unroll
                    for (int j = 0; j < 16; ++j) { const auto sw = __builtin_amdgcn_permlane16_swap(as_u(p[j]), as_u(p[j + 16]), false, false);
                        p[j] = as_f(sw[0]) + as_f(sw[1]); }
#pragma unroll
                    for (int j = 0; j < 8; ++j) { const bool up = (lane & 8) != 0; const float keep = up ? p[j + 8] : p[j], send = up ? p[j] : p[j + 8]; p[j] = keep + __shfl_xor(send, 8); }
#pragma unroll
                    for (int j = 0; j < 4; ++j) { const bool up = (lane & 4) != 0; const float keep = up ? p[j + 4] : p[j], send = up ? p[j] : p[j + 4]; p[j] = keep + __shfl_xor(send, 4); }
#pragma unroll
                    for (int j = 0; j < 2; ++j) { const bool up = (lane & 2) != 0; const float keep = up ? p[j + 2] : p[j], send = up ? p[j] : p[j + 2]; p[j] = keep + __shfl_xor(send, 2); }
                    { const bool up = (lane & 1) != 0; const float keep = up ? p[1] : p[0], send = up ? p[0] : p[1]; p[0] = keep + __shfl_xor(send, 1); }
                    const float pre = p[0];
                    const float act = 0.5f * pre * (1.f + erff(pre * 0.70710678118654752f));
                    if (grp) coefB = gB * act; else coefA = gA * act;
                }
#if defined(DBG_CHECK)
                { float* DC = (float*)(ws + 432 * MiB); DC[(size_t)tok * 128 + lane] = coefA; DC[(size_t)tok * 128 + 64 + lane] = coefB; }
#endif
                float acc[16];
#pragma unroll
                for (int j = 0; j < 16; ++j) acc[j] = 0.f;
#pragma unroll 1
                for (int grp = 0; grp < 2; ++grp) {
                    const unsigned idxv = grp ? idxB : idxA; const float cf = grp ? coefB : coefA;
#pragma unroll 1
                    for (int sub = 0; sub < 8; ++sub) {
                        u32x4 ra[8], rb[8];
#pragma unroll
                        for (int i = 0; i < 8; ++i) { const unsigned e = (unsigned)__builtin_amdgcn_readlane((int)idxv, sub * 8 + i);
                            const f16_t* rp = Eu + (size_t)e * DM; ra[i] = *(const u32x4*)(rp + lane * 8); rb[i] = *(const u32x4*)(rp + 512 + lane * 8); }
#pragma unroll
                        for (int i = 0; i < 8; ++i) { const float cs = __builtin_bit_cast(float, __builtin_amdgcn_readlane(__builtin_bit_cast(int, cf), sub * 8 + i));
                            const f16x8 va = __builtin_bit_cast(f16x8, ra[i]), vb = __builtin_bit_cast(f16x8, rb[i]);
#pragma unroll
                            for (int e = 0; e < 8; ++e) { acc[e] = fmaf((float)va[e], cs, acc[e]); acc[8 + e] = fmaf((float)vb[e], cs, acc[8 + e]); } }
                    }
                }
                float* orow = out + (size_t)tok * DM;
                f32x4 xv[4]; xv[0] = *(const f32x4*)(orow + lane * 8); xv[1] = *(const f32x4*)(orow + lane * 8 + 4); xv[2] = *(const f32x4*)(orow + 512 + lane * 8); xv[3] = *(const f32x4*)(orow + 512 + lane * 8 + 4);
                float ss = 0.f;
#pragma unroll
                for (int q = 0; q < 4; ++q) { const int cb = (q >> 1) * 512 + lane * 8 + (q & 1) * 4; const f32x4 g2 = *(const LAS f32x4*)(G2 + cb);
                    xv[q].x += g2.x * acc[4 * q + 0]; xv[q].y += g2.y * acc[4 * q + 1]; xv[q].z += g2.z * acc[4 * q + 2]; xv[q].w += g2.w * acc[4 * q + 3];
                    ss += (xv[q].x * xv[q].x + xv[q].y * xv[q].y) + (xv[q].z * xv[q].z + xv[q].w * xv[q].w); }
                const float rstd = rsqrtf(wave_sum(ss) * (1.f / DM) + EPS);
#pragma unroll
                for (int q = 0; q < 4; ++q) { const int cb = (q >> 1) * 512 + lane * 8 + (q & 1) * 4; const f32x4 gf = *(const LAS f32x4*)(GF + cb);
                    *(f32x4*)(orow + cb) = xv[q] * rstd * gf; }
            }
        }
    }
#undef IN
#undef BOTH
#undef GRID_BAR
}


#if defined(DBG_CHECK)
constexpr size_t WS_FLAGS = 32 * 1024, WS_SNAP = 12 * MiB;
constexpr int NSAMP_TOK = 64;
__device__ __forceinline__ unsigned hash32(unsigned x) { x ^= x >> 16; x *= 0x7feb352du; x ^= x >> 15; x *= 0x846ca68bu; x ^= x >> 16; return x; }
__device__ __forceinline__ void chk(unsigned* flags, int id, float got, float ref, float atol, float rtol) { if (!(fabsf(got - ref) <= atol + rtol * fabsf(ref))) atomicAdd(&flags[id], 1u); }
__device__ __forceinline__ int samp_tok(int j) { return (j < 8) ? j * 4681 % M : (j < 16 ? ((j - 8) & 3) * 8192 + (j & 1) * 127 + (j >> 2 & 1) * 4000 : (int)(hash32(j * 977u + 5u) % M)); }
__global__ void dbg_check(Args args, int which) {
    unsigned char* ws = args.ws; unsigned* flags = (unsigned*)(ws + WS_FLAGS);
    const float* x = args.in[0]; const float* cvec = args.in[1]; const float* w_ada = args.in[2]; const float* b_ada = args.in[3];
    const float* g_norm1 = args.in[4]; const float* w_in = args.in[5]; const float* w_pool = args.in[6]; const float* pool_scale = args.in[7];
    const float* sgu_ln_g = args.in[8]; const float* sgu_ln_b = args.in[9]; const float* w_spatial = args.in[10]; const float* b_spatial = args.in[11];
    const float* w_out = args.in[12]; const float* g_norm2 = args.in[13]; const float* w_query = args.in[14]; const float* sub_keys = args.in[15];
    const float* expert_down = args.in[16]; const float* expert_up = args.in[17]; const float* g_final = args.in[18];
    const float* mod = (const float*)(ws + WS_MOD);
    const _Float16* H1 = (const _Float16*)(ws + WS_H1); const _Float16* PROJ = (const _Float16*)(ws + WS_PROJ); const _Float16* MIX = (const _Float16*)(ws + WS_MIX); const _Float16* H2 = (const _Float16*)(ws + WS_H2);
    const float* SC = (const float*)(ws + WS_SC); float* snap = (float*)(ws + WS_SNAP); const float* out = args.out;
    const unsigned gt = blockIdx.x * blockDim.x + threadIdx.x, NGT = gridDim.x * blockDim.x;
    if (which == 1) {
        for (unsigned i = gt; i < BATCH * NMOD; i += NGT) { const int b = i / NMOD, e = i % NMOD; float s = b_ada[e];
            for (int d = 0; d < DM; ++d) { const float c = cvec[b * DM + d]; s += (c / (1.f + expf(-c))) * w_ada[(size_t)d * NMOD + e]; }
            chk(flags, 1, mod[i], s, 1e-3f, 1e-3f); }
    } else if (which == 2) {
        for (unsigned i = gt; i < 4096 * 16; i += NGT) { const int row = hash32(i >> 4) % M, c0 = (i & 15) * 64, b = row >> 13; float ss = 0.f;
            for (int c = 0; c < DM; ++c) { const float v = x[(size_t)row * DM + c]; ss += v * v; }
            const float rstd = rsqrtf(ss / DM + EPS);
            for (int c = c0; c < c0 + 64; ++c) { const float ref = x[(size_t)row * DM + c] * rstd * g_norm1[c] * (1.f + mod[b * NMOD + DM + c]) + mod[b * NMOD + c];
                chk(flags, 2, (float)H1[(size_t)row * DM + c], ref, 4e-3f, 2e-3f); } }
    } else if (which == 3) {
        for (unsigned i = gt; i < 65536; i += NGT) { const unsigned h = hash32(i * 3u + 1u); const int row = h % M, col = (h >> 15) % NPROJ; float s = 0.f;
            for (int k = 0; k < DM; ++k) s += (float)H1[(size_t)row * DM + k] * w_in[(size_t)k * NPROJ + col];
            chk(flags, 3, (float)PROJ[(size_t)row * NPROJ + col], s, 1e-2f, 5e-3f); }
    } else if (which == 4) {
        for (unsigned i = gt; i < 32768; i += NGT) { const unsigned h = hash32(i * 5u + 2u); const int row = (i < 2048) ? ((i & 7) * 8192 % M + (i >> 3) % 32) : (int)(h % M), col = (h >> 15) % DM, pos = row & 8191; float ref;
            if (col < 512) { const int g = col >> 7, d = col & 127, w = 2 << g; const int cnt = (pos + 1 < w) ? pos + 1 : w; float acc = 0.f;
                for (int c = 0; c < 128; ++c) { float sm = 0.f; for (int j = 0; j < cnt; ++j) sm += (float)PROJ[(size_t)(row - j) * NPROJ + g * 128 + c];
                    acc += (sm / (float)cnt - (float)PROJ[(size_t)row * NPROJ + g * 128 + c]) * w_pool[(g * 128 + c) * 128 + d]; }
                ref = acc * pool_scale[col]; }
            else { const int cc = col - 512, hh = cc >> 7, t = row & 127, r0 = row - t; float acc = 0.f;
                for (int s2 = 0; s2 <= t; ++s2) { float mean = 0.f, var = 0.f; const _Float16* vr = PROJ + (size_t)(r0 + s2) * NPROJ + 1024;
                    for (int k = 0; k < 512; ++k) mean += (float)vr[k]; mean /= 512.f; for (int k = 0; k < 512; ++k) { const float dd = (float)vr[k] - mean; var += dd * dd; }
                    const float vn = ((float)vr[cc] - mean) * rsqrtf(var / 512.f + EPS) * sgu_ln_g[cc] + sgu_ln_b[cc]; acc += w_spatial[(hh * 128 + t) * 128 + s2] * vn; }
                ref = (float)PROJ[(size_t)row * NPROJ + 512 + cc] * (acc + b_spatial[hh * 128 + t]); }
            chk(flags, 4, (float)MIX[(size_t)row * DM + col], ref, 3e-2f, 1e-2f); }
    } else if (which == 5) {
        for (unsigned i = gt; i < 65536; i += NGT) { const unsigned h = hash32(i * 7u + 3u); const int row = h % M, col = (h >> 15) % DM, b = row >> 13; float s = 0.f;
            for (int k = 0; k < DM; ++k) s += (float)MIX[(size_t)row * DM + k] * w_out[(size_t)k * DM + col];
            chk(flags, 5, out[(size_t)row * DM + col], x[(size_t)row * DM + col] + mod[b * NMOD + 2 * DM + col] * s, 2e-2f, 5e-3f); }
    } else if (which == 6) {
        for (unsigned i = gt; i < 4096 * 16; i += NGT) { const int row = hash32((i >> 4) + 777u) % M, c0 = (i & 15) * 64, b = row >> 13; float ss = 0.f;
            for (int c = 0; c < DM; ++c) { const float v = out[(size_t)row * DM + c]; ss += v * v; }
            const float rstd = rsqrtf(ss / DM + EPS);
            for (int c = c0; c < c0 + 64; ++c) { const float ref = out[(size_t)row * DM + c] * rstd * g_norm2[c] * (1.f + mod[b * NMOD + 4 * DM + c]) + mod[b * NMOD + 3 * DM + c];
                chk(flags, 6, (float)H2[(size_t)row * DM + c], ref, 4e-3f, 2e-3f); } }
        for (unsigned i = gt; i < NSAMP_TOK * DM; i += NGT) snap[i] = out[(size_t)samp_tok(i / DM) * DM + (i % DM)];
    } else if (which == 8) {
        const _Float16* Ed = (const _Float16*)(ws + WS_ED); const _Float16* Eu = (const _Float16*)(ws + WS_EU);
        for (unsigned i = gt; i < 262144; i += NGT) { const size_t j = (size_t)(hash32(i * 13u + 6u) % (unsigned)(NEXP * DM));
            chk(flags, 8, (float)Ed[j], expert_down[j], 1e-5f, 1e-3f); chk(flags, 8, (float)Eu[j], expert_up[j], 1e-5f, 1e-3f); }
    } else if (which == 7) {
        for (unsigned i = gt; i < 16384; i += NGT) { const unsigned h = hash32(i * 11u + 4u); const int row = h % M, n = (h >> 15) % NQK, hp = n >> 7, k = n & 127; float s = 0.f;
            for (int d = 0; d < 128; ++d) { float q = 0.f; for (int kk = 0; kk < DM; ++kk) q += (float)H2[(size_t)row * DM + kk] * w_query[(size_t)kk * NQK + hp * 128 + d];
                s += q * sub_keys[(size_t)(hp * 128 + k) * 128 + d]; }
            chk(flags, 7, SC[(size_t)row * NQK + n], s, 2e-2f, 5e-3f); }
    }
}
__global__ void dbg_check_peer(Args args) {
    __shared__ float sc[2048]; __shared__ float stop[16][16]; __shared__ int itop[16][16]; __shared__ float cand[8][256]; __shared__ float gate[128]; __shared__ int eidx[128]; __shared__ float red[256];
    unsigned char* ws = args.ws; unsigned* flags = (unsigned*)(ws + WS_FLAGS);
    const float* expert_down = args.in[16]; const float* expert_up = args.in[17]; const float* g_final = args.in[18];
    const float* mod = (const float*)(ws + WS_MOD); const _Float16* H2 = (const _Float16*)(ws + WS_H2); const float* SC = (const float*)(ws + WS_SC); const float* snap = (const float*)(ws + WS_SNAP);
    const int j = blockIdx.x, tok = samp_tok(j), t = threadIdx.x, b = tok >> 13;
    for (int i = t; i < 2048; i += 256) sc[i] = SC[(size_t)tok * NQK + i];
    __syncthreads();
    if (t < 16) { for (int r = 0; r < 16; ++r) { int bi = 0; float bv = -3e38f; for (int k = 0; k < 128; ++k) { const float v = sc[t * 128 + k]; if (v > bv) { bv = v; bi = k; } } stop[t][r] = bv; itop[t][r] = bi; sc[t * 128 + bi] = -3e38f; } }
    __syncthreads();
    for (int i = t; i < 2048; i += 256) { const int h = i >> 8, a = (i >> 4) & 15, c = i & 15; cand[h][a * 16 + c] = stop[2 * h][a] + stop[2 * h + 1][c]; }
    __syncthreads();
    if (t < 8) { float bv[16]; float mx = -3e38f; for (int r = 0; r < 16; ++r) { int bi = 0; float v0 = -3e38f; for (int k = 0; k < 256; ++k) { const float v = cand[t][k]; if (v > v0) { v0 = v; bi = k; } }
            cand[t][bi] = -3e38f; gate[t * 16 + r] = v0; eidx[t * 16 + r] = itop[2 * t][bi >> 4] * 128 + itop[2 * t + 1][bi & 15]; mx = fmaxf(mx, v0); }
        float sm = 0.f; for (int r = 0; r < 16; ++r) { const float e = expf(gate[t * 16 + r] - mx); gate[t * 16 + r] = e; sm += e; } for (int r = 0; r < 16; ++r) gate[t * 16 + r] /= sm; }
    __syncthreads();
    const unsigned* DI = (const unsigned*)(ws + 400 * MiB); const float* DG = (const float*)(ws + 416 * MiB); const float* DC = (const float*)(ws + 432 * MiB);
    __shared__ int fidx[128]; __shared__ float fcoef[128];
    if (t < 128) { const int h = t >> 4; const unsigned fi = DI[(size_t)tok * 128 + t]; const float fg = DG[(size_t)tok * 128 + t]; int found = -1;
        for (int r = 0; r < 16; ++r) if (eidx[h * 16 + r] == (int)fi) found = r;
        if (found < 0 || fi >= (unsigned)NEXP) atomicAdd(&flags[10], 1u); else chk(flags, 11, fg, gate[h * 16 + found], 2e-3f, 1e-2f);
        const unsigned fic = fi < (unsigned)NEXP ? fi : 0u; fidx[t] = (int)fic;
        float s = 0.f; const float* ur = expert_down + (size_t)fic * DM; for (int d = 0; d < DM; ++d) s += ur[d] * (float)H2[(size_t)tok * DM + d];
        const float cref = fg * 0.5f * s * (1.f + erff(s * 0.70710678f)); const float fc = DC[(size_t)tok * 128 + t];
        chk(flags, 12, fc, cref, 2e-3f, 1e-2f); fcoef[t] = fc; }
    __syncthreads();
    float x2[4]; float ss = 0.f;
    for (int q = 0; q < 4; ++q) { const int c = t + 256 * q; float o = 0.f; for (int k = 0; k < 128; ++k) o += fcoef[k] * expert_up[(size_t)fidx[k] * DM + c];
        x2[q] = snap[(size_t)j * DM + c] + mod[b * NMOD + 5 * DM + c] * o; ss += x2[q] * x2[q]; }
    red[t] = ss; __syncthreads();
    for (int o = 128; o > 0; o >>= 1) { if (t < o) red[t] += red[t + o]; __syncthreads(); }
    const float rstd = rsqrtf(red[0] / DM + EPS);
    for (int q = 0; q < 4; ++q) { const int c = t + 256 * q; chk(flags, 13, args.out[(size_t)tok * DM + c], x2[q] * rstd * g_final[c], 2e-2f, 1e-2f); }
}
__global__ void dbg_report(Args args) {
    const unsigned* flags = (const unsigned*)(args.ws + WS_FLAGS); int id = 0;
    for (int k = 1; k < 16; ++k) if (flags[k] > ((k == 10 || k == 11) ? 40u : 0u) && !id) id = k;
    if (!id) return; float f = 1.f + 2.f * id; if (id >= 10) { const float fr = (float)flags[id] / 8192.f; f = 1.f + (float)id + 0.9f * (fr > 1.f ? 1.f : fr); }
    for (size_t i = (size_t)blockIdx.x * blockDim.x + threadIdx.x; i < (size_t)M * DM; i += (size_t)gridDim.x * blockDim.x) args.out[i] *= f;
}
#endif
extern "C" void kernel_launch(void* const* d_in, const int* in_sizes, int n_in, void* d_out, int out_size, void* d_ws, size_t ws_size, hipStream_t stream) {
    static int grid = 0;
    if (grid == 0) {
        if (n_in != 19 || out_size != M * DM || ws_size < WS_END) { fprintf(stderr, "kernel_launch: unexpected shapes (n_in %d out %d ws %zu)\n", n_in, out_size, ws_size); grid = -1; return; }
        int dev = 0, cus = 0, per_cu = 0;
        if (hipGetDevice(&dev) != hipSuccess || hipDeviceGetAttribute(&cus, hipDeviceAttributeMultiprocessorCount, dev) != hipSuccess) { grid = -1; return; }
        if (hipFuncSetAttribute((const void*)fwd_kernel, hipFuncAttributeMaxDynamicSharedMemorySize, LDS_BYTES) != hipSuccess) { fprintf(stderr, "kernel_launch: hipFuncSetAttribute failed\n"); grid = -1; return; }
        if (hipOccupancyMaxActiveBlocksPerMultiprocessor(&per_cu, (const void*)fwd_kernel, NTHR, LDS_BYTES) != hipSuccess || per_cu < 1) { fprintf(stderr, "kernel_launch: occupancy query says %d\n", per_cu); }
        (void)hipGetLastError();
        grid = cus;
    }
    if (grid < 0) return;
    (void)hipMemsetAsync((char*)d_ws + WS_CTL, 0, CTL_ZERO_BYTES, stream);
    Args a{};
    for (int i = 0; i < 19; ++i) a.in[i] = (const float*)d_in[i];
    a.out = (float*)d_out; a.ws = (unsigned char*)d_ws;
    if (N_LAUNCHES == 1) {
        a.ph_lo = 0; a.ph_hi = N_PHASES;
        void* kargs[] = {&a};
        hipError_t e = hipLaunchCooperativeKernel((const void*)fwd_kernel, dim3(grid), dim3(NTHR), kargs, LDS_BYTES, stream);
        if (e != hipSuccess) fprintf(stderr, "kernel_launch: cooperative launch failed: %s (grid %d)\n", hipGetErrorString(e), grid);
    } else {
        for (int p = 0; p < N_PHASES; ++p) { a.ph_lo = p; a.ph_hi = p + 1; hipLaunchKernelGGL(fwd_kernel, dim3(grid), dim3(NTHR), LDS_BYTES, stream, a);
#if defined(DBG_CHECK)
            if (p >= 1 && p <= 6) hipLaunchKernelGGL(dbg_check, dim3(1024), dim3(256), 0, stream, a, p);
            if (p == 0) hipLaunchKernelGGL(dbg_check, dim3(1024), dim3(256), 0, stream, a, 8);
            if (p == 6) hipLaunchKernelGGL(dbg_check, dim3(1024), dim3(256), 0, stream, a, 7);
            if (p == 7) { hipLaunchKernelGGL(dbg_check_peer, dim3(NSAMP_TOK), dim3(256), 0, stream, a); hipLaunchKernelGGL(dbg_report, dim3(1024), dim3(256), 0, stream, a); }
#endif
        }
    }
}
```

```cpp
#include <hip/hip_runtime.h>
#include <cstdio>
#include <cstdint>

#ifndef MK_N_LAUNCHES
#define MK_N_LAUNCHES 1
#endif

#define LAS __attribute__((address_space(3)))
#define GAS __attribute__((address_space(1)))
typedef unsigned short f16_t;
typedef _Float16 f16x8 __attribute__((ext_vector_type(8)));
typedef _Float16 f16x4 __attribute__((ext_vector_type(4)));
typedef _Float16 f16x2 __attribute__((ext_vector_type(2)));
typedef float f32x4 __attribute__((ext_vector_type(4)));
typedef unsigned u32x4 __attribute__((ext_vector_type(4)));
typedef unsigned u32x2 __attribute__((ext_vector_type(2)));

__device__ __forceinline__ f16x2 as_h2(unsigned u) { return __builtin_bit_cast(f16x2, u); }
__device__ __forceinline__ float as_f(unsigned u) { return __builtin_bit_cast(float, u); }
__device__ __forceinline__ unsigned as_u(float f) { return __builtin_bit_cast(unsigned, f); }
__device__ __forceinline__ unsigned pk_f16(float lo, float hi) { f16x2 v = {(_Float16)lo, (_Float16)hi}; return __builtin_bit_cast(unsigned, v); }

namespace pg8 {
constexpr int BM = 256, BK = 64, HALF = 128, HTB = HALF * BK * 2, STAGE_BYTES = 8 * HTB, NXCD = 8, WGM = 8;
__host__ __device__ __forceinline__ int lds_byte(int r, int c) { const int st = (r >> 4) * 2 + (c >> 5), rr = r & 15, cc = c & 31, ob = rr * 64 + cc * 2; return st * 1024 + (ob ^ (((ob >> 9) & 1) << 5)); }
__host__ __device__ __forceinline__ void stage_rc(int b, int& R, int& C) { const int st = b / 1024, sb = b % 1024, swz = sb ^ (((sb >> 9) & 1) << 5); R = (st >> 1) * 16 + swz / 64; C = (st & 1) * 32 + (swz % 64) / 2; }
__host__ __device__ __forceinline__ int perm32(int rho) { const int n = rho >> 4, i = rho & 15; return 8 * (i >> 2) + 4 * n + (i & 3); }
struct Unit { int pm, pn; };
struct Gemm { const f16_t* A; const f16_t* Bt; int M, N, K; };
struct StaticOrder {
    int nM, nN, nwg, G, c;
    __host__ __device__ void init(int M, int N, int G_, int c_) { nM = M / BM; nN = N / BM; nwg = nM * nN; G = G_; c = c_; }
    __host__ __device__ bool next(int i, Unit& u) const {
        const long L = (long)i * G + c; if (L >= nwg) return false;
        int wgid = (int)L; { const int q = nwg / NXCD, r = nwg % NXCD, xcd = wgid % NXCD, off = wgid / NXCD; wgid = (xcd < r ? xcd * (q + 1) : r * (q + 1) + (xcd - r) * q) + off; }
        const int nig = WGM * nN, gid = wgid / nig, fm = gid * WGM, gsz = (nM - fm) < WGM ? (nM - fm) : WGM;
        u.pm = fm + ((wgid % nig) % gsz); u.pn = (wgid % nig) / gsz; return true;
    }
    __device__ __forceinline__ void a_ready(const Unit&) const {}
    __device__ __forceinline__ void done(const Unit&) const {}
};
struct EpiF16 {
    static constexpr bool PERM = true, AFTER_DRAIN = false;
    f16_t* O; int ldc;
    __device__ __forceinline__ void operator()(const f32x4 (&acc)[2][2][4][2], const Unit& u, int wr, int wc, int fr, int fq) const {
        const int row0 = u.pm * BM + wr * 64 + fr, col0 = u.pn * BM + wc * 32 + 8 * fq;
#pragma unroll
        for (int ai = 0; ai < 2; ++ai)
#pragma unroll
            for (int m = 0; m < 4; ++m) { f16_t* rowp = O + (size_t)(row0 + ai * HALF + m * 16) * ldc + col0;
#pragma unroll
                for (int bj = 0; bj < 2; ++bj) { const f32x4 v0 = acc[ai][bj][m][0], v1 = acc[ai][bj][m][1];
                    u32x4 w; w.x = pk_f16(v0[0], v0[1]); w.y = pk_f16(v0[2], v0[3]); w.z = pk_f16(v1[0], v1[1]); w.w = pk_f16(v1[2], v1[3]);
                    *(u32x4*)(rowp + bj * HALF) = w; } }
    }
};
struct EpiF32 {
    static constexpr bool PERM = false, AFTER_DRAIN = false;
    float* C; int ldc;
    __device__ __forceinline__ void operator()(const f32x4 (&acc)[2][2][4][2], const Unit& u, int wr, int wc, int fr, int fq) const {
        const int row0 = u.pm * BM + wr * 64 + fr, col0 = u.pn * BM + wc * 32 + 4 * fq;
#pragma unroll
        for (int ai = 0; ai < 2; ++ai)
#pragma unroll
            for (int m = 0; m < 4; ++m) { float* rowp = C + (size_t)(row0 + ai * HALF + m * 16) * ldc + col0;
#pragma unroll
                for (int bj = 0; bj < 2; ++bj)
#pragma unroll
                    for (int n = 0; n < 2; ++n) *(f32x4*)(rowp + bj * HALF + n * 16) = acc[ai][bj][m][n]; }
    }
};
struct EpiRes {
    static constexpr bool PERM = false, AFTER_DRAIN = false;
    const float* X; float* O; const float* gate; int ldc;
    __device__ __forceinline__ void operator()(const f32x4 (&acc)[2][2][4][2], const Unit& u, int wr, int wc, int fr, int fq) const {
        const int row0 = u.pm * BM + wr * 64 + fr, col0 = u.pn * BM + wc * 32 + 4 * fq;
        const float* g = gate + (size_t)((u.pm * BM) >> 13) * 6144;
        f32x4 gv[2][2];
#pragma unroll
        for (int bj = 0; bj < 2; ++bj)
#pragma unroll
            for (int n = 0; n < 2; ++n) gv[bj][n] = *(const f32x4*)(g + col0 + bj * HALF + n * 16);
#pragma unroll
        for (int ai = 0; ai < 2; ++ai)
#pragma unroll
            for (int m = 0; m < 4; ++m) { const size_t off = (size_t)(row0 + ai * HALF + m * 16) * ldc + col0;
#pragma unroll
                for (int bj = 0; bj < 2; ++bj)
#pragma unroll
                    for (int n = 0; n < 2; ++n) { const f32x4 xv = *(const f32x4*)(X + off + bj * HALF + n * 16); *(f32x4*)(O + off + bj * HALF + n * 16) = xv + gv[bj][n] * acc[ai][bj][m][n]; }
                if (m & 1) asm volatile("" ::: "memory"); }
    }
};

template <class Epi, class Sched, bool ALIGN_EPI = false, bool SP2 = false>
__device__ __forceinline__ void gemm_phase(LAS unsigned char* lds, const Gemm g, const Sched& S, const Epi& E) {
    const int tid = threadIdx.x, wid = __builtin_amdgcn_readfirstlane(tid >> 6), lane = tid & 63, wr = wid >> 2, wc = wid & 3, fr = lane & 15, fq = lane >> 4;
    const int K = g.K, nt = K / BK;
    unsigned voffA[2], voffB[2];
#pragma unroll
    for (int i = 0; i < 2; ++i) { int R, C; stage_rc(tid * 16 + i * 8192, R, C); const int Rb = Epi::PERM ? ((R & ~31) + perm32(R & 31)) : R;
        voffA[i] = (unsigned)(R * K + C) * 2u; voffB[i] = (unsigned)(Rb * K + C) * 2u; }
    const size_t kstep = (size_t)(BK * 2);
    const size_t hstep = (size_t)HALF * K * 2;
    const size_t tstep = 2 * hstep;
    const unsigned ldsw = (unsigned)wid * 1024u;
    const int aoff = lds_byte(wr * 64 + fr, fq * 8), boff = lds_byte(wc * 32 + fr, fq * 8);
#define PG8_SA(b, h) (((b) * 2 + (h)) * HTB)
#define PG8_SB(b, h) ((4 + (b) * 2 + (h)) * HTB)
#define PG8_STAGE(bufoff, gbase, voff) do { _Pragma("unroll") for (int _i = 0; _i < 2; ++_i) \
        __builtin_amdgcn_global_load_lds((const unsigned*)((const char*)(gbase) + (voff)[_i]), (LAS unsigned*)(lds + (bufoff) + ldsw + _i * 8192), 16, 0, 0); } while (0)
#define PG8_LDA(dst, b, h) do { _Pragma("unroll") for (int m = 0; m < 4; ++m) _Pragma("unroll") for (int k = 0; k < 2; ++k) dst[m][k] = *(const LAS f16x8*)(lds + PG8_SA(b, h) + aoff + m * 2048 + k * 1024); } while (0)
#define PG8_LDB(dst, b, h) do { _Pragma("unroll") for (int n = 0; n < 2; ++n) _Pragma("unroll") for (int k = 0; k < 2; ++k) dst[n][k] = *(const LAS f16x8*)(lds + PG8_SB(b, h) + boff + n * 2048 + k * 1024); } while (0)
#define PG8_MMA(ai, bj, At, Bt) do { __builtin_amdgcn_s_setprio(1); _Pragma("unroll") for (int m = 0; m < 4; ++m) _Pragma("unroll") for (int n = 0; n < 2; ++n) _Pragma("unroll") for (int k = 0; k < 2; ++k) \
        acc[ai][bj][m][n] = __builtin_amdgcn_mfma_f32_16x16x32_f16(Bt[n][k], At[m][k], acc[ai][bj][m][n], 0, 0, 0); __builtin_amdgcn_s_setprio(0); } while (0)
#define PG8_WAIT_V(n) asm volatile("s_waitcnt vmcnt(" #n ")" ::: "memory")
#define PG8_WAIT_L(n) asm volatile("s_waitcnt lgkmcnt(" #n ")" ::: "memory")
#define PG8_BAR __builtin_amdgcn_s_barrier()
#define PG8_SCHED __builtin_amdgcn_sched_barrier(0)
    Unit cur, nxt; int ui = 0;
    if (!S.next(0, cur)) return;
    f32x4 acc[2][2][4][2];
#pragma unroll
    for (int a = 0; a < 2; ++a)
#pragma unroll
        for (int b = 0; b < 2; ++b)
#pragma unroll
            for (int m = 0; m < 4; ++m)
#pragma unroll
                for (int n = 0; n < 2; ++n) acc[a][b][m][n] = (f32x4){0.f, 0.f, 0.f, 0.f};
    f16x8 At[4][2], B0[2][2], B1[2][2];
    const char* cA = (const char*)g.A + (size_t)cur.pm * tstep; const char* cB = (const char*)g.Bt + (size_t)cur.pn * tstep;
    S.a_ready(cur);
    if constexpr (SP2) {
        PG8_STAGE(PG8_SB(0, 0), cB, voffB); PG8_STAGE(PG8_SB(0, 1), cB + hstep, voffB); PG8_STAGE(PG8_SA(0, 0), cA, voffA); PG8_STAGE(PG8_SA(0, 1), cA + hstep, voffA);
        if (wr == 1) PG8_BAR;
        PG8_WAIT_V(2); PG8_BAR;
        PG8_STAGE(PG8_SB(1, 0), cB + kstep, voffB); PG8_STAGE(PG8_SA(1, 0), cA + kstep, voffA); PG8_STAGE(PG8_SB(1, 1), cB + hstep + kstep, voffB);
        PG8_WAIT_V(6); PG8_BAR;
    } else {
        PG8_STAGE(PG8_SB(0, 0), cB, voffB); PG8_STAGE(PG8_SA(0, 0), cA, voffA); PG8_STAGE(PG8_SB(0, 1), cB + hstep, voffB); PG8_STAGE(PG8_SA(0, 1), cA + hstep, voffA);
        if (wr == 1) PG8_BAR;
        PG8_WAIT_V(4); PG8_BAR;
        PG8_STAGE(PG8_SB(1, 0), cB + kstep, voffB); PG8_STAGE(PG8_SA(1, 0), cA + kstep, voffA); PG8_STAGE(PG8_SB(1, 1), cB + hstep + kstep, voffB);
        PG8_WAIT_V(6); PG8_BAR;
    }
    for (;;) {
        const bool has_next = S.next(ui + 1, nxt);
        const char* nA = has_next ? (const char*)g.A + (size_t)nxt.pm * tstep : cA; const char* nB = has_next ? (const char*)g.Bt + (size_t)nxt.pn * tstep : cB;
        for (int t = 0; t < nt; t += 2) {
            const bool last = (t == nt - 2);
            const char* a1 = cA + (size_t)(t + 1) * kstep;
            const char* a2 = last ? nA : cA + (size_t)(t + 2) * kstep; const char* b2 = last ? nB : cB + (size_t)(t + 2) * kstep;
            const char* a3 = a2 + kstep; const char* b3 = b2 + kstep;
            if (last && has_next) S.a_ready(nxt);
            if constexpr (SP2) {
            PG8_LDB(B0, 0, 0); PG8_LDB(B1, 0, 1); PG8_SCHED; PG8_LDA(At, 0, 0); PG8_STAGE(PG8_SA(1, 1), a1 + hstep, voffA);
            PG8_WAIT_V(8); PG8_WAIT_L(0); PG8_BAR; PG8_MMA(0, 0, At, B0); PG8_MMA(0, 1, At, B1); PG8_BAR; PG8_SCHED;
            PG8_LDA(At, 0, 1); PG8_STAGE(PG8_SB(0, 0), b2, voffB); PG8_STAGE(PG8_SB(0, 1), b2 + hstep, voffB); PG8_STAGE(PG8_SA(0, 0), a2, voffA);
            PG8_WAIT_V(8); PG8_WAIT_L(0); PG8_BAR; PG8_MMA(1, 0, At, B0); PG8_MMA(1, 1, At, B1); PG8_BAR; PG8_SCHED;
            PG8_LDB(B0, 1, 0); PG8_LDB(B1, 1, 1); PG8_SCHED; PG8_LDA(At, 1, 0); PG8_STAGE(PG8_SA(0, 1), a2 + hstep, voffA);
            PG8_WAIT_V(8); PG8_WAIT_L(0); PG8_BAR; PG8_MMA(0, 0, At, B0); PG8_MMA(0, 1, At, B1); PG8_BAR; PG8_SCHED;
            PG8_LDA(At, 1, 1); PG8_STAGE(PG8_SB(1, 0), b3, voffB); PG8_STAGE(PG8_SB(1, 1), b3 + hstep, voffB); PG8_STAGE(PG8_SA(1, 0), a3, voffA);
            PG8_WAIT_V(8); PG8_WAIT_L(0); PG8_BAR; PG8_MMA(1, 0, At, B0); PG8_MMA(1, 1, At, B1); PG8_BAR; PG8_SCHED;
            } else {
            PG8_LDB(B0, 0, 0); PG8_SCHED; PG8_LDA(At, 0, 0); PG8_STAGE(PG8_SA(1, 1), a1 + hstep, voffA);
            PG8_WAIT_L(8); PG8_BAR; PG8_WAIT_L(0); PG8_MMA(0, 0, At, B0); PG8_BAR; PG8_SCHED;
            PG8_LDB(B1, 0, 1); PG8_STAGE(PG8_SB(0, 0), b2, voffB);
            PG8_BAR; PG8_WAIT_L(0); PG8_MMA(0, 1, At, B1); PG8_BAR;
            PG8_LDA(At, 0, 1); PG8_STAGE(PG8_SA(0, 0), a2, voffA);
            PG8_BAR; PG8_WAIT_L(0); PG8_MMA(1, 0, At, B0); PG8_BAR; PG8_SCHED;
            PG8_STAGE(PG8_SB(0, 1), b2 + hstep, voffB);
            PG8_WAIT_V(6); PG8_BAR; PG8_MMA(1, 1, At, B1); PG8_BAR;
            PG8_LDB(B0, 1, 0); PG8_SCHED; PG8_LDA(At, 1, 0); PG8_STAGE(PG8_SA(0, 1), a2 + hstep, voffA);
            PG8_WAIT_L(8); PG8_BAR; PG8_WAIT_L(0); PG8_MMA(0, 0, At, B0); PG8_BAR; PG8_SCHED;
            PG8_LDB(B1, 1, 1); PG8_STAGE(PG8_SB(1, 0), b3, voffB);
            PG8_BAR; PG8_WAIT_L(0); PG8_MMA(0, 1, At, B1); PG8_BAR;
            PG8_LDA(At, 1, 1); PG8_STAGE(PG8_SA(1, 0), a3, voffA);
            PG8_BAR; PG8_WAIT_L(0); PG8_MMA(1, 0, At, B0); PG8_BAR; PG8_SCHED;
            PG8_STAGE(PG8_SB(1, 1), b3 + hstep, voffB);
            PG8_WAIT_V(6); PG8_BAR; PG8_MMA(1, 1, At, B1); PG8_BAR;
            }
        }
        if constexpr (ALIGN_EPI) { if (wr == 0) PG8_BAR; }
        if constexpr (!Epi::AFTER_DRAIN) { E(acc, cur, wr, wc, fr, fq); S.done(cur); }
        if (!has_next) break;
#pragma unroll
        for (int a = 0; a < 2; ++a)
#pragma unroll
            for (int b = 0; b < 2; ++b)
#pragma unroll
                for (int m = 0; m < 4; ++m)
#pragma unroll
                    for (int n = 0; n < 2; ++n) acc[a][b][m][n] = (f32x4){0.f, 0.f, 0.f, 0.f};
        cur = nxt; cA = nA; cB = nB; ++ui;
        if constexpr (ALIGN_EPI) { if (wr == 1) PG8_BAR; }
    }
    PG8_WAIT_V(0);
    if constexpr (!ALIGN_EPI) { if (wr == 0) PG8_BAR; }
    PG8_BAR;
#undef PG8_SA
#undef PG8_SB
#undef PG8_STAGE
#undef PG8_LDA
#undef PG8_LDB
#undef PG8_MMA
#undef PG8_WAIT_V
#undef PG8_WAIT_L
#undef PG8_BAR
#undef PG8_SCHED
}
}

constexpr int NWAVES = 8, NTHR = NWAVES * 64;
constexpr int N_LAUNCHES = MK_N_LAUNCHES, N_PHASES = 8;
constexpr int BATCH = 4, SEQ = 8192, DM = 1024, M = BATCH * SEQ;
constexpr int NPROJ = 1536, NQK = 2048, NEXP = 16384, NMOD = 6 * DM;
constexpr float EPS = 1e-6f;

constexpr size_t MiB = 1u << 20;
constexpr size_t WS_CTL = 0, CTL_ZERO_BYTES = 64 * 1024;
constexpr size_t WS_MOD = 256 * 1024;
constexpr size_t WS_MODP = 1 * MiB;
constexpr size_t WS_WIN = 2 * MiB;
constexpr size_t WS_WOUT = 5 * MiB;
constexpr size_t WS_WQK = 7 * MiB;
constexpr size_t WS_WPOOL = 11 * MiB;
constexpr size_t WS_WSP = 11 * MiB + 256 * 1024;
constexpr size_t WS_ED = 16 * MiB, WS_EU = 48 * MiB;
constexpr size_t WS_H2 = 80 * MiB;
constexpr size_t WS_SC = 144 * MiB;
constexpr size_t WS_H1 = 144 * MiB, WS_PROJ = 208 * MiB, WS_MIX = 304 * MiB;
constexpr size_t WS_END = 400 * MiB;
constexpr int CW_BAR = 1024;

constexpr int RING_BYTES = 131072;
constexpr int MISC_OFF = 160 * 1024 - 256;
constexpr int LDS_BYTES = 160 * 1024;

#define RLX_AGENT __ATOMIC_RELAXED, __HIP_MEMORY_SCOPE_AGENT
#define LDS_WAIT() asm volatile("s_waitcnt lgkmcnt(0)" ::: "memory")
#define VM_WAIT() asm volatile("s_waitcnt vmcnt(0)" ::: "memory")

#define XB_TMO      128
#define XB_XCNT(j)  (256  + 64 * (j))
#define XB_XSUB(j)  (1280 + 64 * (j))
#define XB_XGEN(j)  (2304 + 64 * (j))
#define XB_TOP      3328
#define XB_TOPGEN   3392
#define XCD_BAR_WORDS 3456
#define XB_SPIN_CAP (1u << 22)
__device__ __forceinline__ unsigned xb_ld(unsigned* p)              { return __hip_atomic_load(p, __ATOMIC_RELAXED, __HIP_MEMORY_SCOPE_AGENT); }
__device__ __forceinline__ unsigned xb_add(unsigned* p, unsigned v) { return __hip_atomic_fetch_add(p, v, __ATOMIC_RELAXED, __HIP_MEMORY_SCOPE_AGENT); }
__device__ __forceinline__ unsigned xb_xcc_id() { return (unsigned)__builtin_amdgcn_s_getreg((3 << 11) | 20) & 0xFu; }
#define XB_SPIN(cond, bar) do { unsigned _sp = 0; while (cond) { __builtin_amdgcn_s_sleep(1); \
    if ((++_sp & 255u) == 0u) { if (xb_ld(&(bar)[XB_TMO])) break; if (_sp > XB_SPIN_CAP) { atomicAdd(&(bar)[XB_TMO], 1u); break; } } } } while (0)
struct XcdBarrier { unsigned* bar; unsigned x; volatile LAS unsigned* st; };
__device__ __forceinline__ XcdBarrier xcd_barrier_post(unsigned* bar, volatile LAS unsigned* st) {
    XcdBarrier b; b.bar = bar; b.x = xb_xcc_id(); b.st = st;
    if (threadIdx.x == 0) (void)xb_add(&bar[XB_XCNT(b.x)], 1u);
    return b;
}
__device__ __forceinline__ void xcd_barrier_complete(unsigned* bar, unsigned x, unsigned& nloc, unsigned& nx) {
    const unsigned G = gridDim.x * gridDim.y * gridDim.z;
    unsigned sum, cnt, mine, sp = 0u;
    for (;;) {
        sum = 0u; cnt = 0u; mine = 0u;
#pragma unroll
        for (unsigned j = 0; j < 16; ++j) { const unsigned c = xb_ld(&bar[XB_XCNT(j)]); sum += c; cnt += (c > 0u) ? 1u : 0u; mine = (j == x) ? c : mine; }
        if (sum == G) break;
        __builtin_amdgcn_s_sleep(1);
        if ((++sp & 255u) == 0u) { if (xb_ld(&bar[XB_TMO])) break; if (sp > XB_SPIN_CAP) { atomicAdd(&bar[XB_TMO], 1u); break; } }
    }
    nloc = mine > 0u ? mine : 1u; nx = cnt > 0u ? cnt : 1u;
}
__device__ __forceinline__ void xcd_barrier(const XcdBarrier& b) {
    asm volatile("s_waitcnt vmcnt(0)" ::: "memory");
    __syncthreads();
    if (threadIdx.x == 0) {
        unsigned* bar = b.bar;
        __builtin_amdgcn_s_waitcnt(0);
        unsigned nloc = b.st[0], nx = b.st[1];
        if (nloc == 0u) { xcd_barrier_complete(bar, b.x, nloc, nx); b.st[0] = nloc; b.st[1] = nx; }
        const unsigned old = xb_add(&bar[XB_XSUB(b.x)], 1u);
        const unsigned gen = old / nloc;
        if (old + 1u == (gen + 1u) * nloc) {
            __builtin_amdgcn_fence(__ATOMIC_RELEASE, "agent");
            asm volatile("s_waitcnt vmcnt(0)" ::: "memory");
            const unsigned og = xb_add(&bar[XB_TOP], 1u);
            const unsigned tg = og / nx;
            if (og + 1u == (tg + 1u) * nx) xb_add(&bar[XB_TOPGEN], 1u);
            else XB_SPIN(xb_ld(&bar[XB_TOPGEN]) == tg, bar);
            __builtin_amdgcn_fence(__ATOMIC_ACQUIRE, "agent");
            xb_add(&bar[XB_XGEN(b.x)], 1u);
            asm volatile("s_waitcnt vmcnt(0)" ::: "memory");
        } else {
            XB_SPIN(xb_ld(&bar[XB_XGEN(b.x)]) == gen, bar);
            __builtin_amdgcn_fence(__ATOMIC_ACQUIRE, "agent");
            asm volatile("s_waitcnt vmcnt(0)" ::: "memory");
        }
    }
    __syncthreads();
}

__device__ __forceinline__ float wave_sum(float v) {
#pragma unroll
    for (int o = 1; o < 64; o <<= 1) v += __shfl_xor(v, o);
    return v;
}
template <int CTRL> __device__ __forceinline__ unsigned dppu(unsigned x) { return (unsigned)__builtin_amdgcn_update_dpp((int)x, (int)x, CTRL, 0xF, 0xF, false); }
template <int CTRL> __device__ __forceinline__ float dppf(float x) { return __builtin_bit_cast(float, __builtin_amdgcn_update_dpp(__builtin_bit_cast(int, x), __builtin_bit_cast(int, x), CTRL, 0xF, 0xF, false)); }
__device__ __forceinline__ unsigned umax_(unsigned a, unsigned b) { return a > b ? a : b; }
__device__ __forceinline__ unsigned umin_(unsigned a, unsigned b) { return a < b ? a : b; }
__device__ __forceinline__ unsigned rowmax16u(unsigned x) {
    x = umax_(x, dppu<0xB1>(x)); x = umax_(x, dppu<0x4E>(x)); x = umax_(x, dppu<0x141>(x)); x = umax_(x, dppu<0x140>(x)); return x; }
__device__ __forceinline__ float rowmax16f(float x) {
    x = fmaxf(x, dppf<0xB1>(x)); x = fmaxf(x, dppf<0x4E>(x)); x = fmaxf(x, dppf<0x141>(x)); x = fmaxf(x, dppf<0x140>(x)); return x; }
__device__ __forceinline__ float rowsum16f(float x) {
    x += dppf<0xB1>(x); x += dppf<0x4E>(x); x += dppf<0x141>(x); x += dppf<0x140>(x); return x; }
__device__ __forceinline__ unsigned fkey(float f) { const unsigned u = __builtin_bit_cast(unsigned, f); return (u & 0x80000000u) ? ~u : (u | 0x80000000u); }
__device__ __forceinline__ float fval(unsigned k, unsigned lowmask) {
    unsigned u = (k & 0x80000000u) ? (k & 0x7fffffffu) : ~k; u &= ~lowmask; return __builtin_bit_cast(float, u); }
#define CE_DESC(a, b) do { const unsigned _hi = umax_(a, b), _lo = umin_(a, b); a = _hi; b = _lo; } while (0)

struct Args { const float* in[19]; float* out; unsigned char* ws; int ph_lo, ph_hi; };

__device__ __forceinline__ void p0_transpose_item(const float* W, int K, int N, f16_t* WT, LAS float* scr, int item, int lane) {
    const int nblk = N / 32, kb = item / nblk, nb = item % nblk, k0 = 64 * kb, n0 = 32 * nb;
#pragma unroll 8
    for (int i = 0; i < 32; ++i) { const int kk = 2 * i + (lane >> 5); scr[kk * 33 + (lane & 31)] = W[(size_t)(k0 + kk) * N + n0 + (lane & 31)]; }
    LDS_WAIT(); asm volatile("" ::: "memory");
    const int c = lane & 7;
#pragma unroll
    for (int j = 0; j < 4; ++j) { const int n = (lane >> 3) + 8 * j; const LAS float* s = scr + (8 * c) * 33 + n;
        u32x4 o; o.x = pk_f16(s[0 * 33], s[1 * 33]); o.y = pk_f16(s[2 * 33], s[3 * 33]); o.z = pk_f16(s[4 * 33], s[5 * 33]); o.w = pk_f16(s[6 * 33], s[7 * 33]);
        *(u32x4*)(WT + (size_t)(n0 + n) * K + k0 + 8 * c) = o; }
    LDS_WAIT(); asm volatile("" ::: "memory");
}

__device__ __forceinline__ void norm_rows(const float* src, f16_t* dst, const LAS float* A, const LAS float* S, int row0, int nrows, int wave, int lane) {
    for (int r = wave; r < nrows; r += NWAVES) {
        const f32x4* xr = (const f32x4*)(src + (size_t)(row0 + r) * DM) + lane;
        f32x4 v[4]; float s = 0.f;
#pragma unroll
        for (int j = 0; j < 4; ++j) { v[j] = xr[64 * j]; s += (v[j].x * v[j].x + v[j].y * v[j].y) + (v[j].z * v[j].z + v[j].w * v[j].w); }
        const float rstd = rsqrtf(wave_sum(s) * (1.f / DM) + EPS);
        unsigned long long* o8 = (unsigned long long*)(dst + (size_t)(row0 + r) * DM) + lane;
#pragma unroll
        for (int j = 0; j < 4; ++j) { const f32x4 a = *(const LAS f32x4*)(A + 4 * (64 * j + lane)), sh = *(const LAS f32x4*)(S + 4 * (64 * j + lane));
            const f32x4 h = v[j] * rstd * a + sh;
            o8[64 * j] = (unsigned long long)pk_f16(h.x, h.y) | ((unsigned long long)pk_f16(h.z, h.w) << 32); }
    }
}

__global__ void __launch_bounds__(NTHR, 2) fwd_kernel(Args args) {
    extern __shared__ __attribute__((aligned(16))) unsigned char lds_raw[];
    LAS unsigned char* lds = (LAS unsigned char*)lds_raw;
    volatile LAS unsigned* MISC = (volatile LAS unsigned*)(lds + MISC_OFF);
    const int tid = threadIdx.x, lane = tid & 63, wave = __builtin_amdgcn_readfirstlane(tid >> 6);
    const int G = gridDim.x, wg = blockIdx.x;
    unsigned char* ws = args.ws;
    unsigned* ctl = (unsigned*)(ws + WS_CTL);

    const float* x = args.in[0]; const float* cvec = args.in[1]; const float* w_ada = args.in[2]; const float* b_ada = args.in[3];
    const float* g_norm1 = args.in[4]; const float* w_in = args.in[5]; const float* w_pool = args.in[6]; const float* pool_scale = args.in[7];
    const float* sgu_ln_g = args.in[8]; const float* sgu_ln_b = args.in[9]; const float* w_spatial = args.in[10]; const float* b_spatial = args.in[11];
    const float* w_out = args.in[12]; const float* g_norm2 = args.in[13]; const float* w_query = args.in[14]; const float* sub_keys = args.in[15];
    const float* expert_down = args.in[16]; const float* expert_up = args.in[17]; const float* g_final = args.in[18];
    float* out = args.out;
    float* mod = (float*)(ws + WS_MOD); float* modp = (float*)(ws + WS_MODP);
    f16_t* WinT = (f16_t*)(ws + WS_WIN); f16_t* WoutT = (f16_t*)(ws + WS_WOUT); f16_t* WqkT = (f16_t*)(ws + WS_WQK);
    f16_t* WpoolT = (f16_t*)(ws + WS_WPOOL); f16_t* Wsp = (f16_t*)(ws + WS_WSP);
    f16_t* Ed = (f16_t*)(ws + WS_ED); f16_t* Eu = (f16_t*)(ws + WS_EU);
    f16_t* H1 = (f16_t*)(ws + WS_H1); f16_t* PROJ = (f16_t*)(ws + WS_PROJ); f16_t* MIX = (f16_t*)(ws + WS_MIX); f16_t* H2 = (f16_t*)(ws + WS_H2);
    float* SC = (float*)(ws + WS_SC);

    if (tid < 64) MISC[tid] = 0u;
    __syncthreads();
    XcdBarrier bar; bar.bar = ctl + CW_BAR; bar.x = 0; bar.st = MISC + 8;
    if (N_LAUNCHES == 1) bar = xcd_barrier_post(ctl + CW_BAR, MISC + 8);
#define GRID_BAR() do { if (N_LAUNCHES == 1) xcd_barrier(bar); } while (0)
    const int lo = args.ph_lo, hi = args.ph_hi;
#define IN(k) (lo <= (k) && (k) < hi)
#define BOTH(k) (IN(k) && IN((k) + 1))

    if (IN(0)) {
        LAS float* cact = (LAS float*)lds;
        for (int i = tid; i < BATCH * DM; i += NTHR) { const float v = cvec[i]; cact[i] = v / (1.f + __expf(-v)); }
        __syncthreads();
        const int gw = wg * NWAVES + wave, NGW = G * NWAVES;
        for (int it = gw; it < 96 * 8; it += NGW) {
            const int cc = it % 96, ks = it / 96, e = cc * 64 + lane;
            const float* wp = w_ada + (size_t)(ks * 128) * NMOD + e; const LAS float* ca = cact + ks * 128;
            float a0 = 0.f, a1 = 0.f, a2 = 0.f, a3 = 0.f;
#pragma unroll 8
            for (int k = 0; k < 128; ++k) { const float w = wp[(size_t)k * NMOD]; a0 += ca[k] * w; a1 += ca[DM + k] * w; a2 += ca[2 * DM + k] * w; a3 += ca[3 * DM + k] * w; }
            float* mp = modp + (size_t)(ks * 4) * NMOD + e; mp[0] = a0; mp[NMOD] = a1; mp[2 * NMOD] = a2; mp[3 * NMOD] = a3;
        }
        { LAS float* scr = (LAS float*)(lds + 16384 + wave * 12288);
          constexpr int I_IN = (DM / 64) * (NPROJ / 32), I_OUT = (DM / 64) * (DM / 32), I_POOL = (128 / 64) * (128 / 32);
          for (int it = gw; it < I_IN + I_OUT + 4 * I_POOL; it += NGW) {
              int r = it;
              if (r < I_IN) { p0_transpose_item(w_in, DM, NPROJ, WinT, scr, r, lane); continue; } r -= I_IN;
              if (r < I_OUT) { p0_transpose_item(w_out, DM, DM, WoutT, scr, r, lane); continue; } r -= I_OUT;
              const int g = r / I_POOL; p0_transpose_item(w_pool + g * 16384, 128, 128, WpoolT + g * 16384, scr, r % I_POOL, lane);
          } }
        { const int gt = wg * NTHR + tid, NGT = G * NTHR;
          for (int i = gt; i < 8192; i += NGT) { const int base = i * 8, t = (base >> 7) & 127, s0 = base & 127;
              const f32x4 a = *(const f32x4*)(w_spatial + base), b = *(const f32x4*)(w_spatial + base + 4);
              float v[8] = {a.x, a.y, a.z, a.w, b.x, b.y, b.z, b.w};
#pragma unroll
              for (int e = 0; e < 8; ++e) v[e] = (s0 + e <= t) ? v[e] : 0.f;
              u32x4 o; o.x = pk_f16(v[0], v[1]); o.y = pk_f16(v[2], v[3]); o.z = pk_f16(v[4], v[5]); o.w = pk_f16(v[6], v[7]);
              *(u32x4*)(Wsp + base) = o; }
          const int NIT = NEXP * DM / 8;
          for (int i = gt; i < 2 * NIT; i += NGT) { const int tb = i >= NIT; const size_t j = (size_t)(tb ? i - NIT : i) * 8;
              const float* src = (tb ? expert_up : expert_down) + j; f16_t* dst = (tb ? Eu : Ed) + j;
              const f32x4 a = *(const f32x4*)src, b = *(const f32x4*)(src + 4);
              u32x4 o; o.x = pk_f16(a.x, a.y); o.y = pk_f16(a.z, a.w); o.z = pk_f16(b.x, b.y); o.w = pk_f16(b.z, b.w);
              *(u32x4*)dst = o; } }
        __syncthreads();
        for (int item = wg; item < 256; item += G) {
            const int hp = item >> 4, D0 = (item & 15) * 64;
            LAS float* SKs = (LAS float*)lds;
            LAS float* WQs = (LAS float*)(lds + 128 * 129 * 4);
            for (int i = tid; i < 128 * 32; i += NTHR) { const int k = i >> 5, d4 = (i & 31) * 4; const f32x4 v = *(const f32x4*)(sub_keys + (size_t)(hp * 128 + k) * 128 + d4);
                LAS float* p = SKs + k * 129 + d4; p[0] = v.x; p[1] = v.y; p[2] = v.z; p[3] = v.w; }
            for (int i = tid; i < 64 * 32; i += NTHR) { const int dd = i >> 5, d4 = (i & 31) * 4; const f32x4 v = *(const f32x4*)(w_query + (size_t)(D0 + dd) * NQK + hp * 128 + d4);
                LAS float* p = WQs + dd * 129 + d4; p[0] = v.x; p[1] = v.y; p[2] = v.z; p[3] = v.w; }
            __syncthreads();
            const int tk = tid >> 4, td = tid & 15;
            float acc[4][4];
#pragma unroll
            for (int i = 0; i < 4; ++i)
#pragma unroll
                for (int j = 0; j < 4; ++j) acc[i][j] = 0.f;
            for (int d = 0; d < 128; ++d) { float a[4], b[4];
#pragma unroll
                for (int i = 0; i < 4; ++i) { a[i] = SKs[(4 * tk + i) * 129 + d]; b[i] = WQs[(4 * td + i) * 129 + d]; }
#pragma unroll
                for (int i = 0; i < 4; ++i)
#pragma unroll
                    for (int j = 0; j < 4; ++j) acc[i][j] += a[i] * b[j]; }
#pragma unroll
            for (int i = 0; i < 4; ++i) { u32x2 o; o.x = pk_f16(acc[i][0], acc[i][1]); o.y = pk_f16(acc[i][2], acc[i][3]);
                *(u32x2*)(WqkT + (size_t)(hp * 128 + 4 * tk + i) * DM + D0 + 4 * td) = o; }
            __syncthreads();
        }
        if (BOTH(0)) GRID_BAR();
    }

    if (IN(1)) {
        LAS float* A = (LAS float*)lds; LAS float* S = A + DM;
        for (int i = wg * NTHR + tid; i < BATCH * NMOD; i += G * NTHR) { const int b = i / NMOD, e = i % NMOD; float s = b_ada[e];
#pragma unroll
            for (int ks = 0; ks < 8; ++ks) s += modp[(size_t)(ks * 4 + b) * NMOD + e];
            mod[i] = s; }
        for (int tile = wg; tile < M / 128; tile += G) {
            const int b = tile >> 6;
            __syncthreads();
            for (int c = tid; c < DM; c += NTHR) { float sh = b_ada[c], sc = b_ada[DM + c];
#pragma unroll
                for (int ks = 0; ks < 8; ++ks) { sh += modp[(size_t)(ks * 4 + b) * NMOD + c]; sc += modp[(size_t)(ks * 4 + b) * NMOD + DM + c]; }
                A[c] = g_norm1[c] * (1.f + sc); S[c] = sh; }
            __syncthreads();
            norm_rows(x, H1, A, S, tile * 128, 128, wave, lane);
        }
        if (BOTH(1)) GRID_BAR();
    }

    if (IN(2)) {
        pg8::Gemm g{H1, WinT, M, NPROJ, DM}; pg8::StaticOrder S; S.init(M, NPROJ, G, wg);
        pg8::EpiF16 E{PROJ, NPROJ};
        pg8::gemm_phase<pg8::EpiF16, pg8::StaticOrder, true, true>(lds, g, S, E);
        if (BOTH(2)) GRID_BAR();
    }

#if defined(DBG_NAIVE_P3)
    if (IN(3)) {
        LAS float* stats = (LAS float*)lds;
        for (int tile = wg; tile < M / 128; tile += G) {
            const int row0 = tile * 128;
            __syncthreads();
            for (int r = wave; r < 128; r += NWAVES) {
                const f16x8 v = *(const f16x8*)(PROJ + (size_t)(row0 + r) * NPROJ + 1024 + lane * 8);
                float s = 0.f;
                for (int e = 0; e < 8; ++e) s += (float)v[e];
                const float mean = wave_sum(s) * (1.f / 512.f); float q = 0.f;
                for (int e = 0; e < 8; ++e) { const float d = (float)v[e] - mean; q += d * d; }
                const float rstd = rsqrtf(wave_sum(q) * (1.f / 512.f) + EPS);
                if (lane == 0) { stats[2 * r] = mean; stats[2 * r + 1] = rstd; }
            }
            __syncthreads();
            const _Float16* PH = (const _Float16*)PROJ;
            for (int i = tid; i < 128 * DM; i += NTHR) {
                const int t = i >> 10, col = i & 1023, row = row0 + t, pos = row & 8191;
                float outv;
                if (col < 512) { const int g = col >> 7, d = col & 127, w = 2 << g; const int cnt = (pos + 1 < w) ? pos + 1 : w; float acc = 0.f;
                    for (int c = 0; c < 128; ++c) { float sm = 0.f; for (int j = 0; j < cnt; ++j) sm += (float)PH[(size_t)(row - j) * NPROJ + g * 128 + c];
                        const float pooled = sm / (float)cnt - (float)PH[(size_t)row * NPROJ + g * 128 + c]; acc += pooled * w_pool[(g * 128 + c) * 128 + d]; }
                    outv = acc * pool_scale[col]; }
                else { const int cc = col - 512, h = cc >> 7; float acc = 0.f;
                    for (int s2 = 0; s2 <= t; ++s2) { const float vn = ((float)PH[(size_t)(row0 + s2) * NPROJ + 1024 + cc] - stats[2 * s2]) * stats[2 * s2 + 1] * sgu_ln_g[cc] + sgu_ln_b[cc];
                        acc += w_spatial[(h * 128 + t) * 128 + s2] * vn; }
                    acc += b_spatial[h * 128 + t];
                    outv = (float)PH[(size_t)row * NPROJ + 512 + cc] * acc; }
                ((_Float16*)MIX)[(size_t)row * DM + col] = (_Float16)outv;
            }
        }
        if (BOTH(3)) GRID_BAR();
    }
#else
    if (IN(3)) {
        constexpr int PITCH = 272;
        LAS unsigned char* img = lds;
        LAS float* stats = (LAS float*)(lds + 512 * PITCH);
        const int fr = lane & 15, fq = lane >> 4;
        for (int tile = wg; tile < M / 128; tile += G) {
            const int row0 = tile * 128;
            __syncthreads();
            for (int r = wave; r < 128; r += NWAVES) {
                const f16x8 v = *(const f16x8*)(PROJ + (size_t)(row0 + r) * NPROJ + 1024 + lane * 8);
                float s = 0.f;
#pragma unroll
                for (int e = 0; e < 8; ++e) s += (float)v[e];
                const float mean = wave_sum(s) * (1.f / 512.f); float q = 0.f;
#pragma unroll
                for (int e = 0; e < 8; ++e) { const float d = (float)v[e] - mean; q += d * d; }
                const float rstd = rsqrtf(wave_sum(q) * (1.f / 512.f) + EPS);
                if (lane == 0) { stats[2 * r] = mean; stats[2 * r + 1] = rstd; }
            }
            __syncthreads();
            { const int cp = tid & 255; const float g0 = sgu_ln_g[2 * cp], g1 = sgu_ln_g[2 * cp + 1], b0 = sgu_ln_b[2 * cp], b1 = sgu_ln_b[2 * cp + 1];
              for (int sb = tid >> 8; sb < 16; sb += 2) {
                  float v0[8], v1[8];
#pragma unroll
                  for (int e = 0; e < 8; ++e) { const int s = sb * 8 + e; const f16x2 hv = *(const f16x2*)(PROJ + (size_t)(row0 + s) * NPROJ + 1024 + 2 * cp);
                      const float mean = stats[2 * s], rstd = stats[2 * s + 1];
                      v0[e] = ((float)hv.x - mean) * rstd * g0 + b0; v1[e] = ((float)hv.y - mean) * rstd * g1 + b1; }
                  u32x4 o0, o1; o0.x = pk_f16(v0[0], v0[1]); o0.y = pk_f16(v0[2], v0[3]); o0.z = pk_f16(v0[4], v0[5]); o0.w = pk_f16(v0[6], v0[7]);
                  o1.x = pk_f16(v1[0], v1[1]); o1.y = pk_f16(v1[2], v1[3]); o1.z = pk_f16(v1[4], v1[5]); o1.w = pk_f16(v1[6], v1[7]);
                  *(LAS u32x4*)(img + (2 * cp) * PITCH + sb * 16) = o0; *(LAS u32x4*)(img + (2 * cp + 1) * PITCH + sb * 16) = o1; } }
            __syncthreads();
            { const int h = wave >> 1, th = wave & 1, t0 = 64 * th;
              const int nks = th ? 4 : 2;
#pragma unroll 1
              for (int ch = 0; ch < 2; ++ch) {
                  f32x4 acc[4][4];
#pragma unroll
                  for (int m = 0; m < 4; ++m)
#pragma unroll
                      for (int n = 0; n < 4; ++n) acc[m][n] = (f32x4){0.f, 0.f, 0.f, 0.f};
                  const f16_t* wbase = Wsp + (size_t)(h * 128 + t0 + fr) * 128 + 8 * fq;
                  const LAS unsigned char* vbase = img + (h * 128 + 64 * ch + fr) * PITCH + 16 * fq;
#pragma unroll 1
                  for (int ks = 0; ks < nks; ++ks) {
                      f16x8 wf[4], vf[4];
#pragma unroll
                      for (int m = 0; m < 4; ++m) wf[m] = *(const f16x8*)(wbase + (16 * m) * 128 + 32 * ks);
#pragma unroll
                      for (int n = 0; n < 4; ++n) vf[n] = *(const LAS f16x8*)(vbase + (16 * n) * PITCH + 64 * ks);
#pragma unroll
                      for (int m = 0; m < 4; ++m)
#pragma unroll
                          for (int n = 0; n < 4; ++n) acc[m][n] = __builtin_amdgcn_mfma_f32_16x16x32_f16(vf[n], wf[m], acc[m][n], 0, 0, 0);
                  }
#pragma unroll
                  for (int m = 0; m < 4; ++m) { const int t = t0 + 16 * m + fr; const float bs = b_spatial[h * 128 + t];
                      const int cb0 = h * 128 + 64 * ch + 4 * fq;
                      const f16_t* up = PROJ + (size_t)(row0 + t) * NPROJ + 512 + cb0; f16_t* op = MIX + (size_t)(row0 + t) * DM + 512 + cb0;
#pragma unroll
                      for (int n = 0; n < 4; ++n) {
                          const f16x4 u = *(const f16x4*)(up + 16 * n);
                          u32x2 o; o.x = pk_f16((float)u[0] * (acc[m][n][0] + bs), (float)u[1] * (acc[m][n][1] + bs)); o.y = pk_f16((float)u[2] * (acc[m][n][2] + bs), (float)u[3] * (acc[m][n][3] + bs));
                          *(u32x2*)(op + 16 * n) = o; } }
              } }
            __syncthreads();
            { const int cp = tid & 255, thh = tid >> 8, g = cp >> 6, w = 2 << g, cl = (2 * cp) & 127;
              const int p0 = (tile & 63) * 128;
              const f16_t* ap = PROJ + (size_t)row0 * NPROJ + 2 * cp;
              float s0 = 0.f, s1 = 0.f;
              const int tt0 = 64 * thh;
              for (int j = 1; j <= w; ++j) { if (p0 + tt0 - j >= 0) { const f16x2 hv = *(const f16x2*)(ap + (ptrdiff_t)(tt0 - j) * NPROJ); s0 += (float)hv.x; s1 += (float)hv.y; } }
              for (int tb = 0; tb < 64; tb += 8) {
                  f16x2 cur[8], old[8];
#pragma unroll
                  for (int e = 0; e < 8; ++e) { const int tt = tt0 + tb + e; cur[e] = *(const f16x2*)(ap + (ptrdiff_t)tt * NPROJ);
                      const bool ok = (p0 + tt - w >= 0); old[e] = ok ? *(const f16x2*)(ap + (ptrdiff_t)(tt - w) * NPROJ) : (f16x2){(_Float16)0.f, (_Float16)0.f}; }
#pragma unroll
                  for (int e = 0; e < 8; ++e) { const int tt = tt0 + tb + e; const int pos = p0 + tt + 1;
                      s0 += (float)cur[e].x; s1 += (float)cur[e].y; s0 -= (float)old[e].x; s1 -= (float)old[e].y;
                      const float inv = 1.f / (float)(pos < w ? pos : w);
                      *(LAS unsigned*)(img + (g * 128 + tt) * PITCH + cl * 2) = pk_f16(s0 * inv - (float)cur[e].x, s1 * inv - (float)cur[e].y); }
              } }
            __syncthreads();
            { const int g = wave >> 1, th = wave & 1, t0 = 64 * th;
#pragma unroll 1
              for (int ch = 0; ch < 2; ++ch) {
                  f32x4 acc[4][4];
#pragma unroll
                  for (int m = 0; m < 4; ++m)
#pragma unroll
                      for (int n = 0; n < 4; ++n) acc[m][n] = (f32x4){0.f, 0.f, 0.f, 0.f};
                  const LAS unsigned char* pbase = img + (g * 128 + t0 + fr) * PITCH + 16 * fq;
                  const f16_t* wbase = WpoolT + (size_t)(g * 128 + 64 * ch + fr) * 128 + 8 * fq;
#pragma unroll 1
                  for (int ks = 0; ks < 4; ++ks) {
                      f16x8 pf[4], wf[4];
#pragma unroll
                      for (int m = 0; m < 4; ++m) pf[m] = *(const LAS f16x8*)(pbase + (16 * m) * PITCH + 64 * ks);
#pragma unroll
                      for (int n = 0; n < 4; ++n) wf[n] = *(const f16x8*)(wbase + (16 * n) * 128 + 32 * ks);
#pragma unroll
                      for (int m = 0; m < 4; ++m)
#pragma unroll
                          for (int n = 0; n < 4; ++n) acc[m][n] = __builtin_amdgcn_mfma_f32_16x16x32_f16(wf[n], pf[m], acc[m][n], 0, 0, 0);
                  }
                  const int cb0 = g * 128 + 64 * ch + 4 * fq;
#pragma unroll
                  for (int m = 0; m < 4; ++m) { const int t = t0 + 16 * m + fr; f16_t* op = MIX + (size_t)(row0 + t) * DM + cb0;
#pragma unroll
                      for (int n = 0; n < 4; ++n) { const f32x4 ps = *(const f32x4*)(pool_scale + cb0 + 16 * n);
                          u32x2 o; o.x = pk_f16(acc[m][n][0] * ps.x, acc[m][n][1] * ps.y); o.y = pk_f16(acc[m][n][2] * ps.z, acc[m][n][3] * ps.w);
                          *(u32x2*)(op + 16 * n) = o; } }
              } }
        }
        if (BOTH(3)) GRID_BAR();
    }
#endif

    if (IN(4)) {
        pg8::Gemm g{MIX, WoutT, M, DM, DM}; pg8::StaticOrder S; S.init(M, DM, G, wg);
        pg8::EpiRes E{x, out, mod + 2 * DM, DM};
        pg8::gemm_phase<pg8::EpiRes, pg8::StaticOrder, true, true>(lds, g, S, E);
        if (BOTH(4)) GRID_BAR();
    }

    if (IN(5)) {
        LAS float* A = (LAS float*)lds; LAS float* S = A + DM;
        for (int tile = wg; tile < M / 128; tile += G) {
            const int b = tile >> 6;
            __syncthreads();
            for (int c = tid; c < DM; c += NTHR) { A[c] = g_norm2[c] * (1.f + mod[b * NMOD + 4 * DM + c]); S[c] = mod[b * NMOD + 3 * DM + c]; }
            __syncthreads();
            norm_rows(out, H2, A, S, tile * 128, 128, wave, lane);
        }
        if (BOTH(5)) GRID_BAR();
    }

    if (IN(6)) {
        pg8::Gemm g{H2, WqkT, M, NQK, DM}; pg8::StaticOrder S; S.init(M, NQK, G, wg);
        pg8::EpiF32 E{SC, NQK};
        pg8::gemm_phase<pg8::EpiF32, pg8::StaticOrder, true, true>(lds, g, S, E);
        if (BOTH(6)) GRID_BAR();
    }

    if (IN(7)) {
        LAS float* G2 = (LAS float*)lds; LAS float* GF = G2 + DM;
        LAS unsigned* wl = (LAS unsigned*)(lds + 8192 + wave * 2048);
        LAS unsigned* tk = wl; LAS unsigned* pe_idx = wl + 64; LAS float* pe_gate = (LAS float*)(wl + 192);
        const int l16 = lane & 15, row = lane >> 4, hsel = lane >> 5;
        for (int tile = wg; tile < M / 128; tile += G) {
            const int b = tile >> 6;
            __syncthreads();
            for (int c = tid; c < DM; c += NTHR) { G2[c] = mod[b * NMOD + 5 * DM + c]; GF[c] = g_final[c]; }
            __syncthreads();
            for (int r = wave; r < 128; r += NWAVES) {
                const int tok = tile * 128 + r;
                const float* sc = SC + (size_t)tok * NQK;
                for (int ps = 0; ps < 4; ++ps) {
                    const f32x4 sa = *(const f32x4*)(sc + ps * 512 + lane * 8), sb = *(const f32x4*)(sc + ps * 512 + lane * 8 + 4);
                    unsigned k0 = fkey(sa.x), k1 = fkey(sa.y), k2 = fkey(sa.z), k3 = fkey(sa.w), k4 = fkey(sb.x), k5 = fkey(sb.y), k6 = fkey(sb.z), k7 = fkey(sb.w);
                    const unsigned ib = 127u - (unsigned)(l16 * 8);
                    k0 = (k0 & ~127u) | (ib - 0u); k1 = (k1 & ~127u) | (ib - 1u); k2 = (k2 & ~127u) | (ib - 2u); k3 = (k3 & ~127u) | (ib - 3u);
                    k4 = (k4 & ~127u) | (ib - 4u); k5 = (k5 & ~127u) | (ib - 5u); k6 = (k6 & ~127u) | (ib - 6u); k7 = (k7 & ~127u) | (ib - 7u);
                    CE_DESC(k0, k1); CE_DESC(k2, k3); CE_DESC(k4, k5); CE_DESC(k6, k7);
                    CE_DESC(k0, k2); CE_DESC(k1, k3); CE_DESC(k4, k6); CE_DESC(k5, k7);
                    CE_DESC(k1, k2); CE_DESC(k5, k6);
                    CE_DESC(k0, k4); CE_DESC(k1, k5); CE_DESC(k2, k6); CE_DESC(k3, k7);
                    CE_DESC(k2, k4); CE_DESC(k3, k5);
                    CE_DESC(k1, k2); CE_DESC(k3, k4); CE_DESC(k5, k6);
                    unsigned top = 0u;
#pragma unroll
                    for (int rr = 0; rr < 16; ++rr) {
                        const unsigned m = rowmax16u(k0);
                        top = (l16 == rr) ? m : top;
                        const bool pop = (k0 == m);
                        k0 = pop ? k1 : k0; k1 = pop ? k2 : k1; k2 = pop ? k3 : k2; k3 = pop ? k4 : k3; k4 = pop ? k5 : k4; k5 = pop ? k6 : k5; k6 = pop ? k7 : k6; k7 = pop ? 0u : k7;
                    }
                    tk[lane] = top;
                    __builtin_amdgcn_wave_barrier(); LDS_WAIT();
                    const LAS unsigned* ab = tk + 32 * hsel; const LAS unsigned* bb = ab + 16;
                    const unsigned aik = ab[l16], a0k = ab[0], bik = bb[l16];
                    const u32x4 bq0 = *(const LAS u32x4*)bb, bq1 = *(const LAS u32x4*)(bb + 4);
                    const float vai = fval(aik, 127u), va0 = fval(a0k, 127u), vbi = fval(bik, 127u);
                    const unsigned bk[8] = {bq0.x, bq0.y, bq0.z, bq0.w, bq1.x, bq1.y, bq1.z, bq1.w};
                    unsigned L[8];
#pragma unroll
                    for (int e = 0; e < 8; ++e) { const float sv = vai + fval(bk[e], 127u); const unsigned kk = (fkey(sv) & ~255u) | (255u - (unsigned)(l16 * 16 + e));
                        L[e] = ((l16 + 1) * (e + 1) <= 16) ? kk : 0u; }
                    { const float sv = va0 + vbi; const unsigned kk = (fkey(sv) & ~255u) | (255u - (unsigned)l16); L[1] = (l16 >= 8) ? kk : L[1]; }
                    CE_DESC(L[0], L[1]);
                    unsigned best = 0u;
#pragma unroll
                    for (int rr = 0; rr < 16; ++rr) {
                        const unsigned m = rowmax16u(L[0]);
                        best = (l16 == rr) ? m : best;
                        const bool pop = (L[0] == m);
                        L[0] = pop ? L[1] : L[0]; L[1] = pop ? L[2] : L[1]; L[2] = pop ? L[3] : L[2]; L[3] = pop ? L[4] : L[3]; L[4] = pop ? L[5] : L[4]; L[5] = pop ? L[6] : L[5]; L[6] = pop ? L[7] : L[6]; L[7] = pop ? 0u : L[7];
                    }
                    const unsigned flat = 255u - (best & 255u), ci = flat >> 4, cj = flat & 15u;
                    const unsigned ak = ab[ci], bk2 = bb[cj];
                    const float sval = fval(ak, 127u) + fval(bk2, 127u);
                    const unsigned eidx = (127u - (ak & 127u)) * 128u + (127u - (bk2 & 127u));
                    const float mx = rowmax16f(sval), ex = __expf(sval - mx), sm = rowsum16f(ex), gt = ex / sm;
                    if ((row & 1) == 0) { const int hd = 2 * ps + hsel; pe_idx[hd * 16 + l16] = eidx; pe_gate[hd * 16 + l16] = gt; }
                    __builtin_amdgcn_wave_barrier(); LDS_WAIT();
                }
                const unsigned idxA = pe_idx[lane], idxB = pe_idx[64 + lane];
                const float gA = pe_gate[lane], gB = pe_gate[64 + lane];
                const u32x4 hA = *(const u32x4*)(H2 + (size_t)tok * DM + lane * 8), hB = *(const u32x4*)(H2 + (size_t)tok * DM + 512 + lane * 8);
#if defined(DBG_CHECK)
                { unsigned* DI = (unsigned*)(ws + 400 * MiB); float* DG = (float*)(ws + 416 * MiB); DI[(size_t)tok * 128 + lane] = idxA; DI[(size_t)tok * 128 + 64 + lane] = idxB; DG[(size_t)tok * 128 + lane] = gA; DG[(size_t)tok * 128 + 64 + lane] = gB; }
#endif
                float coefA, coefB;
#pragma unroll 1
                for (int grp = 0; grp < 2; ++grp) {
                    const unsigned idxv = grp ? idxB : idxA;
                    float p[64];
#pragma unroll
                    for (int sub = 0; sub < 8; ++sub) {
                        u32x4 ra[8], rb[8];
#pragma unroll
                        for (int i = 0; i < 8; ++i) { const unsigned e = (unsigned)__builtin_amdgcn_readlane((int)idxv, sub * 8 + i);
                            const f16_t* rp = Ed + (size_t)e * DM; ra[i] = *(const u32x4*)(rp + lane * 8); rb[i] = *(const u32x4*)(rp + 512 + lane * 8); }
#pragma unroll
                        for (int i = 0; i < 8; ++i) { float s = 0.f;
                            s = __builtin_amdgcn_fdot2(as_h2(ra[i].x), as_h2(hA.x), s, false);
                            s = __builtin_amdgcn_fdot2(as_h2(ra[i].y), as_h2(hA.y), s, false);
                            s = __builtin_amdgcn_fdot2(as_h2(ra[i].z), as_h2(hA.z), s, false);
                            s = __builtin_amdgcn_fdot2(as_h2(ra[i].w), as_h2(hA.w), s, false);
                            s = __builtin_amdgcn_fdot2(as_h2(rb[i].x), as_h2(hB.x), s, false);
                            s = __builtin_amdgcn_fdot2(as_h2(rb[i].y), as_h2(hB.y), s, false);
                            s = __builtin_amdgcn_fdot2(as_h2(rb[i].z), as_h2(hB.z), s, false);
                            s = __builtin_amdgcn_fdot2(as_h2(rb[i].w), as_h2(hB.w), s, false);
                            p[sub * 8 + i] = s; }
                    }
#pragma unroll
                    for (int j = 0; j < 32; ++j) { const auto sw = __builtin_amdgcn_permlane32_swap(as_u(p[j]), as_u(p[j + 32]), false, false);
                        p[j] = as_f(sw[0]) + as_f(sw[1]); }
#pragma unroll
                    for (int j = 0; j < 16; ++j) { const auto sw = __builtin_amdgcn_permlane16_swap(as_u(p[j]), as_u(p[j + 16]), false, false);
                        p[j] = as_f(sw[0]) + as_f(sw[1]); }
#pragma unroll
                    for (int j = 0; j < 8; ++j) { const bool up = (lane & 8) != 0; const float keep = up ? p[j + 8] : p[j], send = up ? p[j] : p[j + 8]; p[j] = keep + __shfl_xor(send, 8); }
#pragma unroll
                    for (int j = 0; j < 4; ++j) { const bool up = (lane & 4) != 0; const float keep = up ? p[j + 4] : p[j], send = up ? p[j] : p[j + 4]; p[j] = keep + __shfl_xor(send, 4); }
#pragma unroll
                    for (int j = 0; j < 2; ++j) { const bool up = (lane & 2) != 0; const float keep = up ? p[j + 2] : p[j], send = up ? p[j] : p[j + 2]; p[j] = keep + __shfl_xor(send, 2); }
                    { const bool up = (lane & 1) != 0; const float keep = up ? p[1] : p[0], send = up ? p[0] : p[1]; p[0] = keep + __shfl_xor(send, 1); }
                    const float pre = p[0];
                    const float act = 0.5f * pre * (1.f + erff(pre * 0.70710678118654752f));
                    if (grp) coefB = gB * act; else coefA = gA * act;
                }
#if defined(DBG_CHECK)
                { float* DC = (float*)(ws + 432 * MiB); DC[(size_t)tok * 128 + lane] = coefA; DC[(size_t)tok * 128 + 64 + lane] = coefB; }
#endif
                float acc[16];
#pragma unroll
                for (int j = 0; j < 16; ++j) acc[j] = 0.f;
#pragma unroll 1
                for (int grp = 0; grp < 2; ++grp) {
                    const unsigned idxv = grp ? idxB : idxA; const float cf = grp ? coefB : coefA;
#pragma unroll 1
                    for (int sub = 0; sub < 8; ++sub) {
                        u32x4 ra[8], rb[8];
#pragma unroll
                        for (int i = 0; i < 8; ++i) { const unsigned e = (unsigned)__builtin_amdgcn_readlane((int)idxv, sub * 8 + i);
                            const f16_t* rp = Eu + (size_t)e * DM; ra[i] = *(const u32x4*)(rp + lane * 8); rb[i] = *(const u32x4*)(rp + 512 + lane * 8); }
#pragma unroll
                        for (int i = 0; i < 8; ++i) { const float cs = __builtin_bit_cast(float, __builtin_amdgcn_readlane(__builtin_bit_cast(int, cf), sub * 8 + i));
                            const f16x8 va = __builtin_bit_cast(f16x8, ra[i]), vb = __builtin_bit_cast(f16x8, rb[i]);
#pragma unroll
                            for (int e = 0; e < 8; ++e) { acc[e] = fmaf((float)va[e], cs, acc[e]); acc[8 + e] = fmaf((float)vb[e], cs, acc[8 + e]); } }
                    }
                }
                float* orow = out + (size_t)tok * DM;
                f32x4 xv[4]; xv[0] = *(const f32x4*)(orow + lane * 8); xv[1] = *(const f32x4*)(orow + lane * 8 + 4); xv[2] = *(const f32x4*)(orow + 512 + lane * 8); xv[3] = *(const f32x4*)(orow + 512 + lane * 8 + 4);
                float ss = 0.f;
#pragma unroll
                for (int q = 0; q < 4; ++q) { const int cb = (q >> 1) * 512 + lane * 8 + (q & 1) * 4; const f32x4 g2 = *(const LAS f32x4*)(G2 + cb);
                    xv[q].x += g2.x * acc[4 * q + 0]; xv[q].y += g2.y * acc[4 * q + 1]; xv[q].z += g2.z * acc[4 * q + 2]; xv[q].w += g2.w * acc[4 * q + 3];
                    ss += (xv[q].x * xv[q].x + xv[q].y * xv[q].y) + (xv[q].z * xv[q].z + xv[q].w * xv[q].w); }
                const float rstd = rsqrtf(wave_sum(ss) * (1.f / DM) + EPS);
#pragma unroll
                for (int q = 0; q < 4; ++q) { const int cb = (q >> 1) * 512 + lane * 8 + (q & 1) * 4; const f32x4 gf = *(const LAS f32x4*)(GF + cb);
                    *(f32x4*)(orow + cb) = xv[q] * rstd * gf; }
            }
        }
    }
#undef IN
#undef BOTH
#undef GRID_BAR
}


#if defined(DBG_CHECK)
constexpr size_t WS_FLAGS = 32 * 1024, WS_SNAP = 12 * MiB;
constexpr int NSAMP_TOK = 64;
__device__ __forceinline__ unsigned hash32(unsigned x) { x ^= x >> 16; x *= 0x7feb352du; x ^= x >> 15; x *= 0x846ca68bu; x ^= x >> 16; return x; }
__device__ __forceinline__ void chk(unsigned* flags, int id, float got, float ref, float atol, float rtol) { if (!(fabsf(got - ref) <= atol + rtol * fabsf(ref))) atomicAdd(&flags[id], 1u); }
__device__ __forceinline__ int samp_tok(int j) { return (j < 8) ? j * 4681 % M : (j < 16 ? ((j - 8) & 3) * 8192 + (j & 1) * 127 + (j >> 2 & 1) * 4000 : (int)(hash32(j * 977u + 5u) % M)); }
__global__ void dbg_check(Args args, int which) {
    unsigned char* ws = args.ws; unsigned* flags = (unsigned*)(ws + WS_FLAGS);
    const float* x = args.in[0]; const float* cvec = args.in[1]; const float* w_ada = args.in[2]; const float* b_ada = args.in[3];
    const float* g_norm1 = args.in[4]; const float* w_in = args.in[5]; const float* w_pool = args.in[6]; const float* pool_scale = args.in[7];
    const float* sgu_ln_g = args.in[8]; const float* sgu_ln_b = args.in[9]; const float* w_spatial = args.in[10]; const float* b_spatial = args.in[11];
    const float* w_out = args.in[12]; const float* g_norm2 = args.in[13]; const float* w_query = args.in[14]; const float* sub_keys = args.in[15];
    const float* expert_down = args.in[16]; const float* expert_up = args.in[17]; const float* g_final = args.in[18];
    const float* mod = (const float*)(ws + WS_MOD);
    const _Float16* H1 = (const _Float16*)(ws + WS_H1); const _Float16* PROJ = (const _Float16*)(ws + WS_PROJ); const _Float16* MIX = (const _Float16*)(ws + WS_MIX); const _Float16* H2 = (const _Float16*)(ws + WS_H2);
    const float* SC = (const float*)(ws + WS_SC); float* snap = (float*)(ws + WS_SNAP); const float* out = args.out;
    const unsigned gt = blockIdx.x * blockDim.x + threadIdx.x, NGT = gridDim.x * blockDim.x;
    if (which == 1) {
        for (unsigned i = gt; i < BATCH * NMOD; i += NGT) { const int b = i / NMOD, e = i % NMOD; float s = b_ada[e];
            for (int d = 0; d < DM; ++d) { const float c = cvec[b * DM + d]; s += (c / (1.f + expf(-c))) * w_ada[(size_t)d * NMOD + e]; }
            chk(flags, 1, mod[i], s, 1e-3f, 1e-3f); }
    } else if (which == 2) {
        for (unsigned i = gt; i < 4096 * 16; i += NGT) { const int row = hash32(i >> 4) % M, c0 = (i & 15) * 64, b = row >> 13; float ss = 0.f;
            for (int c = 0; c < DM; ++c) { const float v = x[(size_t)row * DM + c]; ss += v * v; }
            const float rstd = rsqrtf(ss / DM + EPS);
            for (int c = c0; c < c0 + 64; ++c) { const float ref = x[(size_t)row * DM + c] * rstd * g_norm1[c] * (1.f + mod[b * NMOD + DM + c]) + mod[b * NMOD + c];
                chk(flags, 2, (float)H1[(size_t)row * DM + c], ref, 4e-3f, 2e-3f); } }
    } else if (which == 3) {
        for (unsigned i = gt; i < 65536; i += NGT) { const unsigned h = hash32(i * 3u + 1u); const int row = h % M, col = (h >> 15) % NPROJ; float s = 0.f;
            for (int k = 0; k < DM; ++k) s += (float)H1[(size_t)row * DM + k] * w_in[(size_t)k * NPROJ + col];
            chk(flags, 3, (float)PROJ[(size_t)row * NPROJ + col], s, 1e-2f, 5e-3f); }
    } else if (which == 4) {
        for (unsigned i = gt; i < 32768; i += NGT) { const unsigned h = hash32(i * 5u + 2u); const int row = (i < 2048) ? ((i & 7) * 8192 % M + (i >> 3) % 32) : (int)(h % M), col = (h >> 15) % DM, pos = row & 8191; float ref;
            if (col < 512) { const int g = col >> 7, d = col & 127, w = 2 << g; const int cnt = (pos + 1 < w) ? pos + 1 : w; float acc = 0.f;
                for (int c = 0; c < 128; ++c) { float sm = 0.f; for (int j = 0; j < cnt; ++j) sm += (float)PROJ[(size_t)(row - j) * NPROJ + g * 128 + c];
                    acc += (sm / (float)cnt - (float)PROJ[(size_t)row * NPROJ + g * 128 + c]) * w_pool[(g * 128 + c) * 128 + d]; }
                ref = acc * pool_scale[col]; }
            else { const int cc = col - 512, hh = cc >> 7, t = row & 127, r0 = row - t; float acc = 0.f;
                for (int s2 = 0; s2 <= t; ++s2) { float mean = 0.f, var = 0.f; const _Float16* vr = PROJ + (size_t)(r0 + s2) * NPROJ + 1024;
                    for (int k = 0; k < 512; ++k) mean += (float)vr[k]; mean /= 512.f; for (int k = 0; k < 512; ++k) { const float dd = (float)vr[k] - mean; var += dd * dd; }
                    const float vn = ((float)vr[cc] - mean) * rsqrtf(var / 512.f + EPS) * sgu_ln_g[cc] + sgu_ln_b[cc]; acc += w_spatial[(hh * 128 + t) * 128 + s2] * vn; }
                ref = (float)PROJ[(size_t)row * NPROJ + 512 + cc] * (acc + b_spatial[hh * 128 + t]); }
            chk(flags, 4, (float)MIX[(size_t)row * DM + col], ref, 3e-2f, 1e-2f); }
    } else if (which == 5) {
        for (unsigned i = gt; i < 65536; i += NGT) { const unsigned h = hash32(i * 7u + 3u); const int row = h % M, col = (h >> 15) % DM, b = row >> 13; float s = 0.f;
            for (int k = 0; k < DM; ++k) s += (float)MIX[(size_t)row * DM + k] * w_out[(size_t)k * DM + col];
            chk(flags, 5, out[(size_t)row * DM + col], x[(size_t)row * DM + col] + mod[b * NMOD + 2 * DM + col] * s, 2e-2f, 5e-3f); }
    } else if (which == 6) {
        for (unsigned i = gt; i < 4096 * 16; i += NGT) { const int row = hash32((i >> 4) + 777u) % M, c0 = (i & 15) * 64, b = row >> 13; float ss = 0.f;
            for (int c = 0; c < DM; ++c) { const float v = out[(size_t)row * DM + c]; ss += v * v; }
            const float rstd = rsqrtf(ss / DM + EPS);
            for (int c = c0; c < c0 + 64; ++c) { const float ref = out[(size_t)row * DM + c] * rstd * g_norm2[c] * (1.f + mod[b * NMOD + 4 * DM + c]) + mod[b * NMOD + 3 * DM + c];
                chk(flags, 6, (float)H2[(size_t)row * DM + c], ref, 4e-3f, 2e-3f); } }
        for (unsigned i = gt; i < NSAMP_TOK * DM; i += NGT) snap[i] = out[(size_t)samp_tok(i / DM) * DM + (i % DM)];
    } else if (which == 8) {
        const _Float16* Ed = (const _Float16*)(ws + WS_ED); const _Float16* Eu = (const _Float16*)(ws + WS_EU);
        for (unsigned i = gt; i < 262144; i += NGT) { const size_t j = (size_t)(hash32(i * 13u + 6u) % (unsigned)(NEXP * DM));
            chk(flags, 8, (float)Ed[j], expert_down[j], 1e-5f, 1e-3f); chk(flags, 8, (float)Eu[j], expert_up[j], 1e-5f, 1e-3f); }
    } else if (which == 7) {
        for (unsigned i = gt; i < 16384; i += NGT) { const unsigned h = hash32(i * 11u + 4u); const int row = h % M, n = (h >> 15) % NQK, hp = n >> 7, k = n & 127; float s = 0.f;
            for (int d = 0; d < 128; ++d) { float q = 0.f; for (int kk = 0; kk < DM; ++kk) q += (float)H2[(size_t)row * DM + kk] * w_query[(size_t)kk * NQK + hp * 128 + d];
                s += q * sub_keys[(size_t)(hp * 128 + k) * 128 + d]; }
            chk(flags, 7, SC[(size_t)row * NQK + n], s, 2e-2f, 5e-3f); }
    }
}
__global__ void dbg_check_peer(Args args) {
    __shared__ float sc[2048]; __shared__ float stop[16][16]; __shared__ int itop[16][16]; __shared__ float cand[8][256]; __shared__ float gate[128]; __shared__ int eidx[128]; __shared__ float red[256];
    unsigned char* ws = args.ws; unsigned* flags = (unsigned*)(ws + WS_FLAGS);
    const float* expert_down = args.in[16]; const float* expert_up = args.in[17]; const float* g_final = args.in[18];
    const float* mod = (const float*)(ws + WS_MOD); const _Float16* H2 = (const _Float16*)(ws + WS_H2); const float* SC = (const float*)(ws + WS_SC); const float* snap = (const float*)(ws + WS_SNAP);
    const int j = blockIdx.x, tok = samp_tok(j), t = threadIdx.x, b = tok >> 13;
    for (int i = t; i < 2048; i += 256) sc[i] = SC[(size_t)tok * NQK + i];
    __syncthreads();
    if (t < 16) { for (int r = 0; r < 16; ++r) { int bi = 0; float bv = -3e38f; for (int k = 0; k < 128; ++k) { const float v = sc[t * 128 + k]; if (v > bv) { bv = v; bi = k; } } stop[t][r] = bv; itop[t][r] = bi; sc[t * 128 + bi] = -3e38f; } }
    __syncthreads();
    for (int i = t; i < 2048; i += 256) { const int h = i >> 8, a = (i >> 4) & 15, c = i & 15; cand[h][a * 16 + c] = stop[2 * h][a] + stop[2 * h + 1][c]; }
    __syncthreads();
    if (t < 8) { float bv[16]; float mx = -3e38f; for (int r = 0; r < 16; ++r) { int bi = 0; float v0 = -3e38f; for (int k = 0; k < 256; ++k) { const float v = cand[t][k]; if (v > v0) { v0 = v; bi = k; } }
            cand[t][bi] = -3e38f; gate[t * 16 + r] = v0; eidx[t * 16 + r] = itop[2 * t][bi >> 4] * 128 + itop[2 * t + 1][bi & 15]; mx = fmaxf(mx, v0); }
        float sm = 0.f; for (int r = 0; r < 16; ++r) { const float e = expf(gate[t * 16 + r] - mx); gate[t * 16 + r] = e; sm += e; } for (int r = 0; r < 16; ++r) gate[t * 16 + r] /= sm; }
    __syncthreads();
    const unsigned* DI = (const unsigned*)(ws + 400 * MiB); const float* DG = (const float*)(ws + 416 * MiB); const float* DC = (const float*)(ws + 432 * MiB);
    __shared__ int fidx[128]; __shared__ float fcoef[128];
    if (t < 128) { const int h = t >> 4; const unsigned fi = DI[(size_t)tok * 128 + t]; const float fg = DG[(size_t)tok * 128 + t]; int found = -1;
        for (int r = 0; r < 16; ++r) if (eidx[h * 16 + r] == (int)fi) found = r;
        if (found < 0 || fi >= (unsigned)NEXP) atomicAdd(&flags[10], 1u); else chk(flags, 11, fg, gate[h * 16 + found], 2e-3f, 1e-2f);
        const unsigned fic = fi < (unsigned)NEXP ? fi : 0u; fidx[t] = (int)fic;
        float s = 0.f; const float* ur = expert_down + (size_t)fic * DM; for (int d = 0; d < DM; ++d) s += ur[d] * (float)H2[(size_t)tok * DM + d];
        const float cref = fg * 0.5f * s * (1.f + erff(s * 0.70710678f)); const float fc = DC[(size_t)tok * 128 + t];
        chk(flags, 12, fc, cref, 2e-3f, 1e-2f); fcoef[t] = fc; }
    __syncthreads();
    float x2[4]; float ss = 0.f;
    for (int q = 0; q < 4; ++q) { const int c = t + 256 * q; float o = 0.f; for (int k = 0; k < 128; ++k) o += fcoef[k] * expert_up[(size_t)fidx[k] * DM + c];
        x2[q] = snap[(size_t)j * DM + c] + mod[b * NMOD + 5 * DM + c] * o; ss += x2[q] * x2[q]; }
    red[t] = ss; __syncthreads();
    for (int o = 128; o > 0; o >>= 1) { if (t < o) red[t] += red[t + o]; __syncthreads(); }
    const float rstd = rsqrtf(red[0] / DM + EPS);
    for (int q = 0; q < 4; ++q) { const int c = t + 256 * q; chk(flags, 13, args.out[(size_t)tok * DM + c], x2[q] * rstd * g_final[c], 2e-2f, 1e-2f); }
}
__global__ void dbg_report(Args args) {
    const unsigned* flags = (const unsigned*)(args.ws + WS_FLAGS); int id = 0;
    for (int k = 1; k < 16; ++k) if (flags[k] > ((k == 10 || k == 11) ? 40u : 0u) && !id) id = k;
    if (!id) return; float f = 1.f + 2.f * id; if (id >= 10) { const float fr = (float)flags[id] / 8192.f; f = 1.f + (float)id + 0.9f * (fr > 1.f ? 1.f : fr); }
    for (size_t i = (size_t)blockIdx.x * blockDim.x + threadIdx.x; i < (size_t)M * DM; i += (size_t)gridDim.x * blockDim.x) args.out[i] *= f;
}
#endif
extern "C" void kernel_launch(void* const* d_in, const int* in_sizes, int n_in, void* d_out, int out_size, void* d_ws, size_t ws_size, hipStream_t stream) {
    static int grid = 0;
    if (grid == 0) {
        if (n_in != 19 || out_size != M * DM || ws_size < WS_END) { fprintf(stderr, "kernel_launch: unexpected shapes (n_in %d out %d ws %zu)\n", n_in, out_size, ws_size); grid = -1; return; }
        int dev = 0, cus = 0, per_cu = 0;
        if (hipGetDevice(&dev) != hipSuccess || hipDeviceGetAttribute(&cus, hipDeviceAttributeMultiprocessorCount, dev) != hipSuccess) { grid = -1; return; }
        if (hipFuncSetAttribute((const void*)fwd_kernel, hipFuncAttributeMaxDynamicSharedMemorySize, LDS_BYTES) != hipSuccess) { fprintf(stderr, "kernel_launch: hipFuncSetAttribute failed\n"); grid = -1; return; }
        if (hipOccupancyMaxActiveBlocksPerMultiprocessor(&per_cu, (const void*)fwd_kernel, NTHR, LDS_BYTES) != hipSuccess || per_cu < 1) { fprintf(stderr, "kernel_launch: occupancy query says %d\n", per_cu); }
        (void)hipGetLastError();
        grid = cus;
    }
    if (grid < 0) return;
    (void)hipMemsetAsync((char*)d_ws + WS_CTL, 0, CTL_ZERO_BYTES, stream);
    Args a{};
    for (int i = 0; i < 19; ++i) a.in[i] = (const float*)d_in[i];
    a.out = (float*)d_out; a.ws = (unsigned char*)d_ws;
    if (N_LAUNCHES == 1) {
        a.ph_lo = 0; a.ph_hi = N_PHASES;
        void* kargs[] = {&a};
        hipError_t e = hipLaunchCooperativeKernel((const void*)fwd_kernel, dim3(grid), dim3(NTHR), kargs, LDS_BYTES, stream);
        if (e != hipSuccess) fprintf(stderr, "kernel_launch: cooperative launch failed: %s (grid %d)\n", hipGetErrorString(e), grid);
    } else {
        for (int p = 0; p < N_PHASES; ++p) { a.ph_lo = p; a.ph_hi = p + 1; hipLaunchKernelGGL(fwd_kernel, dim3(grid), dim3(NTHR), LDS_BYTES, stream, a);
#if defined(DBG_CHECK)
            if (p >= 1 && p <= 6) hipLaunchKernelGGL(dbg_check, dim3(1024), dim3(256), 0, stream, a, p);
            if (p == 0) hipLaunchKernelGGL(dbg_check, dim3(1024), dim3(256), 0, stream, a, 8);
            if (p == 6) hipLaunchKernelGGL(dbg_check, dim3(1024), dim3(256), 0, stream, a, 7);
            if (p == 7) { hipLaunchKernelGGL(dbg_check_peer, dim3(NSAMP_TOK), dim3(256), 0, stream, a); hipLaunchKernelGGL(dbg_report, dim3(1024), dim3(256), 0, stream, a); }
#endif
        }
    }
}
```

```cpp
#include <hip/hip_runtime.h>
#include <cstdio>
#include <cstdint>

#ifndef MK_N_LAUNCHES
#define MK_N_LAUNCHES 1
#endif

#define LAS __attribute__((address_space(3)))
#define GAS __attribute__((address_space(1)))
typedef unsigned short f16_t;
typedef _Float16 f16x8 __attribute__((ext_vector_type(8)));
typedef _Float16 f16x4 __attribute__((ext_vector_type(4)));
typedef _Float16 f16x2 __attribute__((ext_vector_type(2)));
typedef float f32x4 __attribute__((ext_vector_type(4)));
typedef unsigned u32x4 __attribute__((ext_vector_type(4)));
typedef unsigned u32x2 __attribute__((ext_vector_type(2)));

__device__ __forceinline__ f16x2 as_h2(unsigned u) { return __builtin_bit_cast(f16x2, u); }
__device__ __forceinline__ float as_f(unsigned u) { return __builtin_bit_cast(float, u); }
__device__ __forceinline__ unsigned as_u(float f) { return __builtin_bit_cast(unsigned, f); }
__device__ __forceinline__ unsigned pk_f16(float lo, float hi) { f16x2 v = {(_Float16)lo, (_Float16)hi}; return __builtin_bit_cast(unsigned, v); }

namespace pg8 {
constexpr int BM = 256, BK = 64, HALF = 128, HTB = HALF * BK * 2, STAGE_BYTES = 8 * HTB, NXCD = 8, WGM = 8;
__host__ __device__ __forceinline__ int lds_byte(int r, int c) { const int st = (r >> 4) * 2 + (c >> 5), rr = r & 15, cc = c & 31, ob = rr * 64 + cc * 2; return st * 1024 + (ob ^ (((ob >> 9) & 1) << 5)); }
__host__ __device__ __forceinline__ void stage_rc(int b, int& R, int& C) { const int st = b / 1024, sb = b % 1024, swz = sb ^ (((sb >> 9) & 1) << 5); R = (st >> 1) * 16 + swz / 64; C = (st & 1) * 32 + (swz % 64) / 2; }
__host__ __device__ __forceinline__ int perm32(int rho) { const int n = rho >> 4, i = rho & 15; return 8 * (i >> 2) + 4 * n + (i & 3); }
struct Unit { int pm, pn; };
struct Gemm { const f16_t* A; const f16_t* Bt; int M, N, K; };
struct StaticOrder {
    int nM, nN, nwg, G, c;
    __host__ __device__ void init(int M, int N, int G_, int c_) { nM = M / BM; nN = N / BM; nwg = nM * nN; G = G_; c = c_; }
    __host__ __device__ bool next(int i, Unit& u) const {
        const long L = (long)i * G + c; if (L >= nwg) return false;
        int wgid = (int)L; { const int q = nwg / NXCD, r = nwg % NXCD, xcd = wgid % NXCD, off = wgid / NXCD; wgid = (xcd < r ? xcd * (q + 1) : r * (q + 1) + (xcd - r) * q) + off; }
        const int nig = WGM * nN, gid = wgid / nig, fm = gid * WGM, gsz = (nM - fm) < WGM ? (nM - fm) : WGM;
        u.pm = fm + ((wgid % nig) % gsz); u.pn = (wgid % nig) / gsz; return true;
    }
    __device__ __forceinline__ void a_ready(const Unit&) const {}
    __device__ __forceinline__ void done(const Unit&) const {}
};
struct EpiF16 {
    static constexpr bool PERM = true, AFTER_DRAIN = false;
    f16_t* O; int ldc;
    __device__ __forceinline__ void operator()(const f32x4 (&acc)[2][2][4][2], const Unit& u, int wr, int wc, int fr, int fq) const {
        const int row0 = u.pm * BM + wr * 64 + fr, col0 = u.pn * BM + wc * 32 + 8 * fq;
#pragma unroll
        for (int ai = 0; ai < 2; ++ai)
#pragma unroll
            for (int m = 0; m < 4; ++m) { f16_t* rowp = O + (size_t)(row0 + ai * HALF + m * 16) * ldc + col0;
#pragma unroll
                for (int bj = 0; bj < 2; ++bj) { const f32x4 v0 = acc[ai][bj][m][0], v1 = acc[ai][bj][m][1];
                    u32x4 w; w.x = pk_f16(v0[0], v0[1]); w.y = pk_f16(v0[2], v0[3]); w.z = pk_f16(v1[0], v1[1]); w.w = pk_f16(v1[2], v1[3]);
                    *(u32x4*)(rowp + bj * HALF) = w; } }
    }
};
struct EpiF32 {
    static constexpr bool PERM = false, AFTER_DRAIN = false;
    float* C; int ldc;
    __device__ __forceinline__ void operator()(const f32x4 (&acc)[2][2][4][2], const Unit& u, int wr, int wc, int fr, int fq) const {
        const int row0 = u.pm * BM + wr * 64 + fr, col0 = u.pn * BM + wc * 32 + 4 * fq;
#pragma unroll
        for (int ai = 0; ai < 2; ++ai)
#pragma unroll
            for (int m = 0; m < 4; ++m) { float* rowp = C + (size_t)(row0 + ai * HALF + m * 16) * ldc + col0;
#pragma unroll
                for (int bj = 0; bj < 2; ++bj)
#pragma unroll
                    for (int n = 0; n < 2; ++n) *(f32x4*)(rowp + bj * HALF + n * 16) = acc[ai][bj][m][n]; }
    }
};
struct EpiRes {
    static constexpr bool PERM = false, AFTER_DRAIN = false;
    const float* X; float* O; const float* gate; int ldc;
    __device__ __forceinline__ void operator()(const f32x4 (&acc)[2][2][4][2], const Unit& u, int wr, int wc, int fr, int fq) const {
        const int row0 = u.pm * BM + wr * 64 + fr, col0 = u.pn * BM + wc * 32 + 4 * fq;
        const float* g = gate + (size_t)((u.pm * BM) >> 13) * 6144;
        f32x4 gv[2][2];
#pragma unroll
        for (int bj = 0; bj < 2; ++bj)
#pragma unroll
            for (int n = 0; n < 2; ++n) gv[bj][n] = *(const f32x4*)(g + col0 + bj * HALF + n * 16);
#pragma unroll
        for (int ai = 0; ai < 2; ++ai)
#pragma unroll
            for (int m = 0; m < 4; ++m) { const size_t off = (size_t)(row0 + ai * HALF + m * 16) * ldc + col0;
#pragma unroll
                for (int bj = 0; bj < 2; ++bj)
#pragma unroll
                    for (int n = 0; n < 2; ++n) { const f32x4 xv = *(const f32x4*)(X + off + bj * HALF + n * 16); *(f32x4*)(O + off + bj * HALF + n * 16) = xv + gv[bj][n] * acc[ai][bj][m][n]; }
                if (m & 1) asm volatile("" ::: "memory"); }
    }
};

template <class Epi, class Sched, bool ALIGN_EPI = false, bool SP2 = false>
__device__ __forceinline__ void gemm_phase(LAS unsigned char* lds, const Gemm g, const Sched& S, const Epi& E) {
    const int tid = threadIdx.x, wid = __builtin_amdgcn_readfirstlane(tid >> 6), lane = tid & 63, wr = wid >> 2, wc = wid & 3, fr = lane & 15, fq = lane >> 4;
    const int K = g.K, nt = K / BK;
    unsigned voffA[2], voffB[2];
#pragma unroll
    for (int i = 0; i < 2; ++i) { int R, C; stage_rc(tid * 16 + i * 8192, R, C); const int Rb = Epi::PERM ? ((R & ~31) + perm32(R & 31)) : R;
        voffA[i] = (unsigned)(R * K + C) * 2u; voffB[i] = (unsigned)(Rb * K + C) * 2u; }
    const size_t kstep = (size_t)(BK * 2);
    const size_t hstep = (size_t)HALF * K * 2;
    const size_t tstep = 2 * hstep;
    const unsigned ldsw = (unsigned)wid * 1024u;
    const int aoff = lds_byte(wr * 64 + fr, fq * 8), boff = lds_byte(wc * 32 + fr, fq * 8);
#define PG8_SA(b, h) (((b) * 2 + (h)) * HTB)
#define PG8_SB(b, h) ((4 + (b) * 2 + (h)) * HTB)
#define PG8_STAGE(bufoff, gbase, voff) do { _Pragma("unroll") for (int _i = 0; _i < 2; ++_i) \
        __builtin_amdgcn_global_load_lds((const unsigned*)((const char*)(gbase) + (voff)[_i]), (LAS unsigned*)(lds + (bufoff) + ldsw + _i * 8192), 16, 0, 0); } while (0)
#define PG8_LDA(dst, b, h) do { _Pragma("unroll") for (int m = 0; m < 4; ++m) _Pragma("unroll") for (int k = 0; k < 2; ++k) dst[m][k] = *(const LAS f16x8*)(lds + PG8_SA(b, h) + aoff + m * 2048 + k * 1024); } while (0)
#define PG8_LDB(dst, b, h) do { _Pragma("unroll") for (int n = 0; n < 2; ++n) _Pragma("unroll") for (int k = 0; k < 2; ++k) dst[n][k] = *(const LAS f16x8*)(lds + PG8_SB(b, h) + boff + n * 2048 + k * 1024); } while (0)
#define PG8_MMA(ai, bj, At, Bt) do { __builtin_amdgcn_s_setprio(1); _Pragma("unroll") for (int m = 0; m < 4; ++m) _Pragma("unroll") for (int n = 0; n < 2; ++n) _Pragma("unroll") for (int k = 0; k < 2; ++k) \
        acc[ai][bj][m][n] = __builtin_amdgcn_mfma_f32_16x16x32_f16(Bt[n][k], At[m][k], acc[ai][bj][m][n], 0, 0, 0); __builtin_amdgcn_s_setprio(0); } while (0)
#define PG8_WAIT_V(n) asm volatile("s_waitcnt vmcnt(" #n ")" ::: "memory")
#define PG8_WAIT_L(n) asm volatile("s_waitcnt lgkmcnt(" #n ")" ::: "memory")
#define PG8_BAR __builtin_amdgcn_s_barrier()
#define PG8_SCHED __builtin_amdgcn_sched_barrier(0)
    Unit cur, nxt; int ui = 0;
    if (!S.next(0, cur)) return;
    f32x4 acc[2][2][4][2];
#pragma unroll
    for (int a = 0; a < 2; ++a)
#pragma unroll
        for (int b = 0; b < 2; ++b)
#pragma unroll
            for (int m = 0; m < 4; ++m)
#pragma unroll
                for (int n = 0; n < 2; ++n) acc[a][b][m][n] = (f32x4){0.f, 0.f, 0.f, 0.f};
    f16x8 At[4][2], B0[2][2], B1[2][2];
    const char* cA = (const char*)g.A + (size_t)cur.pm * tstep; const char* cB = (const char*)g.Bt + (size_t)cur.pn * tstep;
    S.a_ready(cur);
    if constexpr (SP2) {
        PG8_STAGE(PG8_SB(0, 0), cB, voffB); PG8_STAGE(PG8_SB(0, 1), cB + hstep, voffB); PG8_STAGE(PG8_SA(0, 0), cA, voffA); PG8_STAGE(PG8_SA(0, 1), cA + hstep, voffA);
        if (wr == 1) PG8_BAR;
        PG8_WAIT_V(2); PG8_BAR;
        PG8_STAGE(PG8_SB(1, 0), cB + kstep, voffB); PG8_STAGE(PG8_SA(1, 0), cA + kstep, voffA); PG8_STAGE(PG8_SB(1, 1), cB + hstep + kstep, voffB);
        PG8_WAIT_V(6); PG8_BAR;
    } else {
        PG8_STAGE(PG8_SB(0, 0), cB, voffB); PG8_STAGE(PG8_SA(0, 0), cA, voffA); PG8_STAGE(PG8_SB(0, 1), cB + hstep, voffB); PG8_STAGE(PG8_SA(0, 1), cA + hstep, voffA);
        if (wr == 1) PG8_BAR;
        PG8_WAIT_V(4); PG8_BAR;
        PG8_STAGE(PG8_SB(1, 0), cB + kstep, voffB); PG8_STAGE(PG8_SA(1, 0), cA + kstep, voffA); PG8_STAGE(PG8_SB(1, 1), cB + hstep + kstep, voffB);
        PG8_WAIT_V(6); PG8_BAR;
    }
    for (;;) {
        const bool has_next = S.next(ui + 1, nxt);
        const char* nA = has_next ? (const char*)g.A + (size_t)nxt.pm * tstep : cA; const char* nB = has_next ? (const char*)g.Bt + (size_t)nxt.pn * tstep : cB;
        for (int t = 0; t < nt; t += 2) {
            const bool last = (t == nt - 2);
            const char* a1 = cA + (size_t)(t + 1) * kstep;
            const char* a2 = last ? nA : cA + (size_t)(t + 2) * kstep; const char* b2 = last ? nB : cB + (size_t)(t + 2) * kstep;
            const char* a3 = a2 + kstep; const char* b3 = b2 + kstep;
            if (last && has_next) S.a_ready(nxt);
            if constexpr (SP2) {
            PG8_LDB(B0, 0, 0); PG8_LDB(B1, 0, 1); PG8_SCHED; PG8_LDA(At, 0, 0); PG8_STAGE(PG8_SA(1, 1), a1 + hstep, voffA);
            PG8_WAIT_V(8); PG8_WAIT_L(0); PG8_BAR; PG8_MMA(0, 0, At, B0); PG8_MMA(0, 1, At, B1); PG8_BAR; PG8_SCHED;
            PG8_LDA(At, 0, 1); PG8_STAGE(PG8_SB(0, 0), b2, voffB); PG8_STAGE(PG8_SB(0, 1), b2 + hstep, voffB); PG8_STAGE(PG8_SA(0, 0), a2, voffA);
            PG8_WAIT_V(8); PG8_WAIT_L(0); PG8_BAR; PG8_MMA(1, 0, At, B0); PG8_MMA(1, 1, At, B1); PG8_BAR; PG8_SCHED;
            PG8_LDB(B0, 1, 0); PG8_LDB(B1, 1, 1); PG8_SCHED; PG8_LDA(At, 1, 0); PG8_STAGE(PG8_SA(0, 1), a2 + hstep, voffA);
            PG8_WAIT_V(8); PG8_WAIT_L(0); PG8_BAR; PG8_MMA(0, 0, At, B0); PG8_MMA(0, 1, At, B1); PG8_BAR; PG8_SCHED;
            PG8_LDA(At, 1, 1); PG8_STAGE(PG8_SB(1, 0), b3, voffB); PG8_STAGE(PG8_SB(1, 1), b3 + hstep, voffB); PG8_STAGE(PG8_SA(1, 0), a3, voffA);
            PG8_WAIT_V(8); PG8_WAIT_L(0); PG8_BAR; PG8_MMA(1, 0, At, B0); PG8_MMA(1, 1, At, B1); PG8_BAR; PG8_SCHED;
            } else {
            PG8_LDB(B0, 0, 0); PG8_SCHED; PG8_LDA(At, 0, 0); PG8_STAGE(PG8_SA(1, 1), a1 + hstep, voffA);
            PG8_WAIT_L(8); PG8_BAR; PG8_WAIT_L(0); PG8_MMA(0, 0, At, B0); PG8_BAR; PG8_SCHED;
            PG8_LDB(B1, 0, 1); PG8_STAGE(PG8_SB(0, 0), b2, voffB);
            PG8_BAR; PG8_WAIT_L(0); PG8_MMA(0, 1, At, B1); PG8_BAR;
            PG8_LDA(At, 0, 1); PG8_STAGE(PG8_SA(0, 0), a2, voffA);
            PG8_BAR; PG8_WAIT_L(0); PG8_MMA(1, 0, At, B0); PG8_BAR; PG8_SCHED;
            PG8_STAGE(PG8_SB(0, 1), b2 + hstep, voffB);
            PG8_WAIT_V(6); PG8_BAR; PG8_MMA(1, 1, At, B1); PG8_BAR;
            PG8_LDB(B0, 1, 0); PG8_SCHED; PG8_LDA(At, 1, 0); PG8_STAGE(PG8_SA(0, 1), a2 + hstep, voffA);
            PG8_WAIT_L(8); PG8_BAR; PG8_WAIT_L(0); PG8_MMA(0, 0, At, B0); PG8_BAR; PG8_SCHED;
            PG8_LDB(B1, 1, 1); PG8_STAGE(PG8_SB(1, 0), b3, voffB);
            PG8_BAR; PG8_WAIT_L(0); PG8_MMA(0, 1, At, B1); PG8_BAR;
            PG8_LDA(At, 1, 1); PG8_STAGE(PG8_SA(1, 0), a3, voffA);
            PG8_BAR; PG8_WAIT_L(0); PG8_MMA(1, 0, At, B0); PG8_BAR; PG8_SCHED;
            PG8_STAGE(PG8_SB(1, 1), b3 + hstep, voffB);
            PG8_WAIT_V(6); PG8_BAR; PG8_MMA(1, 1, At, B1); PG8_BAR;
            }
        }
        if constexpr (ALIGN_EPI) { if (wr == 0) PG8_BAR; }
        if constexpr (!Epi::AFTER_DRAIN) { E(acc, cur, wr, wc, fr, fq); S.done(cur); }
        if (!has_next) break;
#pragma unroll
        for (int a = 0; a < 2; ++a)
#pragma unroll
            for (int b = 0; b < 2; ++b)
#pragma unroll
                for (int m = 0; m < 4; ++m)
#pragma unroll
                    for (int n = 0; n < 2; ++n) acc[a][b][m][n] = (f32x4){0.f, 0.f, 0.f, 0.f};
        cur = nxt; cA = nA; cB = nB; ++ui;
        if constexpr (ALIGN_EPI) { if (wr == 1) PG8_BAR; }
    }
    PG8_WAIT_V(0);
    if constexpr (!ALIGN_EPI) { if (wr == 0) PG8_BAR; }
    PG8_BAR;
#undef PG8_SA
#undef PG8_SB
#undef PG8_STAGE
#undef PG8_LDA
#undef PG8_LDB
#undef PG8_MMA
#undef PG8_WAIT_V
#undef PG8_WAIT_L
#undef PG8_BAR
#undef PG8_SCHED
}
}

constexpr int NWAVES = 8, NTHR = NWAVES * 64;
constexpr int N_LAUNCHES = MK_N_LAUNCHES, N_PHASES = 8;
constexpr int BATCH = 4, SEQ = 8192, DM = 1024, M = BATCH * SEQ;
constexpr int NPROJ = 1536, NQK = 2048, NEXP = 16384, NMOD = 6 * DM;
constexpr float EPS = 1e-6f;

constexpr size_t MiB = 1u << 20;
constexpr size_t WS_CTL = 0, CTL_ZERO_BYTES = 64 * 1024;
constexpr size_t WS_MOD = 256 * 1024;
constexpr size_t WS_MODP = 1 * MiB;
constexpr size_t WS_WIN = 2 * MiB;
constexpr size_t WS_WOUT = 5 * MiB;
constexpr size_t WS_WQK = 7 * MiB;
constexpr size_t WS_WPOOL = 11 * MiB;
constexpr size_t WS_WSP = 11 * MiB + 256 * 1024;
constexpr size_t WS_ED = 16 * MiB, WS_EU = 32 * MiB;
constexpr size_t WS_EDS = 13 * MiB, WS_EUS = 13 * MiB + 65536;
constexpr size_t WS_H2 = 80 * MiB;
constexpr size_t WS_SC = 144 * MiB;
constexpr size_t WS_H1 = 144 * MiB, WS_PROJ = 208 * MiB, WS_MIX = 304 * MiB;
constexpr size_t WS_END = 400 * MiB;
constexpr int CW_BAR = 1024;

constexpr int RING_BYTES = 131072;
constexpr int MISC_OFF = 160 * 1024 - 256;
constexpr int LDS_BYTES = 160 * 1024;

#define RLX_AGENT __ATOMIC_RELAXED, __HIP_MEMORY_SCOPE_AGENT
#define LDS_WAIT() asm volatile("s_waitcnt lgkmcnt(0)" ::: "memory")
#define VM_WAIT() asm volatile("s_waitcnt vmcnt(0)" ::: "memory")

#define XB_TMO      128
#define XB_XCNT(j)  (256  + 64 * (j))
#define XB_XSUB(j)  (1280 + 64 * (j))
#define XB_XGEN(j)  (2304 + 64 * (j))
#define XB_TOP      3328
#define XB_TOPGEN   3392
#define XCD_BAR_WORDS 3456
#define XB_SPIN_CAP (1u << 22)
__device__ __forceinline__ unsigned xb_ld(unsigned* p)              { return __hip_atomic_load(p, __ATOMIC_RELAXED, __HIP_MEMORY_SCOPE_AGENT); }
__device__ __forceinline__ unsigned xb_add(unsigned* p, unsigned v) { return __hip_atomic_fetch_add(p, v, __ATOMIC_RELAXED, __HIP_MEMORY_SCOPE_AGENT); }
__device__ __forceinline__ unsigned xb_xcc_id() { return (unsigned)__builtin_amdgcn_s_getreg((3 << 11) | 20) & 0xFu; }
#define XB_SPIN(cond, bar) do { unsigned _sp = 0; while (cond) { __builtin_amdgcn_s_sleep(1); \
    if ((++_sp & 255u) == 0u) { if (xb_ld(&(bar)[XB_TMO])) break; if (_sp > XB_SPIN_CAP) { atomicAdd(&(bar)[XB_TMO], 1u); break; } } } } while (0)
struct XcdBarrier { unsigned* bar; unsigned x; volatile LAS unsigned* st; };
__device__ __forceinline__ XcdBarrier xcd_barrier_post(unsigned* bar, volatile LAS unsigned* st) {
    XcdBarrier b; b.bar = bar; b.x = xb_xcc_id(); b.st = st;
    if (threadIdx.x == 0) (void)xb_add(&bar[XB_XCNT(b.x)], 1u);
    return b;
}
__device__ __forceinline__ void xcd_barrier_complete(unsigned* bar, unsigned x, unsigned& nloc, unsigned& nx) {
    const unsigned G = gridDim.x * gridDim.y * gridDim.z;
    unsigned sum, cnt, mine, sp = 0u;
    for (;;) {
        sum = 0u; cnt = 0u; mine = 0u;
#pragma unroll
        for (unsigned j = 0; j < 16; ++j) { const unsigned c = xb_ld(&bar[XB_XCNT(j)]); sum += c; cnt += (c > 0u) ? 1u : 0u; mine = (j == x) ? c : mine; }
        if (sum == G) break;
        __builtin_amdgcn_s_sleep(1);
        if ((++sp & 255u) == 0u) { if (xb_ld(&bar[XB_TMO])) break; if (sp > XB_SPIN_CAP) { atomicAdd(&bar[XB_TMO], 1u); break; } }
    }
    nloc = mine > 0u ? mine : 1u; nx = cnt > 0u ? cnt : 1u;
}
__device__ __forceinline__ void xcd_barrier(const XcdBarrier& b) {
    asm volatile("s_waitcnt vmcnt(0)" ::: "memory");
    __syncthreads();
    if (threadIdx.x == 0) {
        unsigned* bar = b.bar;
        __builtin_amdgcn_s_waitcnt(0);
        unsigned nloc = b.st[0], nx = b.st[1];
        if (nloc == 0u) { xcd_barrier_complete(bar, b.x, nloc, nx); b.st[0] = nloc; b.st[1] = nx; }
        const unsigned old = xb_add(&bar[XB_XSUB(b.x)], 1u);
        const unsigned gen = old / nloc;
        if (old + 1u == (gen + 1u) * nloc) {
            __builtin_amdgcn_fence(__ATOMIC_RELEASE, "agent");
            asm volatile("s_waitcnt vmcnt(0)" ::: "memory");
            const unsigned og = xb_add(&bar[XB_TOP], 1u);
            const unsigned tg = og / nx;
            if (og + 1u == (tg + 1u) * nx) xb_add(&bar[XB_TOPGEN], 1u);
            else XB_SPIN(xb_ld(&bar[XB_TOPGEN]) == tg, bar);
            __builtin_amdgcn_fence(__ATOMIC_ACQUIRE, "agent");
            xb_add(&bar[XB_XGEN(b.x)], 1u);
            asm volatile("s_waitcnt vmcnt(0)" ::: "memory");
        } else {
            XB_SPIN(xb_ld(&bar[XB_XGEN(b.x)]) == gen, bar);
            __builtin_amdgcn_fence(__ATOMIC_ACQUIRE, "agent");
            asm volatile("s_waitcnt vmcnt(0)" ::: "memory");
        }
    }
    __syncthreads();
}

__device__ __forceinline__ float wave_sum(float v) {
#pragma unroll
    for (int o = 1; o < 64; o <<= 1) v += __shfl_xor(v, o);
    return v;
}
template <int CTRL> __device__ __forceinline__ unsigned dppu(unsigned x) { return (unsigned)__builtin_amdgcn_update_dpp((int)x, (int)x, CTRL, 0xF, 0xF, false); }
template <int CTRL> __device__ __forceinline__ float dppf(float x) { return __builtin_bit_cast(float, __builtin_amdgcn_update_dpp(__builtin_bit_cast(int, x), __builtin_bit_cast(int, x), CTRL, 0xF, 0xF, false)); }
__device__ __forceinline__ unsigned umax_(unsigned a, unsigned b) { return a > b ? a : b; }
__device__ __forceinline__ unsigned umin_(unsigned a, unsigned b) { return a < b ? a : b; }
__device__ __forceinline__ unsigned rowmax16u(unsigned x) {
    x = umax_(x, dppu<0xB1>(x)); x = umax_(x, dppu<0x4E>(x)); x = umax_(x, dppu<0x141>(x)); x = umax_(x, dppu<0x140>(x)); return x; }
__device__ __forceinline__ float rowmax16f(float x) {
    x = fmaxf(x, dppf<0xB1>(x)); x = fmaxf(x, dppf<0x4E>(x)); x = fmaxf(x, dppf<0x141>(x)); x = fmaxf(x, dppf<0x140>(x)); return x; }
__device__ __forceinline__ float rowsum16f(float x) {
    x += dppf<0xB1>(x); x += dppf<0x4E>(x); x += dppf<0x141>(x); x += dppf<0x140>(x); return x; }
__device__ __forceinline__ unsigned fkey(float f) { const unsigned u = __builtin_bit_cast(unsigned, f); return (u & 0x80000000u) ? ~u : (u | 0x80000000u); }
__device__ __forceinline__ float fval(unsigned k, unsigned lowmask) {
    unsigned u = (k & 0x80000000u) ? (k & 0x7fffffffu) : ~k; u &= ~lowmask; return __builtin_bit_cast(float, u); }
#define CE_DESC(a, b) do { const unsigned _hi = umax_(a, b), _lo = umin_(a, b); a = _hi; b = _lo; } while (0)

__device__ __forceinline__ float wave_max(float v) {
    v = fmaxf(v, dppf<0xB1>(v)); v = fmaxf(v, dppf<0x4E>(v)); v = fmaxf(v, dppf<0x141>(v)); v = fmaxf(v, dppf<0x140>(v));
    { const auto a = __builtin_amdgcn_permlane16_swap(as_u(v), as_u(v), false, false); v = fmaxf(as_f(a[0]), as_f(a[1])); }
    { const auto a = __builtin_amdgcn_permlane32_swap(as_u(v), as_u(v), false, false); v = fmaxf(as_f(a[0]), as_f(a[1])); }
    return v;
}
__device__ __forceinline__ float wave_total(float v) {
    v += dppf<0xB1>(v); v += dppf<0x4E>(v); v += dppf<0x141>(v); v += dppf<0x140>(v);
    { const auto a = __builtin_amdgcn_permlane16_swap(as_u(v), as_u(v), false, false); v = as_f(a[0]) + as_f(a[1]); }
    { const auto a = __builtin_amdgcn_permlane32_swap(as_u(v), as_u(v), false, false); v = as_f(a[0]) + as_f(a[1]); }
    return v;
}

__device__ __forceinline__ void topk_token(const float* sc, LAS unsigned* tk, LAS unsigned* pe_idx, LAS float* pe_gate, int lane) {
    const int l16 = lane & 15, row = lane >> 4, hsel = lane >> 5;
    for (int ps = 0; ps < 4; ++ps) {
        const f32x4 sa = *(const f32x4*)(sc + ps * 512 + lane * 8), sb = *(const f32x4*)(sc + ps * 512 + lane * 8 + 4);
        unsigned k0 = fkey(sa.x), k1 = fkey(sa.y), k2 = fkey(sa.z), k3 = fkey(sa.w), k4 = fkey(sb.x), k5 = fkey(sb.y), k6 = fkey(sb.z), k7 = fkey(sb.w);
        const unsigned ib = 127u - (unsigned)(l16 * 8);
        k0 = (k0 & ~127u) | (ib - 0u); k1 = (k1 & ~127u) | (ib - 1u); k2 = (k2 & ~127u) | (ib - 2u); k3 = (k3 & ~127u) | (ib - 3u);
        k4 = (k4 & ~127u) | (ib - 4u); k5 = (k5 & ~127u) | (ib - 5u); k6 = (k6 & ~127u) | (ib - 6u); k7 = (k7 & ~127u) | (ib - 7u);
        CE_DESC(k0, k1); CE_DESC(k2, k3); CE_DESC(k4, k5); CE_DESC(k6, k7);
        CE_DESC(k0, k2); CE_DESC(k1, k3); CE_DESC(k4, k6); CE_DESC(k5, k7);
        CE_DESC(k1, k2); CE_DESC(k5, k6);
        CE_DESC(k0, k4); CE_DESC(k1, k5); CE_DESC(k2, k6); CE_DESC(k3, k7);
        CE_DESC(k2, k4); CE_DESC(k3, k5);
        CE_DESC(k1, k2); CE_DESC(k3, k4); CE_DESC(k5, k6);
        unsigned top = 0u;
#pragma unroll
        for (int rr = 0; rr < 16; ++rr) {
            const unsigned m = rowmax16u(k0);
            top = (l16 == rr) ? m : top;
            const bool pop = (k0 == m);
            k0 = pop ? k1 : k0; k1 = pop ? k2 : k1; k2 = pop ? k3 : k2; k3 = pop ? k4 : k3; k4 = pop ? k5 : k4; k5 = pop ? k6 : k5; k6 = pop ? k7 : k6; k7 = pop ? 0u : k7;
        }
        tk[lane] = top;
        __builtin_amdgcn_wave_barrier(); LDS_WAIT();
        const LAS unsigned* ab = tk + 32 * hsel; const LAS unsigned* bb = ab + 16;
        const unsigned aik = ab[l16], a0k = ab[0], bik = bb[l16];
        const u32x4 bq0 = *(const LAS u32x4*)bb, bq1 = *(const LAS u32x4*)(bb + 4);
        const float vai = fval(aik, 127u), va0 = fval(a0k, 127u), vbi = fval(bik, 127u);
        const unsigned bk[8] = {bq0.x, bq0.y, bq0.z, bq0.w, bq1.x, bq1.y, bq1.z, bq1.w};
        unsigned L[8];
#pragma unroll
        for (int e = 0; e < 8; ++e) { const float sv = vai + fval(bk[e], 127u); const unsigned kk = (fkey(sv) & ~255u) | (255u - (unsigned)(l16 * 16 + e));
            L[e] = ((l16 + 1) * (e + 1) <= 16) ? kk : 0u; }
        { const float sv = va0 + vbi; const unsigned kk = (fkey(sv) & ~255u) | (255u - (unsigned)l16); L[1] = (l16 >= 8) ? kk : L[1]; }
        CE_DESC(L[0], L[1]);
        unsigned best = 0u;
#pragma unroll
        for (int rr = 0; rr < 16; ++rr) {
            const unsigned m = rowmax16u(L[0]);
            best = (l16 == rr) ? m : best;
            const bool pop = (L[0] == m);
            L[0] = pop ? L[1] : L[0]; L[1] = pop ? L[2] : L[1]; L[2] = pop ? L[3] : L[2]; L[3] = pop ? L[4] : L[3]; L[4] = pop ? L[5] : L[4]; L[5] = pop ? L[6] : L[5]; L[6] = pop ? L[7] : L[6]; L[7] = pop ? 0u : L[7];
        }
        const unsigned flat = 255u - (best & 255u), ci = flat >> 4, cj = flat & 15u;
        const unsigned ak = ab[ci], bk2 = bb[cj];
        const float sval = fval(ak, 127u) + fval(bk2, 127u);
        const unsigned eidx = (127u - (ak & 127u)) * 128u + (127u - (bk2 & 127u));
        const float mx = rowmax16f(sval), ex = __expf(sval - mx), sm = rowsum16f(ex), gt = ex / sm;
        if ((row & 1) == 0) { const int hd = 2 * ps + hsel; pe_idx[hd * 16 + l16] = eidx; pe_gate[hd * 16 + l16] = gt; }
        __builtin_amdgcn_wave_barrier(); LDS_WAIT();
    }
}

struct Args { const float* in[19]; float* out; unsigned char* ws; int ph_lo, ph_hi; };

__device__ __forceinline__ void p0_transpose_item(const float* W, int K, int N, f16_t* WT, LAS float* scr, int item, int lane) {
    const int nblk = N / 32, kb = item / nblk, nb = item % nblk, k0 = 64 * kb, n0 = 32 * nb;
#pragma unroll 8
    for (int i = 0; i < 32; ++i) { const int kk = 2 * i + (lane >> 5); scr[kk * 33 + (lane & 31)] = W[(size_t)(k0 + kk) * N + n0 + (lane & 31)]; }
    LDS_WAIT(); asm volatile("" ::: "memory");
    const int c = lane & 7;
#pragma unroll
    for (int j = 0; j < 4; ++j) { const int n = (lane >> 3) + 8 * j; const LAS float* s = scr + (8 * c) * 33 + n;
        u32x4 o; o.x = pk_f16(s[0 * 33], s[1 * 33]); o.y = pk_f16(s[2 * 33], s[3 * 33]); o.z = pk_f16(s[4 * 33], s[5 * 33]); o.w = pk_f16(s[6 * 33], s[7 * 33]);
        *(u32x4*)(WT + (size_t)(n0 + n) * K + k0 + 8 * c) = o; }
    LDS_WAIT(); asm volatile("" ::: "memory");
}

__device__ __forceinline__ void norm_rows(const float* src, f16_t* dst, const LAS float* A, const LAS float* S, int row0, int nrows, int wave, int lane) {
    for (int r = wave; r < nrows; r += NWAVES) {
        const f32x4* xr = (const f32x4*)(src + (size_t)(row0 + r) * DM) + lane;
        f32x4 v[4]; float s = 0.f;
#pragma unroll
        for (int j = 0; j < 4; ++j) { v[j] = xr[64 * j]; s += (v[j].x * v[j].x + v[j].y * v[j].y) + (v[j].z * v[j].z + v[j].w * v[j].w); }
        const float rstd = rsqrtf(wave_sum(s) * (1.f / DM) + EPS);
        unsigned long long* o8 = (unsigned long long*)(dst + (size_t)(row0 + r) * DM) + lane;
#pragma unroll
        for (int j = 0; j < 4; ++j) { const f32x4 a = *(const LAS f32x4*)(A + 4 * (64 * j + lane)), sh = *(const LAS f32x4*)(S + 4 * (64 * j + lane));
            const f32x4 h = v[j] * rstd * a + sh;
            o8[64 * j] = (unsigned long long)pk_f16(h.x, h.y) | ((unsigned long long)pk_f16(h.z, h.w) << 32); }
    }
}

__global__ void __launch_bounds__(NTHR, 2) fwd_kernel(Args args) {
    extern __shared__ __attribute__((aligned(16))) unsigned char lds_raw[];
    LAS unsigned char* lds = (LAS unsigned char*)lds_raw;
    volatile LAS unsigned* MISC = (volatile LAS unsigned*)(lds + MISC_OFF);
    const int tid = threadIdx.x, lane = tid & 63, wave = __builtin_amdgcn_readfirstlane(tid >> 6);
    const int G = gridDim.x, wg = blockIdx.x;
    unsigned char* ws = args.ws;
    unsigned* ctl = (unsigned*)(ws + WS_CTL);

    const float* x = args.in[0]; const float* cvec = args.in[1]; const float* w_ada = args.in[2]; const float* b_ada = args.in[3];
    const float* g_norm1 = args.in[4]; const float* w_in = args.in[5]; const float* w_pool = args.in[6]; const float* pool_scale = args.in[7];
    const float* sgu_ln_g = args.in[8]; const float* sgu_ln_b = args.in[9]; const float* w_spatial = args.in[10]; const float* b_spatial = args.in[11];
    const float* w_out = args.in[12]; const float* g_norm2 = args.in[13]; const float* w_query = args.in[14]; const float* sub_keys = args.in[15];
    const float* expert_down = args.in[16]; const float* expert_up = args.in[17]; const float* g_final = args.in[18];
    float* out = args.out;
    float* mod = (float*)(ws + WS_MOD); float* modp = (float*)(ws + WS_MODP);
    f16_t* WinT = (f16_t*)(ws + WS_WIN); f16_t* WoutT = (f16_t*)(ws + WS_WOUT); f16_t* WqkT = (f16_t*)(ws + WS_WQK);
    f16_t* WpoolT = (f16_t*)(ws + WS_WPOOL); f16_t* Wsp = (f16_t*)(ws + WS_WSP);
    unsigned char* Ed8 = ws + WS_ED; unsigned char* Eu8 = ws + WS_EU; float* EdS = (float*)(ws + WS_EDS); float* EuS = (float*)(ws + WS_EUS);
    f16_t* H1 = (f16_t*)(ws + WS_H1); f16_t* PROJ = (f16_t*)(ws + WS_PROJ); f16_t* MIX = (f16_t*)(ws + WS_MIX); f16_t* H2 = (f16_t*)(ws + WS_H2);
    float* SC = (float*)(ws + WS_SC);

    if (tid < 64) MISC[tid] = 0u;
    __syncthreads();
    XcdBarrier bar; bar.bar = ctl + CW_BAR; bar.x = 0; bar.st = MISC + 8;
    if (N_LAUNCHES == 1) bar = xcd_barrier_post(ctl + CW_BAR, MISC + 8);
#define GRID_BAR() do { if (N_LAUNCHES == 1) xcd_barrier(bar); } while (0)
    const int lo = args.ph_lo, hi = args.ph_hi;
#define IN(k) (lo <= (k) && (k) < hi)
#define BOTH(k) (IN(k) && IN((k) + 1))

    if (IN(0)) {
        LAS float* cact = (LAS float*)lds;
        for (int i = tid; i < BATCH * DM; i += NTHR) { const float v = cvec[i]; cact[i] = v / (1.f + __expf(-v)); }
        __syncthreads();
        const int gw = wg * NWAVES + wave, NGW = G * NWAVES;
        for (int it = gw; it < 96 * 8; it += NGW) {
            const int cc = it % 96, ks = it / 96, e = cc * 64 + lane;
            const float* wp = w_ada + (size_t)(ks * 128) * NMOD + e; const LAS float* ca = cact + ks * 128;
            float a0 = 0.f, a1 = 0.f, a2 = 0.f, a3 = 0.f;
#pragma unroll 8
            for (int k = 0; k < 128; ++k) { const float w = wp[(size_t)k * NMOD]; a0 += ca[k] * w; a1 += ca[DM + k] * w; a2 += ca[2 * DM + k] * w; a3 += ca[3 * DM + k] * w; }
            float* mp = modp + (size_t)(ks * 4) * NMOD + e; mp[0] = a0; mp[NMOD] = a1; mp[2 * NMOD] = a2; mp[3 * NMOD] = a3;
        }
        { LAS float* scr = (LAS float*)(lds + 16384 + wave * 12288);
          constexpr int I_IN = (DM / 64) * (NPROJ / 32), I_OUT = (DM / 64) * (DM / 32), I_POOL = (128 / 64) * (128 / 32);
          for (int it = gw; it < I_IN + I_OUT + 4 * I_POOL; it += NGW) {
              int r = it;
              if (r < I_IN) { p0_transpose_item(w_in, DM, NPROJ, WinT, scr, r, lane); continue; } r -= I_IN;
              if (r < I_OUT) { p0_transpose_item(w_out, DM, DM, WoutT, scr, r, lane); continue; } r -= I_OUT;
              const int g = r / I_POOL; p0_transpose_item(w_pool + g * 16384, 128, 128, WpoolT + g * 16384, scr, r % I_POOL, lane);
          } }
        { const int gt = wg * NTHR + tid, NGT = G * NTHR;
          for (int i = gt; i < 8192; i += NGT) { const int base = i * 8, t = (base >> 7) & 127, s0 = base & 127;
              const f32x4 a = *(const f32x4*)(w_spatial + base), b = *(const f32x4*)(w_spatial + base + 4);
              float v[8] = {a.x, a.y, a.z, a.w, b.x, b.y, b.z, b.w};
#pragma unroll
              for (int e = 0; e < 8; ++e) v[e] = (s0 + e <= t) ? v[e] : 0.f;
              u32x4 o; o.x = pk_f16(v[0], v[1]); o.y = pk_f16(v[2], v[3]); o.z = pk_f16(v[4], v[5]); o.w = pk_f16(v[6], v[7]);
              *(u32x4*)(Wsp + base) = o; }
          }
        for (int rowi = gw; rowi < 2 * NEXP; rowi += NGW) {
            const int tb = rowi >= NEXP, er = tb ? rowi - NEXP : rowi;
            const float* src = (tb ? expert_up : expert_down) + (size_t)er * DM;
            const f32x4 a0 = *(const f32x4*)(src + lane * 8), a1 = *(const f32x4*)(src + lane * 8 + 4), b0 = *(const f32x4*)(src + 512 + lane * 8), b1 = *(const f32x4*)(src + 512 + lane * 8 + 4);
            float m = fmaxf(fmaxf(fmaxf(fabsf(a0.x), fabsf(a0.y)), fmaxf(fabsf(a0.z), fabsf(a0.w))), fmaxf(fmaxf(fabsf(a1.x), fabsf(a1.y)), fmaxf(fabsf(a1.z), fabsf(a1.w))));
            m = fmaxf(m, fmaxf(fmaxf(fmaxf(fabsf(b0.x), fabsf(b0.y)), fmaxf(fabsf(b0.z), fabsf(b0.w))), fmaxf(fmaxf(fabsf(b1.x), fabsf(b1.y)), fmaxf(fabsf(b1.z), fabsf(b1.w)))));
            m = wave_max(m);
            const float sc = m > 0.f ? m * (1.f / 432.f) : 1.f, inv = 1.f / sc;
            int w0 = 0, w1 = 0, w2 = 0, w3 = 0;
            w0 = __builtin_amdgcn_cvt_pk_fp8_f32(a0.x * inv, a0.y * inv, w0, false); w0 = __builtin_amdgcn_cvt_pk_fp8_f32(a0.z * inv, a0.w * inv, w0, true);
            w1 = __builtin_amdgcn_cvt_pk_fp8_f32(a1.x * inv, a1.y * inv, w1, false); w1 = __builtin_amdgcn_cvt_pk_fp8_f32(a1.z * inv, a1.w * inv, w1, true);
            w2 = __builtin_amdgcn_cvt_pk_fp8_f32(b0.x * inv, b0.y * inv, w2, false); w2 = __builtin_amdgcn_cvt_pk_fp8_f32(b0.z * inv, b0.w * inv, w2, true);
            w3 = __builtin_amdgcn_cvt_pk_fp8_f32(b1.x * inv, b1.y * inv, w3, false); w3 = __builtin_amdgcn_cvt_pk_fp8_f32(b1.z * inv, b1.w * inv, w3, true);
            u32x4 o; o.x = (unsigned)w0; o.y = (unsigned)w1; o.z = (unsigned)w2; o.w = (unsigned)w3;
            *(u32x4*)((tb ? Eu8 : Ed8) + (size_t)er * 1024 + lane * 16) = o;
            if (lane == 0) (tb ? EuS : EdS)[er] = sc;
        }
        __syncthreads();
        for (int item = wg; item < 256; item += G) {
            const int hp = item >> 4, D0 = (item & 15) * 64;
            LAS float* SKs = (LAS float*)lds;
            LAS float* WQs = (LAS float*)(lds + 128 * 129 * 4);
            for (int i = tid; i < 128 * 32; i += NTHR) { const int k = i >> 5, d4 = (i & 31) * 4; const f32x4 v = *(const f32x4*)(sub_keys + (size_t)(hp * 128 + k) * 128 + d4);
                LAS float* p = SKs + k * 129 + d4; p[0] = v.x; p[1] = v.y; p[2] = v.z; p[3] = v.w; }
            for (int i = tid; i < 64 * 32; i += NTHR) { const int dd = i >> 5, d4 = (i & 31) * 4; const f32x4 v = *(const f32x4*)(w_query + (size_t)(D0 + dd) * NQK + hp * 128 + d4);
                LAS float* p = WQs + dd * 129 + d4; p[0] = v.x; p[1] = v.y; p[2] = v.z; p[3] = v.w; }
            __syncthreads();
            const int tk = tid >> 4, td = tid & 15;
            float acc[4][4];
#pragma unroll
            for (int i = 0; i < 4; ++i)
#pragma unroll
                for (int j = 0; j < 4; ++j) acc[i][j] = 0.f;
            for (int d = 0; d < 128; ++d) { float a[4], b[4];
#pragma unroll
                for (int i = 0; i < 4; ++i) { a[i] = SKs[(4 * tk + i) * 129 + d]; b[i] = WQs[(4 * td + i) * 129 + d]; }
#pragma unroll
                for (int i = 0; i < 4; ++i)
#pragma unroll
                    for (int j = 0; j < 4; ++j) acc[i][j] += a[i] * b[j]; }
#pragma unroll
            for (int i = 0; i < 4; ++i) { u32x2 o; o.x = pk_f16(acc[i][0], acc[i][1]); o.y = pk_f16(acc[i][2], acc[i][3]);
                *(u32x2*)(WqkT + (size_t)(hp * 128 + 4 * tk + i) * DM + D0 + 4 * td) = o; }
            __syncthreads();
        }
        if (BOTH(0)) GRID_BAR();
    }

    if (IN(1)) {
        LAS float* A = (LAS float*)lds; LAS float* S = A + DM;
        for (int i = wg * NTHR + tid; i < BATCH * NMOD; i += G * NTHR) { const int b = i / NMOD, e = i % NMOD; float s = b_ada[e];
#pragma unroll
            for (int ks = 0; ks < 8; ++ks) s += modp[(size_t)(ks * 4 + b) * NMOD + e];
            mod[i] = s; }
        for (int tile = wg; tile < M / 128; tile += G) {
            const int b = tile >> 6;
            __syncthreads();
            for (int c = tid; c < DM; c += NTHR) { float sh = b_ada[c], sc = b_ada[DM + c];
#pragma unroll
                for (int ks = 0; ks < 8; ++ks) { sh += modp[(size_t)(ks * 4 + b) * NMOD + c]; sc += modp[(size_t)(ks * 4 + b) * NMOD + DM + c]; }
                A[c] = g_norm1[c] * (1.f + sc); S[c] = sh; }
            __syncthreads();
            norm_rows(x, H1, A, S, tile * 128, 128, wave, lane);
        }
        if (BOTH(1)) GRID_BAR();
    }

    if (IN(2)) {
        pg8::Gemm g{H1, WinT, M, NPROJ, DM}; pg8::StaticOrder S; S.init(M, NPROJ, G, wg);
        pg8::EpiF16 E{PROJ, NPROJ};
        pg8::gemm_phase<pg8::EpiF16, pg8::StaticOrder, true, true>(lds, g, S, E);
        if (BOTH(2)) GRID_BAR();
    }

#if defined(DBG_NAIVE_P3)
    if (IN(3)) {
        LAS float* stats = (LAS float*)lds;
        for (int tile = wg; tile < M / 128; tile += G) {
            const int row0 = tile * 128;
            __syncthreads();
            for (int r = wave; r < 128; r += NWAVES) {
                const f16x8 v = *(const f16x8*)(PROJ + (size_t)(row0 + r) * NPROJ + 1024 + lane * 8);
                float s = 0.f;
                for (int e = 0; e < 8; ++e) s += (float)v[e];
                const float mean = wave_sum(s) * (1.f / 512.f); float q = 0.f;
                for (int e = 0; e < 8; ++e) { const float d = (float)v[e] - mean; q += d * d; }
                const float rstd = rsqrtf(wave_sum(q) * (1.f / 512.f) + EPS);
                if (lane == 0) { stats[2 * r] = mean; stats[2 * r + 1] = rstd; }
            }
            __syncthreads();
            const _Float16* PH = (const _Float16*)PROJ;
            for (int i = tid; i < 128 * DM; i += NTHR) {
                const int t = i >> 10, col = i & 1023, row = row0 + t, pos = row & 8191;
                float outv;
                if (col < 512) { const int g = col >> 7, d = col & 127, w = 2 << g; const int cnt = (pos + 1 < w) ? pos + 1 : w; float acc = 0.f;
                    for (int c = 0; c < 128; ++c) { float sm = 0.f; for (int j = 0; j < cnt; ++j) sm += (float)PH[(size_t)(row - j) * NPROJ + g * 128 + c];
                        const float pooled = sm / (float)cnt - (float)PH[(size_t)row * NPROJ + g * 128 + c]; acc += pooled * w_pool[(g * 128 + c) * 128 + d]; }
                    outv = acc * pool_scale[col]; }
                else { const int cc = col - 512, h = cc >> 7; float acc = 0.f;
                    for (int s2 = 0; s2 <= t; ++s2) { const float vn = ((float)PH[(size_t)(row0 + s2) * NPROJ + 1024 + cc] - stats[2 * s2]) * stats[2 * s2 + 1] * sgu_ln_g[cc] + sgu_ln_b[cc];
                        acc += w_spatial[(h * 128 + t) * 128 + s2] * vn; }
                    acc += b_spatial[h * 128 + t];
                    outv = (float)PH[(size_t)row * NPROJ + 512 + cc] * acc; }
                ((_Float16*)MIX)[(size_t)row * DM + col] = (_Float16)outv;
            }
        }
        if (BOTH(3)) GRID_BAR();
    }
#else
    if (IN(3)) {
        constexpr int PITCH = 272;
        LAS unsigned char* img = lds;
        LAS float* stats = (LAS float*)(lds + 512 * PITCH);
        const int fr = lane & 15, fq = lane >> 4;
        for (int tile = wg; tile < M / 128; tile += G) {
            const int row0 = tile * 128;
            __syncthreads();
            for (int r = wave; r < 128; r += NWAVES) {
                const f16x8 v = *(const f16x8*)(PROJ + (size_t)(row0 + r) * NPROJ + 1024 + lane * 8);
                float s = 0.f;
#pragma unroll
                for (int e = 0; e < 8; ++e) s += (float)v[e];
                const float mean = wave_sum(s) * (1.f / 512.f); float q = 0.f;
#pragma unroll
                for (int e = 0; e < 8; ++e) { const float d = (float)v[e] - mean; q += d * d; }
                const float rstd = rsqrtf(wave_sum(q) * (1.f / 512.f) + EPS);
                if (lane == 0) { stats[2 * r] = mean; stats[2 * r + 1] = rstd; }
            }
            __syncthreads();
            { const int cp = tid & 255; const float g0 = sgu_ln_g[2 * cp], g1 = sgu_ln_g[2 * cp + 1], b0 = sgu_ln_b[2 * cp], b1 = sgu_ln_b[2 * cp + 1];
              for (int sb = tid >> 8; sb < 16; sb += 2) {
                  float v0[8], v1[8];
#pragma unroll
                  for (int e = 0; e < 8; ++e) { const int s = sb * 8 + e; const f16x2 hv = *(const f16x2*)(PROJ + (size_t)(row0 + s) * NPROJ + 1024 + 2 * cp);
                      const float mean = stats[2 * s], rstd = stats[2 * s + 1];
                      v0[e] = ((float)hv.x - mean) * rstd * g0 + b0; v1[e] = ((float)hv.y - mean) * rstd * g1 + b1; }
                  u32x4 o0, o1; o0.x = pk_f16(v0[0], v0[1]); o0.y = pk_f16(v0[2], v0[3]); o0.z = pk_f16(v0[4], v0[5]); o0.w = pk_f16(v0[6], v0[7]);
                  o1.x = pk_f16(v1[0], v1[1]); o1.y = pk_f16(v1[2], v1[3]); o1.z = pk_f16(v1[4], v1[5]); o1.w = pk_f16(v1[6], v1[7]);
                  *(LAS u32x4*)(img + (2 * cp) * PITCH + sb * 16) = o0; *(LAS u32x4*)(img + (2 * cp + 1) * PITCH + sb * 16) = o1; } }
            __syncthreads();
            { const int h = wave >> 1, th = wave & 1, t0 = 64 * th;
              const int nks = th ? 4 : 2;
#pragma unroll 1
              for (int ch = 0; ch < 2; ++ch) {
                  f32x4 acc[4][4];
#pragma unroll
                  for (int m = 0; m < 4; ++m)
#pragma unroll
                      for (int n = 0; n < 4; ++n) acc[m][n] = (f32x4){0.f, 0.f, 0.f, 0.f};
                  const f16_t* wbase = Wsp + (size_t)(h * 128 + t0 + fr) * 128 + 8 * fq;
                  const LAS unsigned char* vbase = img + (h * 128 + 64 * ch + fr) * PITCH + 16 * fq;
#pragma unroll 1
                  for (int ks = 0; ks < nks; ++ks) {
                      f16x8 wf[4], vf[4];
#pragma unroll
                      for (int m = 0; m < 4; ++m) wf[m] = *(const f16x8*)(wbase + (16 * m) * 128 + 32 * ks);
#pragma unroll
                      for (int n = 0; n < 4; ++n) vf[n] = *(const LAS f16x8*)(vbase + (16 * n) * PITCH + 64 * ks);
#pragma unroll
                      for (int m = 0; m < 4; ++m)
#pragma unroll
                          for (int n = 0; n < 4; ++n) acc[m][n] = __builtin_amdgcn_mfma_f32_16x16x32_f16(vf[n], wf[m], acc[m][n], 0, 0, 0);
                  }
#pragma unroll
                  for (int m = 0; m < 4; ++m) { const int t = t0 + 16 * m + fr; const float bs = b_spatial[h * 128 + t];
                      const int cb0 = h * 128 + 64 * ch + 4 * fq;
                      const f16_t* up = PROJ + (size_t)(row0 + t) * NPROJ + 512 + cb0; f16_t* op = MIX + (size_t)(row0 + t) * DM + 512 + cb0;
#pragma unroll
                      for (int n = 0; n < 4; ++n) {
                          const f16x4 u = *(const f16x4*)(up + 16 * n);
                          u32x2 o; o.x = pk_f16((float)u[0] * (acc[m][n][0] + bs), (float)u[1] * (acc[m][n][1] + bs)); o.y = pk_f16((float)u[2] * (acc[m][n][2] + bs), (float)u[3] * (acc[m][n][3] + bs));
                          *(u32x2*)(op + 16 * n) = o; } }
              } }
            __syncthreads();
            { const int cp = tid & 255, thh = tid >> 8, g = cp >> 6, w = 2 << g, cl = (2 * cp) & 127;
              const int p0 = (tile & 63) * 128;
              const f16_t* ap = PROJ + (size_t)row0 * NPROJ + 2 * cp;
              float s0 = 0.f, s1 = 0.f;
              const int tt0 = 64 * thh;
              for (int j = 1; j <= w; ++j) { if (p0 + tt0 - j >= 0) { const f16x2 hv = *(const f16x2*)(ap + (ptrdiff_t)(tt0 - j) * NPROJ); s0 += (float)hv.x; s1 += (float)hv.y; } }
              for (int tb = 0; tb < 64; tb += 8) {
                  f16x2 cur[8], old[8];
#pragma unroll
                  for (int e = 0; e < 8; ++e) { const int tt = tt0 + tb + e; cur[e] = *(const f16x2*)(ap + (ptrdiff_t)tt * NPROJ);
                      const bool ok = (p0 + tt - w >= 0); old[e] = ok ? *(const f16x2*)(ap + (ptrdiff_t)(tt - w) * NPROJ) : (f16x2){(_Float16)0.f, (_Float16)0.f}; }
#pragma unroll
                  for (int e = 0; e < 8; ++e) { const int tt = tt0 + tb + e; const int pos = p0 + tt + 1;
                      s0 += (float)cur[e].x; s1 += (float)cur[e].y; s0 -= (float)old[e].x; s1 -= (float)old[e].y;
                      const float inv = 1.f / (float)(pos < w ? pos : w);
                      *(LAS unsigned*)(img + (g * 128 + tt) * PITCH + cl * 2) = pk_f16(s0 * inv - (float)cur[e].x, s1 * inv - (float)cur[e].y); }
              } }
            __syncthreads();
            { const int g = wave >> 1, th = wave & 1, t0 = 64 * th;
#pragma unroll 1
              for (int ch = 0; ch < 2; ++ch) {
                  f32x4 acc[4][4];
#pragma unroll
                  for (int m = 0; m < 4; ++m)
#pragma unroll
                      for (int n = 0; n < 4; ++n) acc[m][n] = (f32x4){0.f, 0.f, 0.f, 0.f};
                  const LAS unsigned char* pbase = img + (g * 128 + t0 + fr) * PITCH + 16 * fq;
                  const f16_t* wbase = WpoolT + (size_t)(g * 128 + 64 * ch + fr) * 128 + 8 * fq;
#pragma unroll 1
                  for (int ks = 0; ks < 4; ++ks) {
                      f16x8 pf[4], wf[4];
#pragma unroll
                      for (int m = 0; m < 4; ++m) pf[m] = *(const LAS f16x8*)(pbase + (16 * m) * PITCH + 64 * ks);
#pragma unroll
                      for (int n = 0; n < 4; ++n) wf[n] = *(const f16x8*)(wbase + (16 * n) * 128 + 32 * ks);
#pragma unroll
                      for (int m = 0; m < 4; ++m)
#pragma unroll
                          for (int n = 0; n < 4; ++n) acc[m][n] = __builtin_amdgcn_mfma_f32_16x16x32_f16(wf[n], pf[m], acc[m][n], 0, 0, 0);
                  }
                  const int cb0 = g * 128 + 64 * ch + 4 * fq;
#pragma unroll
                  for (int m = 0; m < 4; ++m) { const int t = t0 + 16 * m + fr; f16_t* op = MIX + (size_t)(row0 + t) * DM + cb0;
#pragma unroll
                      for (int n = 0; n < 4; ++n) { const f32x4 ps = *(const f32x4*)(pool_scale + cb0 + 16 * n);
                          u32x2 o; o.x = pk_f16(acc[m][n][0] * ps.x, acc[m][n][1] * ps.y); o.y = pk_f16(acc[m][n][2] * ps.z, acc[m][n][3] * ps.w);
                          *(u32x2*)(op + 16 * n) = o; } }
              } }
        }
        if (BOTH(3)) GRID_BAR();
    }
#endif

    if (IN(4)) {
        pg8::Gemm g{MIX, WoutT, M, DM, DM}; pg8::StaticOrder S; S.init(M, DM, G, wg);
        pg8::EpiRes E{x, out, mod + 2 * DM, DM};
        pg8::gemm_phase<pg8::EpiRes, pg8::StaticOrder, true, true>(lds, g, S, E);
        if (BOTH(4)) GRID_BAR();
    }

    if (IN(5)) {
        LAS float* A = (LAS float*)lds; LAS float* S = A + DM;
        for (int tile = wg; tile < M / 128; tile += G) {
            const int b = tile >> 6;
            __syncthreads();
            for (int c = tid; c < DM; c += NTHR) { A[c] = g_norm2[c] * (1.f + mod[b * NMOD + 4 * DM + c]); S[c] = mod[b * NMOD + 3 * DM + c]; }
            __syncthreads();
            norm_rows(out, H2, A, S, tile * 128, 128, wave, lane);
        }
        if (BOTH(5)) GRID_BAR();
    }

    if (IN(6)) {
        pg8::Gemm g{H2, WqkT, M, NQK, DM}; pg8::StaticOrder S; S.init(M, NQK, G, wg);
        pg8::EpiF32 E{SC, NQK};
        pg8::gemm_phase<pg8::EpiF32, pg8::StaticOrder, true, true>(lds, g, S, E);
        if (BOTH(6)) GRID_BAR();
    }

    if (IN(7)) {
        constexpr int TT = 4, NSL = 8; static_assert(TT == 4, "the sweeps are written out for four tokens");
        const __amdgpu_buffer_rsrc_t rsD = __builtin_amdgcn_make_buffer_rsrc((void*)Ed8, 0, NEXP * 1024, 0x00020000), rsU = __builtin_amdgcn_make_buffer_rsrc((void*)Eu8, 0, NEXP * 1024, 0x00020000);
        const unsigned lane16 = (unsigned)lane * 16u;
        LAS float* G2 = (LAS float*)lds; LAS float* GF = G2 + DM;
        LAS unsigned* wl = (LAS unsigned*)(lds + 8192 + wave * 8192);
        LAS unsigned* tk = wl; LAS unsigned* pe_idx = wl + 256; LAS float* pe_gate = (LAS float*)(wl + 256 + TT * 128);
        for (int tile = wg; tile < M / 128; tile += G) {
            const int b = tile >> 6;
            __syncthreads();
            for (int c = tid; c < DM; c += NTHR) { G2[c] = mod[b * NMOD + 5 * DM + c]; GF[c] = g_final[c]; }
            __syncthreads();
#pragma unroll 1
            for (int rnd = 0; rnd < 16 / TT; ++rnd) {
                const int tok0 = tile * 128 + wave + NWAVES * (rnd * TT);
#pragma unroll 1
                for (int t = 0; t < TT; ++t) topk_token(SC + (size_t)(tok0 + NWAVES * t) * NQK, tk, pe_idx + t * 128, pe_gate + t * 128, lane);
                unsigned idxA[TT], idxB[TT]; float gA[TT], gB[TT], preA[TT], preB[TT]; u32x4 hA[TT], hB[TT];
#pragma unroll
                for (int t = 0; t < TT; ++t) { idxA[t] = pe_idx[t * 128 + lane]; idxB[t] = pe_idx[t * 128 + 64 + lane]; gA[t] = pe_gate[t * 128 + lane]; gB[t] = pe_gate[t * 128 + 64 + lane];
                    const f16_t* hp = H2 + (size_t)(tok0 + NWAVES * t) * DM; hA[t] = *(const u32x4*)(hp + lane * 8); hB[t] = *(const u32x4*)(hp + 512 + lane * 8); preA[t] = 0.f; preB[t] = 0.f; }
#define NEXTBIT(m, k, v) do { v = (m) != 0ull; k = v ? (int)__builtin_ctzll(m) : 64; m &= (m - 1ull); } while (0)
#define CVT8(u, hi) __builtin_amdgcn_cvt_scalef32_pk_f16_fp8((u), 1.0f, (hi))
#define ISSUE(BUF, MA, MB, T, B, RS) do { MA = __ballot((idxA[T] >> 10) == (unsigned)(B)); MB = __ballot((idxB[T] >> 10) == (unsigned)(B)); \
        unsigned long long _ma = MA, _mb = MB; \
        _Pragma("unroll") for (int j = 0; j < NSL; ++j) { int _k; bool _v; NEXTBIT(_ma, _k, _v); const unsigned _e = (unsigned)__builtin_amdgcn_readlane((int)idxA[T], _k & 63); \
            BUF[j] = __builtin_amdgcn_raw_buffer_load_b128(RS, (_v ? _e * 1024u : 0x7fff0000u) + lane16, 0, 0); } \
        _Pragma("unroll") for (int j = 0; j < NSL; ++j) { int _k; bool _v; NEXTBIT(_mb, _k, _v); const unsigned _e = (unsigned)__builtin_amdgcn_readlane((int)idxB[T], _k & 63); \
            BUF[NSL + j] = __builtin_amdgcn_raw_buffer_load_b128(RS, (_v ? _e * 1024u : 0x7fff0000u) + lane16, 0, 0); } } while (0)
#define DOWN_SLOT(R, T, K, PRE) do { const u32x4 _r = (R); float _sd = 0.f; \
        _sd = __builtin_amdgcn_fdot2(CVT8(_r.x, false), as_h2(hA[T].x), _sd, false); _sd = __builtin_amdgcn_fdot2(CVT8(_r.x, true), as_h2(hA[T].y), _sd, false); \
        _sd = __builtin_amdgcn_fdot2(CVT8(_r.y, false), as_h2(hA[T].z), _sd, false); _sd = __builtin_amdgcn_fdot2(CVT8(_r.y, true), as_h2(hA[T].w), _sd, false); \
        _sd = __builtin_amdgcn_fdot2(CVT8(_r.z, false), as_h2(hB[T].x), _sd, false); _sd = __builtin_amdgcn_fdot2(CVT8(_r.z, true), as_h2(hB[T].y), _sd, false); \
        _sd = __builtin_amdgcn_fdot2(CVT8(_r.w, false), as_h2(hB[T].z), _sd, false); _sd = __builtin_amdgcn_fdot2(CVT8(_r.w, true), as_h2(hB[T].w), _sd, false); \
        const float _tot = wave_total(_sd); PRE = (lane == (K)) ? _tot : PRE; } while (0)
#define UP_SLOT(R, T, CS) do { const u32x4 _r = (R); const float _cs = (CS); \
        const f16x2 q0 = CVT8(_r.x, false), q1 = CVT8(_r.x, true), q2 = CVT8(_r.y, false), q3 = CVT8(_r.y, true), q4 = CVT8(_r.z, false), q5 = CVT8(_r.z, true), q6 = CVT8(_r.w, false), q7 = CVT8(_r.w, true); \
        acc[T][0] = fmaf((float)q0.x, _cs, acc[T][0]); acc[T][1] = fmaf((float)q0.y, _cs, acc[T][1]); acc[T][2] = fmaf((float)q1.x, _cs, acc[T][2]); acc[T][3] = fmaf((float)q1.y, _cs, acc[T][3]); \
        acc[T][4] = fmaf((float)q2.x, _cs, acc[T][4]); acc[T][5] = fmaf((float)q2.y, _cs, acc[T][5]); acc[T][6] = fmaf((float)q3.x, _cs, acc[T][6]); acc[T][7] = fmaf((float)q3.y, _cs, acc[T][7]); \
        acc[T][8] = fmaf((float)q4.x, _cs, acc[T][8]); acc[T][9] = fmaf((float)q4.y, _cs, acc[T][9]); acc[T][10] = fmaf((float)q5.x, _cs, acc[T][10]); acc[T][11] = fmaf((float)q5.y, _cs, acc[T][11]); \
        acc[T][12] = fmaf((float)q6.x, _cs, acc[T][12]); acc[T][13] = fmaf((float)q6.y, _cs, acc[T][13]); acc[T][14] = fmaf((float)q7.x, _cs, acc[T][14]); acc[T][15] = fmaf((float)q7.y, _cs, acc[T][15]); } while (0)
#define CONSUME_DOWN(BUF, MA, MB, T) do { unsigned long long _ma = MA, _mb = MB; \
        _Pragma("unroll") for (int j = 0; j < NSL; ++j) { int _k; bool _v; NEXTBIT(_ma, _k, _v); if (_v) DOWN_SLOT(BUF[j], T, _k, preA[T]); } \
        _Pragma("unroll") for (int j = 0; j < NSL; ++j) { int _k; bool _v; NEXTBIT(_mb, _k, _v); if (_v) DOWN_SLOT(BUF[NSL + j], T, _k, preB[T]); } \
        while (_ma) { int _k; bool _v; NEXTBIT(_ma, _k, _v); const unsigned _e = (unsigned)__builtin_amdgcn_readlane((int)idxA[T], _k & 63); BUF[0] = __builtin_amdgcn_raw_buffer_load_b128(rsD, _e * 1024u + lane16, 0, 0); DOWN_SLOT(BUF[0], T, _k, preA[T]); } \
        while (_mb) { int _k; bool _v; NEXTBIT(_mb, _k, _v); const unsigned _e = (unsigned)__builtin_amdgcn_readlane((int)idxB[T], _k & 63); BUF[0] = __builtin_amdgcn_raw_buffer_load_b128(rsD, _e * 1024u + lane16, 0, 0); DOWN_SLOT(BUF[0], T, _k, preB[T]); } } while (0)
#define CONSUME_UP(BUF, MA, MB, T) do { unsigned long long _ma = MA, _mb = MB; \
        _Pragma("unroll") for (int j = 0; j < NSL; ++j) { int _k; bool _v; NEXTBIT(_ma, _k, _v); if (_v) UP_SLOT(BUF[j], T, as_f((unsigned)__builtin_amdgcn_readlane((int)as_u(coefA[T]), _k))); } \
        _Pragma("unroll") for (int j = 0; j < NSL; ++j) { int _k; bool _v; NEXTBIT(_mb, _k, _v); if (_v) UP_SLOT(BUF[NSL + j], T, as_f((unsigned)__builtin_amdgcn_readlane((int)as_u(coefB[T]), _k))); } \
        while (_ma) { int _k; bool _v; NEXTBIT(_ma, _k, _v); const unsigned _e = (unsigned)__builtin_amdgcn_readlane((int)idxA[T], _k & 63); BUF[0] = __builtin_amdgcn_raw_buffer_load_b128(rsU, _e * 1024u + lane16, 0, 0); UP_SLOT(BUF[0], T, as_f((unsigned)__builtin_amdgcn_readlane((int)as_u(coefA[T]), _k))); } \
        while (_mb) { int _k; bool _v; NEXTBIT(_mb, _k, _v); const unsigned _e = (unsigned)__builtin_amdgcn_readlane((int)idxB[T], _k & 63); BUF[0] = __builtin_amdgcn_raw_buffer_load_b128(rsU, _e * 1024u + lane16, 0, 0); UP_SLOT(BUF[0], T, as_f((unsigned)__builtin_amdgcn_readlane((int)as_u(coefB[T]), _k))); } } while (0)
                u32x4 bufX[2 * NSL], bufY[2 * NSL]; unsigned long long mXa, mXb, mYa, mYb;
                ISSUE(bufX, mXa, mXb, 0, 0, rsD);
#pragma unroll 1
                for (int band = 0; band < 16; ++band) {
                    ISSUE(bufY, mYa, mYb, 1, band, rsD); CONSUME_DOWN(bufX, mXa, mXb, 0);
                    ISSUE(bufX, mXa, mXb, 2, band, rsD); CONSUME_DOWN(bufY, mYa, mYb, 1);
                    ISSUE(bufY, mYa, mYb, 3, band, rsD); CONSUME_DOWN(bufX, mXa, mXb, 2);
                    if (band < 15) ISSUE(bufX, mXa, mXb, 0, band + 1, rsD);
                    CONSUME_DOWN(bufY, mYa, mYb, 3);
                }
                float coefA[TT], coefB[TT];
#pragma unroll
                for (int t = 0; t < TT; ++t) { const float pa = preA[t] * EdS[idxA[t]], pb = preB[t] * EdS[idxB[t]];
                    coefA[t] = gA[t] * 0.5f * pa * (1.f + erff(pa * 0.70710678118654752f)) * EuS[idxA[t]]; coefB[t] = gB[t] * 0.5f * pb * (1.f + erff(pb * 0.70710678118654752f)) * EuS[idxB[t]]; }
                float acc[TT][16];
#pragma unroll
                for (int t = 0; t < TT; ++t)
#pragma unroll
                    for (int j = 0; j < 16; ++j) acc[t][j] = 0.f;
                ISSUE(bufX, mXa, mXb, 0, 0, rsU);
#pragma unroll 1
                for (int band = 0; band < 16; ++band) {
                    ISSUE(bufY, mYa, mYb, 1, band, rsU); CONSUME_UP(bufX, mXa, mXb, 0);
                    ISSUE(bufX, mXa, mXb, 2, band, rsU); CONSUME_UP(bufY, mYa, mYb, 1);
                    ISSUE(bufY, mYa, mYb, 3, band, rsU); CONSUME_UP(bufX, mXa, mXb, 2);
                    if (band < 15) ISSUE(bufX, mXa, mXb, 0, band + 1, rsU);
                    CONSUME_UP(bufY, mYa, mYb, 3);
                }
#undef CONSUME_UP
#undef CONSUME_DOWN
#undef UP_SLOT
#undef DOWN_SLOT
#undef ISSUE
#undef CVT8
#undef NEXTBIT
#pragma unroll
                for (int t = 0; t < TT; ++t) {
                    float* orow = out + (size_t)(tok0 + NWAVES * t) * DM;
                    f32x4 xv[4]; xv[0] = *(const f32x4*)(orow + lane * 8); xv[1] = *(const f32x4*)(orow + lane * 8 + 4); xv[2] = *(const f32x4*)(orow + 512 + lane * 8); xv[3] = *(const f32x4*)(orow + 512 + lane * 8 + 4);
                    float ss = 0.f;
#pragma unroll
                    for (int q = 0; q < 4; ++q) { const int cb = (q >> 1) * 512 + lane * 8 + (q & 1) * 4; const f32x4 g2 = *(const LAS f32x4*)(G2 + cb);
                        xv[q].x += g2.x * acc[t][4 * q + 0]; xv[q].y += g2.y * acc[t][4 * q + 1]; xv[q].z += g2.z * acc[t][4 * q + 2]; xv[q].w += g2.w * acc[t][4 * q + 3];
                        ss += (xv[q].x * xv[q].x + xv[q].y * xv[q].y) + (xv[q].z * xv[q].z + xv[q].w * xv[q].w); }
                    const float rstd = rsqrtf(wave_total(ss) * (1.f / DM) + EPS);
#pragma unroll
                    for (int q = 0; q < 4; ++q) { const int cb = (q >> 1) * 512 + lane * 8 + (q & 1) * 4; const f32x4 gf = *(const LAS f32x4*)(GF + cb);
                        *(f32x4*)(orow + cb) = xv[q] * rstd * gf; }
                }
            }
        }
    }
#undef IN
#undef BOTH
#undef GRID_BAR
}


#if defined(DBG_CHECK)
constexpr size_t WS_FLAGS = 32 * 1024, WS_SNAP = 12 * MiB;
constexpr int NSAMP_TOK = 64;
__device__ __forceinline__ unsigned hash32(unsigned x) { x ^= x >> 16; x *= 0x7feb352du; x ^= x >> 15; x *= 0x846ca68bu; x ^= x >> 16; return x; }
__device__ __forceinline__ void chk(unsigned* flags, int id, float got, float ref, float atol, float rtol) { if (!(fabsf(got - ref) <= atol + rtol * fabsf(ref))) atomicAdd(&flags[id], 1u); }
__device__ __forceinline__ int samp_tok(int j) { return (j < 8) ? j * 4681 % M : (j < 16 ? ((j - 8) & 3) * 8192 + (j & 1) * 127 + (j >> 2 & 1) * 4000 : (int)(hash32(j * 977u + 5u) % M)); }
__global__ void dbg_check(Args args, int which) {
    unsigned char* ws = args.ws; unsigned* flags = (unsigned*)(ws + WS_FLAGS);
    const float* x = args.in[0]; const float* cvec = args.in[1]; const float* w_ada = args.in[2]; const float* b_ada = args.in[3];
    const float* g_norm1 = args.in[4]; const float* w_in = args.in[5]; const float* w_pool = args.in[6]; const float* pool_scale = args.in[7];
    const float* sgu_ln_g = args.in[8]; const float* sgu_ln_b = args.in[9]; const float* w_spatial = args.in[10]; const float* b_spatial = args.in[11];
    const float* w_out = args.in[12]; const float* g_norm2 = args.in[13]; const float* w_query = args.in[14]; const float* sub_keys = args.in[15];
    const float* expert_down = args.in[16]; const float* expert_up = args.in[17]; const float* g_final = args.in[18];
    const float* mod = (const float*)(ws + WS_MOD);
    const _Float16* H1 = (const _Float16*)(ws + WS_H1); const _Float16* PROJ = (const _Float16*)(ws + WS_PROJ); const _Float16* MIX = (const _Float16*)(ws + WS_MIX); const _Float16* H2 = (const _Float16*)(ws + WS_H2);
    const float* SC = (const float*)(ws + WS_SC); float* snap = (float*)(ws + WS_SNAP); const float* out = args.out;
    const unsigned gt = blockIdx.x * blockDim.x + threadIdx.x, NGT = gridDim.x * blockDim.x;
    if (which == 1) {
        for (unsigned i = gt; i < BATCH * NMOD; i += NGT) { const int b = i / NMOD, e = i % NMOD; float s = b_ada[e];
            for (int d = 0; d < DM; ++d) { const float c = cvec[b * DM + d]; s += (c / (1.f + expf(-c))) * w_ada[(size_t)d * NMOD + e]; }
            chk(flags, 1, mod[i], s, 1e-3f, 1e-3f); }
    } else if (which == 2) {
        for (unsigned i = gt; i < 4096 * 16; i += NGT) { const int row = hash32(i >> 4) % M, c0 = (i & 15) * 64, b = row >> 13; float ss = 0.f;
            for (int c = 0; c < DM; ++c) { const float v = x[(size_t)row * DM + c]; ss += v * v; }
            const float rstd = rsqrtf(ss / DM + EPS);
            for (int c = c0; c < c0 + 64; ++c) { const float ref = x[(size_t)row * DM + c] * rstd * g_norm1[c] * (1.f + mod[b * NMOD + DM + c]) + mod[b * NMOD + c];
                chk(flags, 2, (float)H1[(size_t)row * DM + c], ref, 4e-3f, 2e-3f); } }
    } else if (which == 3) {
        for (unsigned i = gt; i < 65536; i += NGT) { const unsigned h = hash32(i * 3u + 1u); const int row = h % M, col = (h >> 15) % NPROJ; float s = 0.f;
            for (int k = 0; k < DM; ++k) s += (float)H1[(size_t)row * DM + k] * w_in[(size_t)k * NPROJ + col];
            chk(flags, 3, (float)PROJ[(size_t)row * NPROJ + col], s, 1e-2f, 5e-3f); }
    } else if (which == 4) {
        for (unsigned i = gt; i < 32768; i += NGT) { const unsigned h = hash32(i * 5u + 2u); const int row = (i < 2048) ? ((i & 7) * 8192 % M + (i >> 3) % 32) : (int)(h % M), col = (h >> 15) % DM, pos = row & 8191; float ref;
            if (col < 512) { const int g = col >> 7, d = col & 127, w = 2 << g; const int cnt = (pos + 1 < w) ? pos + 1 : w; float acc = 0.f;
                for (int c = 0; c < 128; ++c) { float sm = 0.f; for (int j = 0; j < cnt; ++j) sm += (float)PROJ[(size_t)(row - j) * NPROJ + g * 128 + c];
                    acc += (sm / (float)cnt - (float)PROJ[(size_t)row * NPROJ + g * 128 + c]) * w_pool[(g * 128 + c) * 128 + d]; }
                ref = acc * pool_scale[col]; }
            else { const int cc = col - 512, hh = cc >> 7, t = row & 127, r0 = row - t; float acc = 0.f;
                for (int s2 = 0; s2 <= t; ++s2) { float mean = 0.f, var = 0.f; const _Float16* vr = PROJ + (size_t)(r0 + s2) * NPROJ + 1024;
                    for (int k = 0; k < 512; ++k) mean += (float)vr[k]; mean /= 512.f; for (int k = 0; k < 512; ++k) { const float dd = (float)vr[k] - mean; var += dd * dd; }
                    const float vn = ((float)vr[cc] - mean) * rsqrtf(var / 512.f + EPS) * sgu_ln_g[cc] + sgu_ln_b[cc]; acc += w_spatial[(hh * 128 + t) * 128 + s2] * vn; }
                ref = (float)PROJ[(size_t)row * NPROJ + 512 + cc] * (acc + b_spatial[hh * 128 + t]); }
            chk(flags, 4, (float)MIX[(size_t)row * DM + col], ref, 3e-2f, 1e-2f); }
    } else if (which == 5) {
        for (unsigned i = gt; i < 65536; i += NGT) { const unsigned h = hash32(i * 7u + 3u); const int row = h % M, col = (h >> 15) % DM, b = row >> 13; float s = 0.f;
            for (int k = 0; k < DM; ++k) s += (float)MIX[(size_t)row * DM + k] * w_out[(size_t)k * DM + col];
            chk(flags, 5, out[(size_t)row * DM + col], x[(size_t)row * DM + col] + mod[b * NMOD + 2 * DM + col] * s, 2e-2f, 5e-3f); }
    } else if (which == 6) {
        for (unsigned i = gt; i < 4096 * 16; i += NGT) { const int row = hash32((i >> 4) + 777u) % M, c0 = (i & 15) * 64, b = row >> 13; float ss = 0.f;
            for (int c = 0; c < DM; ++c) { const float v = out[(size_t)row * DM + c]; ss += v * v; }
            const float rstd = rsqrtf(ss / DM + EPS);
            for (int c = c0; c < c0 + 64; ++c) { const float ref = out[(size_t)row * DM + c] * rstd * g_norm2[c] * (1.f + mod[b * NMOD + 4 * DM + c]) + mod[b * NMOD + 3 * DM + c];
                chk(flags, 6, (float)H2[(size_t)row * DM + c], ref, 4e-3f, 2e-3f); } }
        for (unsigned i = gt; i < NSAMP_TOK * DM; i += NGT) snap[i] = out[(size_t)samp_tok(i / DM) * DM + (i % DM)];
    } else if (which == 8) {
        const _Float16* Ed = (const _Float16*)(ws + WS_ED); const _Float16* Eu = (const _Float16*)(ws + WS_EU);
        for (unsigned i = gt; i < 262144; i += NGT) { const size_t j = (size_t)(hash32(i * 13u + 6u) % (unsigned)(NEXP * DM));
            chk(flags, 8, (float)Ed[j], expert_down[j], 1e-5f, 1e-3f); chk(flags, 8, (float)Eu[j], expert_up[j], 1e-5f, 1e-3f); }
    } else if (which == 7) {
        for (unsigned i = gt; i < 16384; i += NGT) { const unsigned h = hash32(i * 11u + 4u); const int row = h % M, n = (h >> 15) % NQK, hp = n >> 7, k = n & 127; float s = 0.f;
            for (int d = 0; d < 128; ++d) { float q = 0.f; for (int kk = 0; kk < DM; ++kk) q += (float)H2[(size_t)row * DM + kk] * w_query[(size_t)kk * NQK + hp * 128 + d];
                s += q * sub_keys[(size_t)(hp * 128 + k) * 128 + d]; }
            chk(flags, 7, SC[(size_t)row * NQK + n], s, 2e-2f, 5e-3f); }
    }
}
__global__ void dbg_check_peer(Args args) {
    __shared__ float sc[2048]; __shared__ float stop[16][16]; __shared__ int itop[16][16]; __shared__ float cand[8][256]; __shared__ float gate[128]; __shared__ int eidx[128]; __shared__ float red[256];
    unsigned char* ws = args.ws; unsigned* flags = (unsigned*)(ws + WS_FLAGS);
    const float* expert_down = args.in[16]; const float* expert_up = args.in[17]; const float* g_final = args.in[18];
    const float* mod = (const float*)(ws + WS_MOD); const _Float16* H2 = (const _Float16*)(ws + WS_H2); const float* SC = (const float*)(ws + WS_SC); const float* snap = (const float*)(ws + WS_SNAP);
    const int j = blockIdx.x, tok = samp_tok(j), t = threadIdx.x, b = tok >> 13;
    for (int i = t; i < 2048; i += 256) sc[i] = SC[(size_t)tok * NQK + i];
    __syncthreads();
    if (t < 16) { for (int r = 0; r < 16; ++r) { int bi = 0; float bv = -3e38f; for (int k = 0; k < 128; ++k) { const float v = sc[t * 128 + k]; if (v > bv) { bv = v; bi = k; } } stop[t][r] = bv; itop[t][r] = bi; sc[t * 128 + bi] = -3e38f; } }
    __syncthreads();
    for (int i = t; i < 2048; i += 256) { const int h = i >> 8, a = (i >> 4) & 15, c = i & 15; cand[h][a * 16 + c] = stop[2 * h][a] + stop[2 * h + 1][c]; }
    __syncthreads();
    if (t < 8) { float bv[16]; float mx = -3e38f; for (int r = 0; r < 16; ++r) { int bi = 0; float v0 = -3e38f; for (int k = 0; k < 256; ++k) { const float v = cand[t][k]; if (v > v0) { v0 = v; bi = k; } }
            cand[t][bi] = -3e38f; gate[t * 16 + r] = v0; eidx[t * 16 + r] = itop[2 * t][bi >> 4] * 128 + itop[2 * t + 1][bi & 15]; mx = fmaxf(mx, v0); }
        float sm = 0.f; for (int r = 0; r < 16; ++r) { const float e = expf(gate[t * 16 + r] - mx); gate[t * 16 + r] = e; sm += e; } for (int r = 0; r < 16; ++r) gate[t * 16 + r] /= sm; }
    __syncthreads();
    const unsigned* DI = (const unsigned*)(ws + 400 * MiB); const float* DG = (const float*)(ws + 416 * MiB); const float* DC = (const float*)(ws + 432 * MiB);
    __shared__ int fidx[128]; __shared__ float fcoef[128];
    if (t < 128) { const int h = t >> 4; const unsigned fi = DI[(size_t)tok * 128 + t]; const float fg = DG[(size_t)tok * 128 + t]; int found = -1;
        for (int r = 0; r < 16; ++r) if (eidx[h * 16 + r] == (int)fi) found = r;
        if (found < 0 || fi >= (unsigned)NEXP) atomicAdd(&flags[10], 1u); else chk(flags, 11, fg, gate[h * 16 + found], 2e-3f, 1e-2f);
        const unsigned fic = fi < (unsigned)NEXP ? fi : 0u; fidx[t] = (int)fic;
        float s = 0.f; const float* ur = expert_down + (size_t)fic * DM; for (int d = 0; d < DM; ++d) s += ur[d] * (float)H2[(size_t)tok * DM + d];
        const float cref = fg * 0.5f * s * (1.f + erff(s * 0.70710678f)); const float fc = DC[(size_t)tok * 128 + t];
        chk(flags, 12, fc, cref, 2e-3f, 1e-2f); fcoef[t] = fc; }
    __syncthreads();
    float x2[4]; float ss = 0.f;
    for (int q = 0; q < 4; ++q) { const int c = t + 256 * q; float o = 0.f; for (int k = 0; k < 128; ++k) o += fcoef[k] * expert_up[(size_t)fidx[k] * DM + c];
        x2[q] = snap[(size_t)j * DM + c] + mod[b * NMOD + 5 * DM + c] * o; ss += x2[q] * x2[q]; }
    red[t] = ss; __syncthreads();
    for (int o = 128; o > 0; o >>= 1) { if (t < o) red[t] += red[t + o]; __syncthreads(); }
    const float rstd = rsqrtf(red[0] / DM + EPS);
    for (int q = 0; q < 4; ++q) { const int c = t + 256 * q; chk(flags, 13, args.out[(size_t)tok * DM + c], x2[q] * rstd * g_final[c], 2e-2f, 1e-2f); }
}
__global__ void dbg_report(Args args) {
    const unsigned* flags = (const unsigned*)(args.ws + WS_FLAGS); int id = 0;
    for (int k = 1; k < 16; ++k) if (flags[k] > ((k == 10 || k == 11) ? 40u : 0u) && !id) id = k;
    if (!id) return; float f = 1.f + 2.f * id; if (id >= 10) { const float fr = (float)flags[id] / 8192.f; f = 1.f + (float)id + 0.9f * (fr > 1.f ? 1.f : fr); }
    for (size_t i = (size_t)blockIdx.x * blockDim.x + threadIdx.x; i < (size_t)M * DM; i += (size_t)gridDim.x * blockDim.x) args.out[i] *= f;
}
#endif
extern "C" void kernel_launch(void* const* d_in, const int* in_sizes, int n_in, void* d_out, int out_size, void* d_ws, size_t ws_size, hipStream_t stream) {
    static int grid = 0;
    if (grid == 0) {
        if (n_in != 19 || out_size != M * DM || ws_size < WS_END) { fprintf(stderr, "kernel_launch: unexpected shapes (n_in %d out %d ws %zu)\n", n_in, out_size, ws_size); grid = -1; return; }
        int dev = 0, cus = 0, per_cu = 0;
        if (hipGetDevice(&dev) != hipSuccess || hipDeviceGetAttribute(&cus, hipDeviceAttributeMultiprocessorCount, dev) != hipSuccess) { grid = -1; return; }
        if (hipFuncSetAttribute((const void*)fwd_kernel, hipFuncAttributeMaxDynamicSharedMemorySize, LDS_BYTES) != hipSuccess) { fprintf(stderr, "kernel_launch: hipFuncSetAttribute failed\n"); grid = -1; return; }
        if (hipOccupancyMaxActiveBlocksPerMultiprocessor(&per_cu, (const void*)fwd_kernel, NTHR, LDS_BYTES) != hipSuccess || per_cu < 1) { fprintf(stderr, "kernel_launch: occupancy query says %d\n", per_cu); }
        (void)hipGetLastError();
        grid = cus;
    }
    if (grid < 0) return;
    (void)hipMemsetAsync((char*)d_ws + WS_CTL, 0, CTL_ZERO_BYTES, stream);
    Args a{};
    for (int i = 0; i < 19; ++i) a.in[i] = (const float*)d_in[i];
    a.out = (float*)d_out; a.ws = (unsigned char*)d_ws;
    if (N_LAUNCHES == 1) {
        a.ph_lo = 0; a.ph_hi = N_PHASES;
        void* kargs[] = {&a};
        hipError_t e = hipLaunchCooperativeKernel((const void*)fwd_kernel, dim3(grid), dim3(NTHR), kargs, LDS_BYTES, stream);
        if (e != hipSuccess) fprintf(stderr, "kernel_launch: cooperative launch failed: %s (grid %d)\n", hipGetErrorString(e), grid);
    } else {
        for (int p = 0; p < N_PHASES; ++p) { a.ph_lo = p; a.ph_hi = p + 1; hipLaunchKernelGGL(fwd_kernel, dim3(grid), dim3(NTHR), LDS_BYTES, stream, a);
#if defined(DBG_CHECK)
            if (p >= 1 && p <= 6) hipLaunchKernelGGL(dbg_check, dim3(1024), dim3(256), 0, stream, a, p);
            if (p == 0) hipLaunchKernelGGL(dbg_check, dim3(1024), dim3(256), 0, stream, a, 8);
            if (p == 6) hipLaunchKernelGGL(dbg_check, dim3(1024), dim3(256), 0, stream, a, 7);
            if (p == 7) { hipLaunchKernelGGL(dbg_check_peer, dim3(NSAMP_TOK), dim3(256), 0, stream, a); hipLaunchKernelGGL(dbg_report, dim3(1024), dim3(256), 0, stream, a); }
#endif
        }
    }
}
```

```cpp
#include <hip/hip_runtime.h>
#include <cstdio>
#include <cstdint>

#ifndef MK_N_LAUNCHES
#define MK_N_LAUNCHES 1
#endif

#define LAS __attribute__((address_space(3)))
#define GAS __attribute__((address_space(1)))
typedef unsigned short f16_t;
typedef _Float16 f16x8 __attribute__((ext_vector_type(8)));
typedef _Float16 f16x4 __attribute__((ext_vector_type(4)));
typedef _Float16 f16x2 __attribute__((ext_vector_type(2)));
typedef float f32x4 __attribute__((ext_vector_type(4)));
typedef unsigned u32x4 __attribute__((ext_vector_type(4)));
typedef unsigned u32x2 __attribute__((ext_vector_type(2)));

__device__ __forceinline__ f16x2 as_h2(unsigned u) { return __builtin_bit_cast(f16x2, u); }
__device__ __forceinline__ float as_f(unsigned u) { return __builtin_bit_cast(float, u); }
__device__ __forceinline__ unsigned as_u(float f) { return __builtin_bit_cast(unsigned, f); }
__device__ __forceinline__ unsigned pk_f16(float lo, float hi) { f16x2 v = {(_Float16)lo, (_Float16)hi}; return __builtin_bit_cast(unsigned, v); }

namespace pg8 {
constexpr int BM = 256, BK = 64, HALF = 128, HTB = HALF * BK * 2, STAGE_BYTES = 8 * HTB, NXCD = 8, WGM = 8;
__host__ __device__ __forceinline__ int lds_byte(int r, int c) { const int st = (r >> 4) * 2 + (c >> 5), rr = r & 15, cc = c & 31, ob = rr * 64 + cc * 2; return st * 1024 + (ob ^ (((ob >> 9) & 1) << 5)); }
__host__ __device__ __forceinline__ void stage_rc(int b, int& R, int& C) { const int st = b / 1024, sb = b % 1024, swz = sb ^ (((sb >> 9) & 1) << 5); R = (st >> 1) * 16 + swz / 64; C = (st & 1) * 32 + (swz % 64) / 2; }
__host__ __device__ __forceinline__ int perm32(int rho) { const int n = rho >> 4, i = rho & 15; return 8 * (i >> 2) + 4 * n + (i & 3); }
struct Unit { int pm, pn; };
struct Gemm { const f16_t* A; const f16_t* Bt; int M, N, K; };
struct StaticOrder {
    int nM, nN, nwg, G, c;
    __host__ __device__ void init(int M, int N, int G_, int c_) { nM = M / BM; nN = N / BM; nwg = nM * nN; G = G_; c = c_; }
    __host__ __device__ bool next(int i, Unit& u) const {
        const long L = (long)i * G + c; if (L >= nwg) return false;
        int wgid = (int)L; { const int q = nwg / NXCD, r = nwg % NXCD, xcd = wgid % NXCD, off = wgid / NXCD; wgid = (xcd < r ? xcd * (q + 1) : r * (q + 1) + (xcd - r) * q) + off; }
        const int nig = WGM * nN, gid = wgid / nig, fm = gid * WGM, gsz = (nM - fm) < WGM ? (nM - fm) : WGM;
        u.pm = fm + ((wgid % nig) % gsz); u.pn = (wgid % nig) / gsz; return true;
    }
    __device__ __forceinline__ void a_ready(const Unit&) const {}
    __device__ __forceinline__ void done(const Unit&) const {}
};
struct EpiF16 {
    static constexpr bool PERM = true, AFTER_DRAIN = false;
    f16_t* O; int ldc;
    __device__ __forceinline__ void operator()(const f32x4 (&acc)[2][2][4][2], const Unit& u, int wr, int wc, int fr, int fq) const {
        const int row0 = u.pm * BM + wr * 64 + fr, col0 = u.pn * BM + wc * 32 + 8 * fq;
#pragma unroll
        for (int ai = 0; ai < 2; ++ai)
#pragma unroll
            for (int m = 0; m < 4; ++m) { f16_t* rowp = O + (size_t)(row0 + ai * HALF + m * 16) * ldc + col0;
#pragma unroll
                for (int bj = 0; bj < 2; ++bj) { const f32x4 v0 = acc[ai][bj][m][0], v1 = acc[ai][bj][m][1];
                    u32x4 w; w.x = pk_f16(v0[0], v0[1]); w.y = pk_f16(v0[2], v0[3]); w.z = pk_f16(v1[0], v1[1]); w.w = pk_f16(v1[2], v1[3]);
                    *(u32x4*)(rowp + bj * HALF) = w; } }
    }
};
struct EpiF32 {
    static constexpr bool PERM = false, AFTER_DRAIN = false;
    float* C; int ldc;
    __device__ __forceinline__ void operator()(const f32x4 (&acc)[2][2][4][2], const Unit& u, int wr, int wc, int fr, int fq) const {
        const int row0 = u.pm * BM + wr * 64 + fr, col0 = u.pn * BM + wc * 32 + 4 * fq;
#pragma unroll
        for (int ai = 0; ai < 2; ++ai)
#pragma unroll
            for (int m = 0; m < 4; ++m) { float* rowp = C + (size_t)(row0 + ai * HALF + m * 16) * ldc + col0;
#pragma unroll
                for (int bj = 0; bj < 2; ++bj)
#pragma unroll
                    for (int n = 0; n < 2; ++n) *(f32x4*)(rowp + bj * HALF + n * 16) = acc[ai][bj][m][n]; }
    }
};
struct EpiRes {
    static constexpr bool PERM = false, AFTER_DRAIN = false;
    const float* X; float* O; const float* gate; int ldc;
    __device__ __forceinline__ void operator()(const f32x4 (&acc)[2][2][4][2], const Unit& u, int wr, int wc, int fr, int fq) const {
        const int row0 = u.pm * BM + wr * 64 + fr, col0 = u.pn * BM + wc * 32 + 4 * fq;
        const float* g = gate + (size_t)((u.pm * BM) >> 13) * 6144;
        f32x4 gv[2][2];
#pragma unroll
        for (int bj = 0; bj < 2; ++bj)
#pragma unroll
            for (int n = 0; n < 2; ++n) gv[bj][n] = *(const f32x4*)(g + col0 + bj * HALF + n * 16);
#pragma unroll
        for (int ai = 0; ai < 2; ++ai)
#pragma unroll
            for (int m = 0; m < 4; ++m) { const size_t off = (size_t)(row0 + ai * HALF + m * 16) * ldc + col0;
#pragma unroll
                for (int bj = 0; bj < 2; ++bj)
#pragma unroll
                    for (int n = 0; n < 2; ++n) { const f32x4 xv = *(const f32x4*)(X + off + bj * HALF + n * 16); *(f32x4*)(O + off + bj * HALF + n * 16) = xv + gv[bj][n] * acc[ai][bj][m][n]; }
                if (m & 1) asm volatile("" ::: "memory"); }
    }
};

template <class Epi, class Sched, bool ALIGN_EPI = false, bool SP2 = false>
__device__ __forceinline__ void gemm_phase(LAS unsigned char* lds, const Gemm g, const Sched& S, const Epi& E) {
    const int tid = threadIdx.x, wid = __builtin_amdgcn_readfirstlane(tid >> 6), lane = tid & 63, wr = wid >> 2, wc = wid & 3, fr = lane & 15, fq = lane >> 4;
    const int K = g.K, nt = K / BK;
    unsigned voffA[2], voffB[2];
#pragma unroll
    for (int i = 0; i < 2; ++i) { int R, C; stage_rc(tid * 16 + i * 8192, R, C); const int Rb = Epi::PERM ? ((R & ~31) + perm32(R & 31)) : R;
        voffA[i] = (unsigned)(R * K + C) * 2u; voffB[i] = (unsigned)(Rb * K + C) * 2u; }
    const size_t kstep = (size_t)(BK * 2);
    const size_t hstep = (size_t)HALF * K * 2;
    const size_t tstep = 2 * hstep;
    const unsigned ldsw = (unsigned)wid * 1024u;
    const int aoff = lds_byte(wr * 64 + fr, fq * 8), boff = lds_byte(wc * 32 + fr, fq * 8);
#define PG8_SA(b, h) (((b) * 2 + (h)) * HTB)
#define PG8_SB(b, h) ((4 + (b) * 2 + (h)) * HTB)
#define PG8_STAGE(bufoff, gbase, voff) do { _Pragma("unroll") for (int _i = 0; _i < 2; ++_i) \
        __builtin_amdgcn_global_load_lds((const unsigned*)((const char*)(gbase) + (voff)[_i]), (LAS unsigned*)(lds + (bufoff) + ldsw + _i * 8192), 16, 0, 0); } while (0)
#define PG8_LDA(dst, b, h) do { _Pragma("unroll") for (int m = 0; m < 4; ++m) _Pragma("unroll") for (int k = 0; k < 2; ++k) dst[m][k] = *(const LAS f16x8*)(lds + PG8_SA(b, h) + aoff + m * 2048 + k * 1024); } while (0)
#define PG8_LDB(dst, b, h) do { _Pragma("unroll") for (int n = 0; n < 2; ++n) _Pragma("unroll") for (int k = 0; k < 2; ++k) dst[n][k] = *(const LAS f16x8*)(lds + PG8_SB(b, h) + boff + n * 2048 + k * 1024); } while (0)
#define PG8_MMA(ai, bj, At, Bt) do { __builtin_amdgcn_s_setprio(1); _Pragma("unroll") for (int m = 0; m < 4; ++m) _Pragma("unroll") for (int n = 0; n < 2; ++n) _Pragma("unroll") for (int k = 0; k < 2; ++k) \
        acc[ai][bj][m][n] = __builtin_amdgcn_mfma_f32_16x16x32_f16(Bt[n][k], At[m][k], acc[ai][bj][m][n], 0, 0, 0); __builtin_amdgcn_s_setprio(0); } while (0)
#define PG8_WAIT_V(n) asm volatile("s_waitcnt vmcnt(" #n ")" ::: "memory")
#define PG8_WAIT_L(n) asm volatile("s_waitcnt lgkmcnt(" #n ")" ::: "memory")
#define PG8_BAR __builtin_amdgcn_s_barrier()
#define PG8_SCHED __builtin_amdgcn_sched_barrier(0)
    Unit cur, nxt; int ui = 0;
    if (!S.next(0, cur)) return;
    f32x4 acc[2][2][4][2];
#pragma unroll
    for (int a = 0; a < 2; ++a)
#pragma unroll
        for (int b = 0; b < 2; ++b)
#pragma unroll
            for (int m = 0; m < 4; ++m)
#pragma unroll
                for (int n = 0; n < 2; ++n) acc[a][b][m][n] = (f32x4){0.f, 0.f, 0.f, 0.f};
    f16x8 At[4][2], B0[2][2], B1[2][2];
    const char* cA = (const char*)g.A + (size_t)cur.pm * tstep; const char* cB = (const char*)g.Bt + (size_t)cur.pn * tstep;
    S.a_ready(cur);
    if constexpr (SP2) {
        PG8_STAGE(PG8_SB(0, 0), cB, voffB); PG8_STAGE(PG8_SB(0, 1), cB + hstep, voffB); PG8_STAGE(PG8_SA(0, 0), cA, voffA); PG8_STAGE(PG8_SA(0, 1), cA + hstep, voffA);
        if (wr == 1) PG8_BAR;
        PG8_WAIT_V(2); PG8_BAR;
        PG8_STAGE(PG8_SB(1, 0), cB + kstep, voffB); PG8_STAGE(PG8_SA(1, 0), cA + kstep, voffA); PG8_STAGE(PG8_SB(1, 1), cB + hstep + kstep, voffB);
        PG8_WAIT_V(6); PG8_BAR;
    } else {
        PG8_STAGE(PG8_SB(0, 0), cB, voffB); PG8_STAGE(PG8_SA(0, 0), cA, voffA); PG8_STAGE(PG8_SB(0, 1), cB + hstep, voffB); PG8_STAGE(PG8_SA(0, 1), cA + hstep, voffA);
        if (wr == 1) PG8_BAR;
        PG8_WAIT_V(4); PG8_BAR;
        PG8_STAGE(PG8_SB(1, 0), cB + kstep, voffB); PG8_STAGE(PG8_SA(1, 0), cA + kstep, voffA); PG8_STAGE(PG8_SB(1, 1), cB + hstep + kstep, voffB);
        PG8_WAIT_V(6); PG8_BAR;
    }
    for (;;) {
        const bool has_next = S.next(ui + 1, nxt);
        const char* nA = has_next ? (const char*)g.A + (size_t)nxt.pm * tstep : cA; const char* nB = has_next ? (const char*)g.Bt + (size_t)nxt.pn * tstep : cB;
        for (int t = 0; t < nt; t += 2) {
            const bool last = (t == nt - 2);
            const char* a1 = cA + (size_t)(t + 1) * kstep;
            const char* a2 = last ? nA : cA + (size_t)(t + 2) * kstep; const char* b2 = last ? nB : cB + (size_t)(t + 2) * kstep;
            const char* a3 = a2 + kstep; const char* b3 = b2 + kstep;
            if (last && has_next) S.a_ready(nxt);
            if constexpr (SP2) {
            PG8_LDB(B0, 0, 0); PG8_LDB(B1, 0, 1); PG8_SCHED; PG8_LDA(At, 0, 0); PG8_STAGE(PG8_SA(1, 1), a1 + hstep, voffA);
            PG8_WAIT_V(8); PG8_WAIT_L(0); PG8_BAR; PG8_MMA(0, 0, At, B0); PG8_MMA(0, 1, At, B1); PG8_BAR; PG8_SCHED;
            PG8_LDA(At, 0, 1); PG8_STAGE(PG8_SB(0, 0), b2, voffB); PG8_STAGE(PG8_SB(0, 1), b2 + hstep, voffB); PG8_STAGE(PG8_SA(0, 0), a2, voffA);
            PG8_WAIT_V(8); PG8_WAIT_L(0); PG8_BAR; PG8_MMA(1, 0, At, B0); PG8_MMA(1, 1, At, B1); PG8_BAR; PG8_SCHED;
            PG8_LDB(B0, 1, 0); PG8_LDB(B1, 1, 1); PG8_SCHED; PG8_LDA(At, 1, 0); PG8_STAGE(PG8_SA(0, 1), a2 + hstep, voffA);
            PG8_WAIT_V(8); PG8_WAIT_L(0); PG8_BAR; PG8_MMA(0, 0, At, B0); PG8_MMA(0, 1, At, B1); PG8_BAR; PG8_SCHED;
            PG8_LDA(At, 1, 1); PG8_STAGE(PG8_SB(1, 0), b3, voffB); PG8_STAGE(PG8_SB(1, 1), b3 + hstep, voffB); PG8_STAGE(PG8_SA(1, 0), a3, voffA);
            PG8_WAIT_V(8); PG8_WAIT_L(0); PG8_BAR; PG8_MMA(1, 0, At, B0); PG8_MMA(1, 1, At, B1); PG8_BAR; PG8_SCHED;
            } else {
            PG8_LDB(B0, 0, 0); PG8_SCHED; PG8_LDA(At, 0, 0); PG8_STAGE(PG8_SA(1, 1), a1 + hstep, voffA);
            PG8_WAIT_L(8); PG8_BAR; PG8_WAIT_L(0); PG8_MMA(0, 0, At, B0); PG8_BAR; PG8_SCHED;
            PG8_LDB(B1, 0, 1); PG8_STAGE(PG8_SB(0, 0), b2, voffB);
            PG8_BAR; PG8_WAIT_L(0); PG8_MMA(0, 1, At, B1); PG8_BAR;
            PG8_LDA(At, 0, 1); PG8_STAGE(PG8_SA(0, 0), a2, voffA);
            PG8_BAR; PG8_WAIT_L(0); PG8_MMA(1, 0, At, B0); PG8_BAR; PG8_SCHED;
            PG8_STAGE(PG8_SB(0, 1), b2 + hstep, voffB);
            PG8_WAIT_V(6); PG8_BAR; PG8_MMA(1, 1, At, B1); PG8_BAR;
            PG8_LDB(B0, 1, 0); PG8_SCHED; PG8_LDA(At, 1, 0); PG8_STAGE(PG8_SA(0, 1), a2 + hstep, voffA);
            PG8_WAIT_L(8); PG8_BAR; PG8_WAIT_L(0); PG8_MMA(0, 0, At, B0); PG8_BAR; PG8_SCHED;
            PG8_LDB(B1, 1, 1); PG8_STAGE(PG8_SB(1, 0), b3, voffB);
            PG8_BAR; PG8_WAIT_L(0); PG8_MMA(0, 1, At, B1); PG8_BAR;
            PG8_LDA(At, 1, 1); PG8_STAGE(PG8_SA(1, 0), a3, voffA);
            PG8_BAR; PG8_WAIT_L(0); PG8_MMA(1, 0, At, B0); PG8_BAR; PG8_SCHED;
            PG8_STAGE(PG8_SB(1, 1), b3 + hstep, voffB);
            PG8_WAIT_V(6); PG8_BAR; PG8_MMA(1, 1, At, B1); PG8_BAR;
            }
        }
        if constexpr (ALIGN_EPI) { if (wr == 0) PG8_BAR; }
        if constexpr (!Epi::AFTER_DRAIN) { E(acc, cur, wr, wc, fr, fq); S.done(cur); }
        if (!has_next) break;
#pragma unroll
        for (int a = 0; a < 2; ++a)
#pragma unroll
            for (int b = 0; b < 2; ++b)
#pragma unroll
                for (int m = 0; m < 4; ++m)
#pragma unroll
                    for (int n = 0; n < 2; ++n) acc[a][b][m][n] = (f32x4){0.f, 0.f, 0.f, 0.f};
        cur = nxt; cA = nA; cB = nB; ++ui;
        if constexpr (ALIGN_EPI) { if (wr == 1) PG8_BAR; }
    }
    PG8_WAIT_V(0);
    if constexpr (!ALIGN_EPI) { if (wr == 0) PG8_BAR; }
    PG8_BAR;
#undef PG8_SA
#undef PG8_SB
#undef PG8_STAGE
#undef PG8_LDA
#undef PG8_LDB
#undef PG8_MMA
#undef PG8_WAIT_V
#undef PG8_WAIT_L
#undef PG8_BAR
#undef PG8_SCHED
}
}

constexpr int NWAVES = 8, NTHR = NWAVES * 64;
constexpr int N_LAUNCHES = MK_N_LAUNCHES, N_PHASES = 8;
constexpr int BATCH = 4, SEQ = 8192, DM = 1024, M = BATCH * SEQ;
constexpr int NPROJ = 1536, NQK = 2048, NEXP = 16384, NMOD = 6 * DM;
constexpr float EPS = 1e-6f;

constexpr size_t MiB = 1u << 20;
constexpr size_t WS_CTL = 0, CTL_ZERO_BYTES = 64 * 1024;
constexpr size_t WS_MOD = 256 * 1024;
constexpr size_t WS_MODP = 1 * MiB;
constexpr size_t WS_WIN = 2 * MiB;
constexpr size_t WS_WOUT = 5 * MiB;
constexpr size_t WS_WQK = 7 * MiB;
constexpr size_t WS_WPOOL = 11 * MiB;
constexpr size_t WS_WSP = 11 * MiB + 256 * 1024;
constexpr size_t WS_ED = 16 * MiB, WS_EU = 32 * MiB;
constexpr size_t WS_EDS = 13 * MiB, WS_EUS = 13 * MiB + 65536;
constexpr size_t WS_H2 = 80 * MiB;
constexpr size_t WS_SC = 144 * MiB;
constexpr size_t WS_H1 = 144 * MiB, WS_PROJ = 208 * MiB, WS_MIX = 304 * MiB;
constexpr size_t WS_END = 400 * MiB;
constexpr int CW_BAR = 1024;

constexpr int RING_BYTES = 131072;
constexpr int MISC_OFF = 160 * 1024 - 256;
constexpr int LDS_BYTES = 160 * 1024;

#define RLX_AGENT __ATOMIC_RELAXED, __HIP_MEMORY_SCOPE_AGENT
#define LDS_WAIT() asm volatile("s_waitcnt lgkmcnt(0)" ::: "memory")
#define VM_WAIT() asm volatile("s_waitcnt vmcnt(0)" ::: "memory")

#define XB_TMO      128
#define XB_XCNT(j)  (256  + 64 * (j))
#define XB_XSUB(j)  (1280 + 64 * (j))
#define XB_XGEN(j)  (2304 + 64 * (j))
#define XB_TOP      3328
#define XB_TOPGEN   3392
#define XCD_BAR_WORDS 3456
#define XB_SPIN_CAP (1u << 22)
__device__ __forceinline__ unsigned xb_ld(unsigned* p)              { return __hip_atomic_load(p, __ATOMIC_RELAXED, __HIP_MEMORY_SCOPE_AGENT); }
__device__ __forceinline__ unsigned xb_add(unsigned* p, unsigned v) { return __hip_atomic_fetch_add(p, v, __ATOMIC_RELAXED, __HIP_MEMORY_SCOPE_AGENT); }
__device__ __forceinline__ unsigned xb_xcc_id() { return (unsigned)__builtin_amdgcn_s_getreg((3 << 11) | 20) & 0xFu; }
#define XB_SPIN(cond, bar) do { unsigned _sp = 0; while (cond) { __builtin_amdgcn_s_sleep(1); \
    if ((++_sp & 255u) == 0u) { if (xb_ld(&(bar)[XB_TMO])) break; if (_sp > XB_SPIN_CAP) { atomicAdd(&(bar)[XB_TMO], 1u); break; } } } } while (0)
struct XcdBarrier { unsigned* bar; unsigned x; volatile LAS unsigned* st; };
__device__ __forceinline__ XcdBarrier xcd_barrier_post(unsigned* bar, volatile LAS unsigned* st) {
    XcdBarrier b; b.bar = bar; b.x = xb_xcc_id(); b.st = st;
    if (threadIdx.x == 0) (void)xb_add(&bar[XB_XCNT(b.x)], 1u);
    return b;
}
__device__ __forceinline__ void xcd_barrier_complete(unsigned* bar, unsigned x, unsigned& nloc, unsigned& nx) {
    const unsigned G = gridDim.x * gridDim.y * gridDim.z;
    unsigned sum, cnt, mine, sp = 0u;
    for (;;) {
        sum = 0u; cnt = 0u; mine = 0u;
#pragma unroll
        for (unsigned j = 0; j < 16; ++j) { const unsigned c = xb_ld(&bar[XB_XCNT(j)]); sum += c; cnt += (c > 0u) ? 1u : 0u; mine = (j == x) ? c : mine; }
        if (sum == G) break;
        __builtin_amdgcn_s_sleep(1);
        if ((++sp & 255u) == 0u) { if (xb_ld(&bar[XB_TMO])) break; if (sp > XB_SPIN_CAP) { atomicAdd(&bar[XB_TMO], 1u); break; } }
    }
    nloc = mine > 0u ? mine : 1u; nx = cnt > 0u ? cnt : 1u;
}
__device__ __forceinline__ void xcd_barrier(const XcdBarrier& b) {
    asm volatile("s_waitcnt vmcnt(0)" ::: "memory");
    __syncthreads();
    if (threadIdx.x == 0) {
        unsigned* bar = b.bar;
        __builtin_amdgcn_s_waitcnt(0);
        unsigned nloc = b.st[0], nx = b.st[1];
        if (nloc == 0u) { xcd_barrier_complete(bar, b.x, nloc, nx); b.st[0] = nloc; b.st[1] = nx; }
        const unsigned old = xb_add(&bar[XB_XSUB(b.x)], 1u);
        const unsigned gen = old / nloc;
        if (old + 1u == (gen + 1u) * nloc) {
            __builtin_amdgcn_fence(__ATOMIC_RELEASE, "agent");
            asm volatile("s_waitcnt vmcnt(0)" ::: "memory");
            const unsigned og = xb_add(&bar[XB_TOP], 1u);
            const unsigned tg = og / nx;
            if (og + 1u == (tg + 1u) * nx) xb_add(&bar[XB_TOPGEN], 1u);
            else XB_SPIN(xb_ld(&bar[XB_TOPGEN]) == tg, bar);
            __builtin_amdgcn_fence(__ATOMIC_ACQUIRE, "agent");
            xb_add(&bar[XB_XGEN(b.x)], 1u);
            asm volatile("s_waitcnt vmcnt(0)" ::: "memory");
        } else {
            XB_SPIN(xb_ld(&bar[XB_XGEN(b.x)]) == gen, bar);
            __builtin_amdgcn_fence(__ATOMIC_ACQUIRE, "agent");
            asm volatile("s_waitcnt vmcnt(0)" ::: "memory");
        }
    }
    __syncthreads();
}

__device__ __forceinline__ float wave_sum(float v) {
#pragma unroll
    for (int o = 1; o < 64; o <<= 1) v += __shfl_xor(v, o);
    return v;
}
template <int CTRL> __device__ __forceinline__ unsigned dppu(unsigned x) { return (unsigned)__builtin_amdgcn_update_dpp((int)x, (int)x, CTRL, 0xF, 0xF, false); }
template <int CTRL> __device__ __forceinline__ float dppf(float x) { return __builtin_bit_cast(float, __builtin_amdgcn_update_dpp(__builtin_bit_cast(int, x), __builtin_bit_cast(int, x), CTRL, 0xF, 0xF, false)); }
__device__ __forceinline__ unsigned umax_(unsigned a, unsigned b) { return a > b ? a : b; }
__device__ __forceinline__ unsigned umin_(unsigned a, unsigned b) { return a < b ? a : b; }
__device__ __forceinline__ unsigned rowmax16u(unsigned x) {
    x = umax_(x, dppu<0xB1>(x)); x = umax_(x, dppu<0x4E>(x)); x = umax_(x, dppu<0x141>(x)); x = umax_(x, dppu<0x140>(x)); return x; }
__device__ __forceinline__ float rowmax16f(float x) {
    x = fmaxf(x, dppf<0xB1>(x)); x = fmaxf(x, dppf<0x4E>(x)); x = fmaxf(x, dppf<0x141>(x)); x = fmaxf(x, dppf<0x140>(x)); return x; }
__device__ __forceinline__ float rowsum16f(float x) {
    x += dppf<0xB1>(x); x += dppf<0x4E>(x); x += dppf<0x141>(x); x += dppf<0x140>(x); return x; }
__device__ __forceinline__ unsigned fkey(float f) { const unsigned u = __builtin_bit_cast(unsigned, f); return (u & 0x80000000u) ? ~u : (u | 0x80000000u); }
__device__ __forceinline__ float fval(unsigned k, unsigned lowmask) {
    unsigned u = (k & 0x80000000u) ? (k & 0x7fffffffu) : ~k; u &= ~lowmask; return __builtin_bit_cast(float, u); }
#define CE_DESC(a, b) do { const unsigned _hi = umax_(a, b), _lo = umin_(a, b); a = _hi; b = _lo; } while (0)

__device__ __forceinline__ float gelu_as(float v) {
    const float av = fabsf(v), t = __builtin_amdgcn_rcpf(av * 0.2316418882f + 1.0f);
    float q = t * 0.5307027145f + (-0.7265760135f); q = q * t + 0.7107068705f; q = q * t + (-0.142248368f); q = q * t + 0.127414796f; q = q * t;
    const float e = __builtin_amdgcn_exp2f(v * v * (-0.72134752044f)), m = v * (q * e);
    return v < 0.f ? m : v - m;
}
__device__ __forceinline__ float wave_max(float v) {
    v = fmaxf(v, dppf<0xB1>(v)); v = fmaxf(v, dppf<0x4E>(v)); v = fmaxf(v, dppf<0x141>(v)); v = fmaxf(v, dppf<0x140>(v));
    { const auto a = __builtin_amdgcn_permlane16_swap(as_u(v), as_u(v), false, false); v = fmaxf(as_f(a[0]), as_f(a[1])); }
    { const auto a = __builtin_amdgcn_permlane32_swap(as_u(v), as_u(v), false, false); v = fmaxf(as_f(a[0]), as_f(a[1])); }
    return v;
}
__device__ __forceinline__ float wave_total(float v) {
    v += dppf<0xB1>(v); v += dppf<0x4E>(v); v += dppf<0x141>(v); v += dppf<0x140>(v);
    { const auto a = __builtin_amdgcn_permlane16_swap(as_u(v), as_u(v), false, false); v = as_f(a[0]) + as_f(a[1]); }
    { const auto a = __builtin_amdgcn_permlane32_swap(as_u(v), as_u(v), false, false); v = as_f(a[0]) + as_f(a[1]); }
    return v;
}

__device__ __forceinline__ void topk_token(const float* sc, LAS unsigned* tk, LAS unsigned* pe_idx, LAS float* pe_gate, int lane) {
    const int l16 = lane & 15, row = lane >> 4, hsel = lane >> 5;
    for (int ps = 0; ps < 4; ++ps) {
        const f32x4 sa = *(const f32x4*)(sc + ps * 512 + lane * 8), sb = *(const f32x4*)(sc + ps * 512 + lane * 8 + 4);
        unsigned k0 = fkey(sa.x), k1 = fkey(sa.y), k2 = fkey(sa.z), k3 = fkey(sa.w), k4 = fkey(sb.x), k5 = fkey(sb.y), k6 = fkey(sb.z), k7 = fkey(sb.w);
        const unsigned ib = 127u - (unsigned)(l16 * 8);
        k0 = (k0 & ~127u) | (ib - 0u); k1 = (k1 & ~127u) | (ib - 1u); k2 = (k2 & ~127u) | (ib - 2u); k3 = (k3 & ~127u) | (ib - 3u);
        k4 = (k4 & ~127u) | (ib - 4u); k5 = (k5 & ~127u) | (ib - 5u); k6 = (k6 & ~127u) | (ib - 6u); k7 = (k7 & ~127u) | (ib - 7u);
        CE_DESC(k0, k1); CE_DESC(k2, k3); CE_DESC(k4, k5); CE_DESC(k6, k7);
        CE_DESC(k0, k2); CE_DESC(k1, k3); CE_DESC(k4, k6); CE_DESC(k5, k7);
        CE_DESC(k1, k2); CE_DESC(k5, k6);
        CE_DESC(k0, k4); CE_DESC(k1, k5); CE_DESC(k2, k6); CE_DESC(k3, k7);
        CE_DESC(k2, k4); CE_DESC(k3, k5);
        CE_DESC(k1, k2); CE_DESC(k3, k4); CE_DESC(k5, k6);
        unsigned top = 0u;
#pragma unroll
        for (int rr = 0; rr < 16; ++rr) {
            const unsigned m = rowmax16u(k0);
            top = (l16 == rr) ? m : top;
            const bool pop = (k0 == m);
            k0 = pop ? k1 : k0; k1 = pop ? k2 : k1; k2 = pop ? k3 : k2; k3 = pop ? k4 : k3; k4 = pop ? k5 : k4; k5 = pop ? k6 : k5; k6 = pop ? k7 : k6; k7 = pop ? 0u : k7;
        }
        tk[lane] = top;
        __builtin_amdgcn_wave_barrier(); LDS_WAIT();
        const LAS unsigned* ab = tk + 32 * hsel; const LAS unsigned* bb = ab + 16;
        const unsigned aik = ab[l16], a0k = ab[0], bik = bb[l16];
        const u32x4 bq0 = *(const LAS u32x4*)bb, bq1 = *(const LAS u32x4*)(bb + 4);
        const float vai = fval(aik, 127u), va0 = fval(a0k, 127u), vbi = fval(bik, 127u);
        const unsigned bk[8] = {bq0.x, bq0.y, bq0.z, bq0.w, bq1.x, bq1.y, bq1.z, bq1.w};
        unsigned L[8];
#pragma unroll
        for (int e = 0; e < 8; ++e) { const float sv = vai + fval(bk[e], 127u); const unsigned kk = (fkey(sv) & ~255u) | (255u - (unsigned)(l16 * 16 + e));
            L[e] = ((l16 + 1) * (e + 1) <= 16) ? kk : 0u; }
        { const float sv = va0 + vbi; const unsigned kk = (fkey(sv) & ~255u) | (255u - (unsigned)l16); L[1] = (l16 >= 8) ? kk : L[1]; }
        CE_DESC(L[0], L[1]);
        unsigned best = 0u;
#pragma unroll
        for (int rr = 0; rr < 16; ++rr) {
            const unsigned m = rowmax16u(L[0]);
            best = (l16 == rr) ? m : best;
            const bool pop = (L[0] == m);
            L[0] = pop ? L[1] : L[0]; L[1] = pop ? L[2] : L[1]; L[2] = pop ? L[3] : L[2]; L[3] = pop ? L[4] : L[3]; L[4] = pop ? L[5] : L[4]; L[5] = pop ? L[6] : L[5]; L[6] = pop ? L[7] : L[6]; L[7] = pop ? 0u : L[7];
        }
        const unsigned flat = 255u - (best & 255u), ci = flat >> 4, cj = flat & 15u;
        const unsigned ak = ab[ci], bk2 = bb[cj];
        const float sval = fval(ak, 127u) + fval(bk2, 127u);
        const unsigned eidx = (127u - (ak & 127u)) * 128u + (127u - (bk2 & 127u));
        const float mx = rowmax16f(sval), ex = __expf(sval - mx), sm = rowsum16f(ex), gt = ex / sm;
        if ((row & 1) == 0) { const int hd = 2 * ps + hsel; pe_idx[hd * 16 + l16] = eidx; pe_gate[hd * 16 + l16] = gt; }
        __builtin_amdgcn_wave_barrier(); LDS_WAIT();
    }
}

struct Args { const float* in[19]; float* out; unsigned char* ws; int ph_lo, ph_hi; };

__device__ __forceinline__ void p0_transpose_item(const float* W, int K, int N, f16_t* WT, LAS float* scr, int item, int lane) {
    const int nblk = N / 32, kb = item / nblk, nb = item % nblk, k0 = 64 * kb, n0 = 32 * nb;
#pragma unroll 8
    for (int i = 0; i < 32; ++i) { const int kk = 2 * i + (lane >> 5); scr[kk * 33 + (lane & 31)] = W[(size_t)(k0 + kk) * N + n0 + (lane & 31)]; }
    LDS_WAIT(); asm volatile("" ::: "memory");
    const int c = lane & 7;
#pragma unroll
    for (int j = 0; j < 4; ++j) { const int n = (lane >> 3) + 8 * j; const LAS float* s = scr + (8 * c) * 33 + n;
        u32x4 o; o.x = pk_f16(s[0 * 33], s[1 * 33]); o.y = pk_f16(s[2 * 33], s[3 * 33]); o.z = pk_f16(s[4 * 33], s[5 * 33]); o.w = pk_f16(s[6 * 33], s[7 * 33]);
        *(u32x4*)(WT + (size_t)(n0 + n) * K + k0 + 8 * c) = o; }
    LDS_WAIT(); asm volatile("" ::: "memory");
}

__device__ __forceinline__ void norm_rows(const float* src, f16_t* dst, const LAS float* A, const LAS float* S, int row0, int nrows, int wave, int lane) {
    for (int r = wave; r < nrows; r += NWAVES) {
        const f32x4* xr = (const f32x4*)(src + (size_t)(row0 + r) * DM) + lane;
        f32x4 v[4]; float s = 0.f;
#pragma unroll
        for (int j = 0; j < 4; ++j) { v[j] = xr[64 * j]; s += (v[j].x * v[j].x + v[j].y * v[j].y) + (v[j].z * v[j].z + v[j].w * v[j].w); }
        const float rstd = rsqrtf(wave_sum(s) * (1.f / DM) + EPS);
        unsigned long long* o8 = (unsigned long long*)(dst + (size_t)(row0 + r) * DM) + lane;
#pragma unroll
        for (int j = 0; j < 4; ++j) { const f32x4 a = *(const LAS f32x4*)(A + 4 * (64 * j + lane)), sh = *(const LAS f32x4*)(S + 4 * (64 * j + lane));
            const f32x4 h = v[j] * rstd * a + sh;
            o8[64 * j] = (unsigned long long)pk_f16(h.x, h.y) | ((unsigned long long)pk_f16(h.z, h.w) << 32); }
    }
}

__global__ void __launch_bounds__(NTHR, 2) fwd_kernel(Args args) {
    extern __shared__ __attribute__((aligned(16))) unsigned char lds_raw[];
    LAS unsigned char* lds = (LAS unsigned char*)lds_raw;
    volatile LAS unsigned* MISC = (volatile LAS unsigned*)(lds + MISC_OFF);
    const int tid = threadIdx.x, lane = tid & 63, wave = __builtin_amdgcn_readfirstlane(tid >> 6);
    const int G = gridDim.x, wg = blockIdx.x;
    unsigned char* ws = args.ws;
    unsigned* ctl = (unsigned*)(ws + WS_CTL);

    const float* x = args.in[0]; const float* cvec = args.in[1]; const float* w_ada = args.in[2]; const float* b_ada = args.in[3];
    const float* g_norm1 = args.in[4]; const float* w_in = args.in[5]; const float* w_pool = args.in[6]; const float* pool_scale = args.in[7];
    const float* sgu_ln_g = args.in[8]; const float* sgu_ln_b = args.in[9]; const float* w_spatial = args.in[10]; const float* b_spatial = args.in[11];
    const float* w_out = args.in[12]; const float* g_norm2 = args.in[13]; const float* w_query = args.in[14]; const float* sub_keys = args.in[15];
    const float* expert_down = args.in[16]; const float* expert_up = args.in[17]; const float* g_final = args.in[18];
    float* out = args.out;
    float* mod = (float*)(ws + WS_MOD); float* modp = (float*)(ws + WS_MODP);
    f16_t* WinT = (f16_t*)(ws + WS_WIN); f16_t* WoutT = (f16_t*)(ws + WS_WOUT); f16_t* WqkT = (f16_t*)(ws + WS_WQK);
    f16_t* WpoolT = (f16_t*)(ws + WS_WPOOL); f16_t* Wsp = (f16_t*)(ws + WS_WSP);
    unsigned char* Ed8 = ws + WS_ED; unsigned char* Eu8 = ws + WS_EU; float* EdS = (float*)(ws + WS_EDS); float* EuS = (float*)(ws + WS_EUS);
    f16_t* H1 = (f16_t*)(ws + WS_H1); f16_t* PROJ = (f16_t*)(ws + WS_PROJ); f16_t* MIX = (f16_t*)(ws + WS_MIX); f16_t* H2 = (f16_t*)(ws + WS_H2);
    float* SC = (float*)(ws + WS_SC);

    if (tid < 64) MISC[tid] = 0u;
    __syncthreads();
    XcdBarrier bar; bar.bar = ctl + CW_BAR; bar.x = 0; bar.st = MISC + 8;
    if (N_LAUNCHES == 1) bar = xcd_barrier_post(ctl + CW_BAR, MISC + 8);
#define GRID_BAR() do { if (N_LAUNCHES == 1) xcd_barrier(bar); } while (0)
    const int lo = args.ph_lo, hi = args.ph_hi;
#define IN(k) (lo <= (k) && (k) < hi)
#define BOTH(k) (IN(k) && IN((k) + 1))

    if (IN(0)) {
        LAS float* cact = (LAS float*)lds;
        for (int i = tid; i < BATCH * DM; i += NTHR) { const float v = cvec[i]; cact[i] = v / (1.f + __expf(-v)); }
        __syncthreads();
        const int gw = wg * NWAVES + wave, NGW = G * NWAVES;
        for (int it = gw; it < 96 * 8; it += NGW) {
            const int cc = it % 96, ks = it / 96, e = cc * 64 + lane;
            const float* wp = w_ada + (size_t)(ks * 128) * NMOD + e; const LAS float* ca = cact + ks * 128;
            float a0 = 0.f, a1 = 0.f, a2 = 0.f, a3 = 0.f;
#pragma unroll 8
            for (int k = 0; k < 128; ++k) { const float w = wp[(size_t)k * NMOD]; a0 += ca[k] * w; a1 += ca[DM + k] * w; a2 += ca[2 * DM + k] * w; a3 += ca[3 * DM + k] * w; }
            float* mp = modp + (size_t)(ks * 4) * NMOD + e; mp[0] = a0; mp[NMOD] = a1; mp[2 * NMOD] = a2; mp[3 * NMOD] = a3;
        }
        { LAS float* scr = (LAS float*)(lds + 16384 + wave * 12288);
          constexpr int I_IN = (DM / 64) * (NPROJ / 32), I_OUT = (DM / 64) * (DM / 32), I_POOL = (128 / 64) * (128 / 32);
          for (int it = gw; it < I_IN + I_OUT + 4 * I_POOL; it += NGW) {
              int r = it;
              if (r < I_IN) { p0_transpose_item(w_in, DM, NPROJ, WinT, scr, r, lane); continue; } r -= I_IN;
              if (r < I_OUT) { p0_transpose_item(w_out, DM, DM, WoutT, scr, r, lane); continue; } r -= I_OUT;
              const int g = r / I_POOL; p0_transpose_item(w_pool + g * 16384, 128, 128, WpoolT + g * 16384, scr, r % I_POOL, lane);
          } }
        { const int gt = wg * NTHR + tid, NGT = G * NTHR;
          for (int i = gt; i < 8192; i += NGT) { const int base = i * 8, t = (base >> 7) & 127, s0 = base & 127;
              const f32x4 a = *(const f32x4*)(w_spatial + base), b = *(const f32x4*)(w_spatial + base + 4);
              float v[8] = {a.x, a.y, a.z, a.w, b.x, b.y, b.z, b.w};
#pragma unroll
              for (int e = 0; e < 8; ++e) v[e] = (s0 + e <= t) ? v[e] : 0.f;
              u32x4 o; o.x = pk_f16(v[0], v[1]); o.y = pk_f16(v[2], v[3]); o.z = pk_f16(v[4], v[5]); o.w = pk_f16(v[6], v[7]);
              *(u32x4*)(Wsp + base) = o; }
          }
        for (int rowi = gw; rowi < 2 * NEXP; rowi += NGW) {
            const int tb = rowi >= NEXP, er = tb ? rowi - NEXP : rowi;
            const float* src = (tb ? expert_up : expert_down) + (size_t)er * DM;
            const f32x4 a0 = *(const f32x4*)(src + lane * 8), a1 = *(const f32x4*)(src + lane * 8 + 4), b0 = *(const f32x4*)(src + 512 + lane * 8), b1 = *(const f32x4*)(src + 512 + lane * 8 + 4);
            float m = fmaxf(fmaxf(fmaxf(fabsf(a0.x), fabsf(a0.y)), fmaxf(fabsf(a0.z), fabsf(a0.w))), fmaxf(fmaxf(fabsf(a1.x), fabsf(a1.y)), fmaxf(fabsf(a1.z), fabsf(a1.w))));
            m = fmaxf(m, fmaxf(fmaxf(fmaxf(fabsf(b0.x), fabsf(b0.y)), fmaxf(fabsf(b0.z), fabsf(b0.w))), fmaxf(fmaxf(fabsf(b1.x), fabsf(b1.y)), fmaxf(fabsf(b1.z), fabsf(b1.w)))));
            m = wave_max(m);
            const float sc = m > 0.f ? m * (1.f / 432.f) : 1.f, inv = 1.f / sc;
            int w0 = 0, w1 = 0, w2 = 0, w3 = 0;
            w0 = __builtin_amdgcn_cvt_pk_fp8_f32(a0.x * inv, a0.y * inv, w0, false); w0 = __builtin_amdgcn_cvt_pk_fp8_f32(a0.z * inv, a0.w * inv, w0, true);
            w1 = __builtin_amdgcn_cvt_pk_fp8_f32(a1.x * inv, a1.y * inv, w1, false); w1 = __builtin_amdgcn_cvt_pk_fp8_f32(a1.z * inv, a1.w * inv, w1, true);
            w2 = __builtin_amdgcn_cvt_pk_fp8_f32(b0.x * inv, b0.y * inv, w2, false); w2 = __builtin_amdgcn_cvt_pk_fp8_f32(b0.z * inv, b0.w * inv, w2, true);
            w3 = __builtin_amdgcn_cvt_pk_fp8_f32(b1.x * inv, b1.y * inv, w3, false); w3 = __builtin_amdgcn_cvt_pk_fp8_f32(b1.z * inv, b1.w * inv, w3, true);
            u32x4 o; o.x = (unsigned)w0; o.y = (unsigned)w1; o.z = (unsigned)w2; o.w = (unsigned)w3;
            *(u32x4*)((tb ? Eu8 : Ed8) + (size_t)er * 1024 + lane * 16) = o;
            if (lane == 0) (tb ? EuS : EdS)[er] = sc;
        }
        __syncthreads();
        for (int item = wg; item < 256; item += G) {
            const int hp = item >> 4, D0 = (item & 15) * 64;
            LAS float* SKs = (LAS float*)lds;
            LAS float* WQs = (LAS float*)(lds + 128 * 129 * 4);
            for (int i = tid; i < 128 * 32; i += NTHR) { const int k = i >> 5, d4 = (i & 31) * 4; const f32x4 v = *(const f32x4*)(sub_keys + (size_t)(hp * 128 + k) * 128 + d4);
                LAS float* p = SKs + k * 129 + d4; p[0] = v.x; p[1] = v.y; p[2] = v.z; p[3] = v.w; }
            for (int i = tid; i < 64 * 32; i += NTHR) { const int dd = i >> 5, d4 = (i & 31) * 4; const f32x4 v = *(const f32x4*)(w_query + (size_t)(D0 + dd) * NQK + hp * 128 + d4);
                LAS float* p = WQs + dd * 129 + d4; p[0] = v.x; p[1] = v.y; p[2] = v.z; p[3] = v.w; }
            __syncthreads();
            const int tk = tid >> 4, td = tid & 15;
            float acc[4][4];
#pragma unroll
            for (int i = 0; i < 4; ++i)
#pragma unroll
                for (int j = 0; j < 4; ++j) acc[i][j] = 0.f;
            for (int d = 0; d < 128; ++d) { float a[4], b[4];
#pragma unroll
                for (int i = 0; i < 4; ++i) { a[i] = SKs[(4 * tk + i) * 129 + d]; b[i] = WQs[(4 * td + i) * 129 + d]; }
#pragma unroll
                for (int i = 0; i < 4; ++i)
#pragma unroll
                    for (int j = 0; j < 4; ++j) acc[i][j] += a[i] * b[j]; }
#pragma unroll
            for (int i = 0; i < 4; ++i) { u32x2 o; o.x = pk_f16(acc[i][0], acc[i][1]); o.y = pk_f16(acc[i][2], acc[i][3]);
                *(u32x2*)(WqkT + (size_t)(hp * 128 + 4 * tk + i) * DM + D0 + 4 * td) = o; }
            __syncthreads();
        }
        if (BOTH(0)) GRID_BAR();
    }

    if (IN(1)) {
        LAS float* A = (LAS float*)lds; LAS float* S = A + DM;
        for (int i = wg * NTHR + tid; i < BATCH * NMOD; i += G * NTHR) { const int b = i / NMOD, e = i % NMOD; float s = b_ada[e];
#pragma unroll
            for (int ks = 0; ks < 8; ++ks) s += modp[(size_t)(ks * 4 + b) * NMOD + e];
            mod[i] = s; }
        for (int tile = wg; tile < M / 128; tile += G) {
            const int b = tile >> 6;
            __syncthreads();
            for (int c = tid; c < DM; c += NTHR) { float sh = b_ada[c], sc = b_ada[DM + c];
#pragma unroll
                for (int ks = 0; ks < 8; ++ks) { sh += modp[(size_t)(ks * 4 + b) * NMOD + c]; sc += modp[(size_t)(ks * 4 + b) * NMOD + DM + c]; }
                A[c] = g_norm1[c] * (1.f + sc); S[c] = sh; }
            __syncthreads();
            norm_rows(x, H1, A, S, tile * 128, 128, wave, lane);
        }
        if (BOTH(1)) GRID_BAR();
    }

    if (IN(2)) {
        pg8::Gemm g{H1, WinT, M, NPROJ, DM}; pg8::StaticOrder S; S.init(M, NPROJ, G, wg);
        pg8::EpiF16 E{PROJ, NPROJ};
        pg8::gemm_phase<pg8::EpiF16, pg8::StaticOrder, true, true>(lds, g, S, E);
        if (BOTH(2)) GRID_BAR();
    }

#if defined(DBG_NAIVE_P3)
    if (IN(3)) {
        LAS float* stats = (LAS float*)lds;
        for (int tile = wg; tile < M / 128; tile += G) {
            const int row0 = tile * 128;
            __syncthreads();
            for (int r = wave; r < 128; r += NWAVES) {
                const f16x8 v = *(const f16x8*)(PROJ + (size_t)(row0 + r) * NPROJ + 1024 + lane * 8);
                float s = 0.f;
                for (int e = 0; e < 8; ++e) s += (float)v[e];
                const float mean = wave_sum(s) * (1.f / 512.f); float q = 0.f;
                for (int e = 0; e < 8; ++e) { const float d = (float)v[e] - mean; q += d * d; }
                const float rstd = rsqrtf(wave_sum(q) * (1.f / 512.f) + EPS);
                if (lane == 0) { stats[2 * r] = mean; stats[2 * r + 1] = rstd; }
            }
            __syncthreads();
            const _Float16* PH = (const _Float16*)PROJ;
            for (int i = tid; i < 128 * DM; i += NTHR) {
                const int t = i >> 10, col = i & 1023, row = row0 + t, pos = row & 8191;
                float outv;
                if (col < 512) { const int g = col >> 7, d = col & 127, w = 2 << g; const int cnt = (pos + 1 < w) ? pos + 1 : w; float acc = 0.f;
                    for (int c = 0; c < 128; ++c) { float sm = 0.f; for (int j = 0; j < cnt; ++j) sm += (float)PH[(size_t)(row - j) * NPROJ + g * 128 + c];
                        const float pooled = sm / (float)cnt - (float)PH[(size_t)row * NPROJ + g * 128 + c]; acc += pooled * w_pool[(g * 128 + c) * 128 + d]; }
                    outv = acc * pool_scale[col]; }
                else { const int cc = col - 512, h = cc >> 7; float acc = 0.f;
                    for (int s2 = 0; s2 <= t; ++s2) { const float vn = ((float)PH[(size_t)(row0 + s2) * NPROJ + 1024 + cc] - stats[2 * s2]) * stats[2 * s2 + 1] * sgu_ln_g[cc] + sgu_ln_b[cc];
                        acc += w_spatial[(h * 128 + t) * 128 + s2] * vn; }
                    acc += b_spatial[h * 128 + t];
                    outv = (float)PH[(size_t)row * NPROJ + 512 + cc] * acc; }
                ((_Float16*)MIX)[(size_t)row * DM + col] = (_Float16)outv;
            }
        }
        if (BOTH(3)) GRID_BAR();
    }
#else
    if (IN(3)) {
        constexpr int PITCH = 272;
        LAS unsigned char* img = lds;
        LAS float* stats = (LAS float*)(lds + 512 * PITCH);
        const int fr = lane & 15, fq = lane >> 4;
        for (int tile = wg; tile < M / 128; tile += G) {
            const int row0 = tile * 128;
            __syncthreads();
            for (int r = wave; r < 128; r += NWAVES) {
                const f16x8 v = *(const f16x8*)(PROJ + (size_t)(row0 + r) * NPROJ + 1024 + lane * 8);
                float s = 0.f;
#pragma unroll
                for (int e = 0; e < 8; ++e) s += (float)v[e];
                const float mean = wave_sum(s) * (1.f / 512.f); float q = 0.f;
#pragma unroll
                for (int e = 0; e < 8; ++e) { const float d = (float)v[e] - mean; q += d * d; }
                const float rstd = rsqrtf(wave_sum(q) * (1.f / 512.f) + EPS);
                if (lane == 0) { stats[2 * r] = mean; stats[2 * r + 1] = rstd; }
            }
            __syncthreads();
            { const int cp = tid & 255; const float g0 = sgu_ln_g[2 * cp], g1 = sgu_ln_g[2 * cp + 1], b0 = sgu_ln_b[2 * cp], b1 = sgu_ln_b[2 * cp + 1];
              for (int sb = tid >> 8; sb < 16; sb += 2) {
                  float v0[8], v1[8];
#pragma unroll
                  for (int e = 0; e < 8; ++e) { const int s = sb * 8 + e; const f16x2 hv = *(const f16x2*)(PROJ + (size_t)(row0 + s) * NPROJ + 1024 + 2 * cp);
                      const float mean = stats[2 * s], rstd = stats[2 * s + 1];
                      v0[e] = ((float)hv.x - mean) * rstd * g0 + b0; v1[e] = ((float)hv.y - mean) * rstd * g1 + b1; }
                  u32x4 o0, o1; o0.x = pk_f16(v0[0], v0[1]); o0.y = pk_f16(v0[2], v0[3]); o0.z = pk_f16(v0[4], v0[5]); o0.w = pk_f16(v0[6], v0[7]);
                  o1.x = pk_f16(v1[0], v1[1]); o1.y = pk_f16(v1[2], v1[3]); o1.z = pk_f16(v1[4], v1[5]); o1.w = pk_f16(v1[6], v1[7]);
                  *(LAS u32x4*)(img + (2 * cp) * PITCH + sb * 16) = o0; *(LAS u32x4*)(img + (2 * cp + 1) * PITCH + sb * 16) = o1; } }
            __syncthreads();
            { const int h = wave >> 1, th = wave & 1, t0 = 64 * th;
              const int nks = th ? 4 : 2;
#pragma unroll 1
              for (int ch = 0; ch < 2; ++ch) {
                  f32x4 acc[4][4];
#pragma unroll
                  for (int m = 0; m < 4; ++m)
#pragma unroll
                      for (int n = 0; n < 4; ++n) acc[m][n] = (f32x4){0.f, 0.f, 0.f, 0.f};
                  const f16_t* wbase = Wsp + (size_t)(h * 128 + t0 + fr) * 128 + 8 * fq;
                  const LAS unsigned char* vbase = img + (h * 128 + 64 * ch + fr) * PITCH + 16 * fq;
#pragma unroll 1
                  for (int ks = 0; ks < nks; ++ks) {
                      f16x8 wf[4], vf[4];
#pragma unroll
                      for (int m = 0; m < 4; ++m) wf[m] = *(const f16x8*)(wbase + (16 * m) * 128 + 32 * ks);
#pragma unroll
                      for (int n = 0; n < 4; ++n) vf[n] = *(const LAS f16x8*)(vbase + (16 * n) * PITCH + 64 * ks);
#pragma unroll
                      for (int m = 0; m < 4; ++m)
#pragma unroll
                          for (int n = 0; n < 4; ++n) acc[m][n] = __builtin_amdgcn_mfma_f32_16x16x32_f16(vf[n], wf[m], acc[m][n], 0, 0, 0);
                  }
#pragma unroll
                  for (int m = 0; m < 4; ++m) { const int t = t0 + 16 * m + fr; const float bs = b_spatial[h * 128 + t];
                      const int cb0 = h * 128 + 64 * ch + 4 * fq;
                      const f16_t* up = PROJ + (size_t)(row0 + t) * NPROJ + 512 + cb0; f16_t* op = MIX + (size_t)(row0 + t) * DM + 512 + cb0;
#pragma unroll
                      for (int n = 0; n < 4; ++n) {
                          const f16x4 u = *(const f16x4*)(up + 16 * n);
                          u32x2 o; o.x = pk_f16((float)u[0] * (acc[m][n][0] + bs), (float)u[1] * (acc[m][n][1] + bs)); o.y = pk_f16((float)u[2] * (acc[m][n][2] + bs), (float)u[3] * (acc[m][n][3] + bs));
                          *(u32x2*)(op + 16 * n) = o; } }
              } }
            __syncthreads();
            { const int cp = tid & 255, thh = tid >> 8, g = cp >> 6, w = 2 << g, cl = (2 * cp) & 127;
              const int p0 = (tile & 63) * 128;
              const f16_t* ap = PROJ + (size_t)row0 * NPROJ + 2 * cp;
              float s0 = 0.f, s1 = 0.f;
              const int tt0 = 64 * thh;
              for (int j = 1; j <= w; ++j) { if (p0 + tt0 - j >= 0) { const f16x2 hv = *(const f16x2*)(ap + (ptrdiff_t)(tt0 - j) * NPROJ); s0 += (float)hv.x; s1 += (float)hv.y; } }
              for (int tb = 0; tb < 64; tb += 8) {
                  f16x2 cur[8], old[8];
#pragma unroll
                  for (int e = 0; e < 8; ++e) { const int tt = tt0 + tb + e; cur[e] = *(const f16x2*)(ap + (ptrdiff_t)tt * NPROJ);
                      const bool ok = (p0 + tt - w >= 0); old[e] = ok ? *(const f16x2*)(ap + (ptrdiff_t)(tt - w) * NPROJ) : (f16x2){(_Float16)0.f, (_Float16)0.f}; }
#pragma unroll
                  for (int e = 0; e < 8; ++e) { const int tt = tt0 + tb + e; const int pos = p0 + tt + 1;
                      s0 += (float)cur[e].x; s1 += (float)cur[e].y; s0 -= (float)old[e].x; s1 -= (float)old[e].y;
                      const float inv = 1.f / (float)(pos < w ? pos : w);
                      *(LAS unsigned*)(img + (g * 128 + tt) * PITCH + cl * 2) = pk_f16(s0 * inv - (float)cur[e].x, s1 * inv - (float)cur[e].y); }
              } }
            __syncthreads();
            { const int g = wave >> 1, th = wave & 1, t0 = 64 * th;
#pragma unroll 1
              for (int ch = 0; ch < 2; ++ch) {
                  f32x4 acc[4][4];
#pragma unroll
                  for (int m = 0; m < 4; ++m)
#pragma unroll
                      for (int n = 0; n < 4; ++n) acc[m][n] = (f32x4){0.f, 0.f, 0.f, 0.f};
                  const LAS unsigned char* pbase = img + (g * 128 + t0 + fr) * PITCH + 16 * fq;
                  const f16_t* wbase = WpoolT + (size_t)(g * 128 + 64 * ch + fr) * 128 + 8 * fq;
#pragma unroll 1
                  for (int ks = 0; ks < 4; ++ks) {
                      f16x8 pf[4], wf[4];
#pragma unroll
                      for (int m = 0; m < 4; ++m) pf[m] = *(const LAS f16x8*)(pbase + (16 * m) * PITCH + 64 * ks);
#pragma unroll
                      for (int n = 0; n < 4; ++n) wf[n] = *(const f16x8*)(wbase + (16 * n) * 128 + 32 * ks);
#pragma unroll
                      for (int m = 0; m < 4; ++m)
#pragma unroll
                          for (int n = 0; n < 4; ++n) acc[m][n] = __builtin_amdgcn_mfma_f32_16x16x32_f16(wf[n], pf[m], acc[m][n], 0, 0, 0);
                  }
                  const int cb0 = g * 128 + 64 * ch + 4 * fq;
#pragma unroll
                  for (int m = 0; m < 4; ++m) { const int t = t0 + 16 * m + fr; f16_t* op = MIX + (size_t)(row0 + t) * DM + cb0;
#pragma unroll
                      for (int n = 0; n < 4; ++n) { const f32x4 ps = *(const f32x4*)(pool_scale + cb0 + 16 * n);
                          u32x2 o; o.x = pk_f16(acc[m][n][0] * ps.x, acc[m][n][1] * ps.y); o.y = pk_f16(acc[m][n][2] * ps.z, acc[m][n][3] * ps.w);
                          *(u32x2*)(op + 16 * n) = o; } }
              } }
        }
        if (BOTH(3)) GRID_BAR();
    }
#endif

    if (IN(4)) {
        pg8::Gemm g{MIX, WoutT, M, DM, DM}; pg8::StaticOrder S; S.init(M, DM, G, wg);
        pg8::EpiRes E{x, out, mod + 2 * DM, DM};
        pg8::gemm_phase<pg8::EpiRes, pg8::StaticOrder, true, true>(lds, g, S, E);
        if (BOTH(4)) GRID_BAR();
    }

    if (IN(5)) {
        LAS float* A = (LAS float*)lds; LAS float* S = A + DM;
        for (int tile = wg; tile < M / 128; tile += G) {
            const int b = tile >> 6;
            __syncthreads();
            for (int c = tid; c < DM; c += NTHR) { A[c] = g_norm2[c] * (1.f + mod[b * NMOD + 4 * DM + c]); S[c] = mod[b * NMOD + 3 * DM + c]; }
            __syncthreads();
            norm_rows(out, H2, A, S, tile * 128, 128, wave, lane);
        }
        if (BOTH(5)) GRID_BAR();
    }

    if (IN(6)) {
        pg8::Gemm g{H2, WqkT, M, NQK, DM}; pg8::StaticOrder S; S.init(M, NQK, G, wg);
        pg8::EpiF32 E{SC, NQK};
        pg8::gemm_phase<pg8::EpiF32, pg8::StaticOrder, true, true>(lds, g, S, E);
        if (BOTH(6)) GRID_BAR();
    }

    if (IN(7)) {
        constexpr int TT = 2; static_assert(TT == 2, "the sweeps are written out for two tokens");
        const __amdgpu_buffer_rsrc_t rsD = __builtin_amdgcn_make_buffer_rsrc((void*)Ed8, 0, NEXP * 1024, 0x00020000), rsU = __builtin_amdgcn_make_buffer_rsrc((void*)Eu8, 0, NEXP * 1024, 0x00020000);
        const unsigned lane16 = (unsigned)lane * 16u;
        LAS float* G2 = (LAS float*)lds; LAS float* GF = G2 + DM;
        LAS unsigned* wl = (LAS unsigned*)(lds + 8192 + wave * 8192);
        LAS unsigned* tk = wl; LAS unsigned* pe_idx = wl + 256; LAS float* pe_gate = (LAS float*)(wl + 256 + TT * 128);
        for (int tile = wg; tile < M / 128; tile += G) {
            const int b = tile >> 6;
            __syncthreads();
            for (int c = tid; c < DM; c += NTHR) { G2[c] = mod[b * NMOD + 5 * DM + c]; GF[c] = g_final[c]; }
            __syncthreads();
#pragma unroll 1
            for (int rnd = 0; rnd < 16 / TT; ++rnd) {
                const int tok0 = tile * 128 + wave + NWAVES * (rnd * TT);
#pragma unroll 1
                for (int t = 0; t < TT; ++t) {
                    LAS unsigned* pi = pe_idx + t * 128; LAS float* pg = pe_gate + t * 128;
                    topk_token(SC + (size_t)(tok0 + NWAVES * t) * NQK, tk, pi, pg, lane);
                    const unsigned ia = pi[lane], ib = pi[64 + lane]; const float ga = pg[lane], gb = pg[64 + lane];
                    unsigned posA = 0, posB = 0, base = 0;
#pragma unroll
                    for (int bd = 0; bd < 16; ++bd) { const bool inA = (ia >> 10) == (unsigned)bd, inB = (ib >> 10) == (unsigned)bd;
                        const unsigned long long ma = __ballot(inA), mb = __ballot(inB);
                        const unsigned ra = __builtin_amdgcn_mbcnt_hi((unsigned)(ma >> 32), __builtin_amdgcn_mbcnt_lo((unsigned)ma, 0u)), rb = __builtin_amdgcn_mbcnt_hi((unsigned)(mb >> 32), __builtin_amdgcn_mbcnt_lo((unsigned)mb, 0u));
                        const unsigned ca = (unsigned)__builtin_popcountll(ma), cb = (unsigned)__builtin_popcountll(mb);
                        posA = inA ? base + ra : posA; posB = inB ? base + ca + rb : posB; base += ca + cb; }
                    __builtin_amdgcn_wave_barrier(); LDS_WAIT();
                    pi[posA] = ia; pi[posB] = ib; pg[posA] = ga; pg[posB] = gb;
                    __builtin_amdgcn_wave_barrier(); LDS_WAIT();
                }
                unsigned idxA[TT], idxB[TT]; float gA[TT], gB[TT], preA[TT], preB[TT]; u32x4 hA[TT], hB[TT];
#pragma unroll
                for (int t = 0; t < TT; ++t) { idxA[t] = pe_idx[t * 128 + lane]; idxB[t] = pe_idx[t * 128 + 64 + lane]; gA[t] = pe_gate[t * 128 + lane]; gB[t] = pe_gate[t * 128 + 64 + lane];
                    const f16_t* hp = H2 + (size_t)(tok0 + NWAVES * t) * DM; hA[t] = *(const u32x4*)(hp + lane * 8); hB[t] = *(const u32x4*)(hp + 512 + lane * 8); preA[t] = 0.f; preB[t] = 0.f; }
                const int rsel = (lane & 7) * 8;
#define CVT8(u, hi) __builtin_amdgcn_cvt_scalef32_pk_f16_fp8((u), 1.0f, (hi))
#define ISSUE(BUF, IDX, L0, RS) do { _Pragma("unroll") for (int j = 0; j < 8; ++j) { const unsigned _e = (unsigned)__builtin_amdgcn_readlane((int)(IDX), (L0) + j); \
            BUF[j] = __builtin_amdgcn_raw_buffer_load_b128(RS, lane16, _e * 1024u, 0); } } while (0)
#define DOT16(R, T, OUT) do { const u32x4 _r = (R); float _sd = 0.f; \
        _sd = __builtin_amdgcn_fdot2(CVT8(_r.x, false), as_h2(hA[T].x), _sd, false); _sd = __builtin_amdgcn_fdot2(CVT8(_r.x, true), as_h2(hA[T].y), _sd, false); \
        _sd = __builtin_amdgcn_fdot2(CVT8(_r.y, false), as_h2(hA[T].z), _sd, false); _sd = __builtin_amdgcn_fdot2(CVT8(_r.y, true), as_h2(hA[T].w), _sd, false); \
        _sd = __builtin_amdgcn_fdot2(CVT8(_r.z, false), as_h2(hB[T].x), _sd, false); _sd = __builtin_amdgcn_fdot2(CVT8(_r.z, true), as_h2(hB[T].y), _sd, false); \
        _sd = __builtin_amdgcn_fdot2(CVT8(_r.w, false), as_h2(hB[T].z), _sd, false); _sd = __builtin_amdgcn_fdot2(CVT8(_r.w, true), as_h2(hB[T].w), _sd, false); OUT = _sd; __builtin_amdgcn_sched_barrier(0); } while (0)
#define CONSUME_DOWN(BUF, T, PREA, PREB, CA, CB) do { float _p[8]; _Pragma("unroll") for (int j = 0; j < 8; ++j) DOT16(BUF[j], T, _p[j]); \
        _Pragma("unroll") for (int j = 0; j < 4; ++j) { const auto _s = __builtin_amdgcn_permlane32_swap(as_u(_p[j]), as_u(_p[j + 4]), false, false); _p[j] = as_f(_s[0]) + as_f(_s[1]); } \
        _Pragma("unroll") for (int j = 0; j < 2; ++j) { const auto _s = __builtin_amdgcn_permlane16_swap(as_u(_p[j]), as_u(_p[j + 2]), false, false); _p[j] = as_f(_s[0]) + as_f(_s[1]); } \
        { const bool _up = (lane & 8) != 0; const float _keep = _up ? _p[1] : _p[0], _send = _up ? _p[0] : _p[1]; float _v = _keep + dppf<0x128>(_send); \
          _v += dppf<0xB1>(_v); _v += dppf<0x4E>(_v); _v += dppf<0x141>(_v); \
          const float _g = __shfl(_v, rsel); PREA = ((lane >> 3) == (CA)) ? _g : PREA; PREB = ((lane >> 3) == (CB)) ? _g : PREB; } } while (0)
#define FMIX(ACC, Q, CSV) do { asm("v_fma_mix_f32 %0, %1, %2, %0 op_sel_hi:[1,0,0]" : "+v"(ACC[0]) : "v"(Q), "s"(CSV)); asm("v_fma_mix_f32 %0, %1, %2, %0 op_sel:[1,0,0] op_sel_hi:[1,0,0]" : "+v"(ACC[1]) : "v"(Q), "s"(CSV)); } while (0)
#define UP_SLOT(R, T, CS) do { const u32x4 _r = (R); const float _cs = (CS); \
        { const f16x2 q0 = CVT8(_r.x, false), q1 = CVT8(_r.x, true), q2 = CVT8(_r.y, false), q3 = CVT8(_r.y, true); \
          FMIX((&acc[T][0]), q0, _cs); FMIX((&acc[T][2]), q1, _cs); FMIX((&acc[T][4]), q2, _cs); FMIX((&acc[T][6]), q3, _cs); } \
        { const f16x2 q4 = CVT8(_r.z, false), q5 = CVT8(_r.z, true), q6 = CVT8(_r.w, false), q7 = CVT8(_r.w, true); \
          FMIX((&acc[T][8]), q4, _cs); FMIX((&acc[T][10]), q5, _cs); FMIX((&acc[T][12]), q6, _cs); FMIX((&acc[T][14]), q7, _cs); } \
        __builtin_amdgcn_sched_barrier(0); } while (0)
#define CONSUME_UP(BUF, T, COEF, L0) do { _Pragma("unroll") for (int j = 0; j < 8; ++j) UP_SLOT(BUF[j], T, as_f((unsigned)__builtin_amdgcn_readlane((int)as_u(COEF), (L0) + j))); } while (0)
                u32x4 bufA[8], bufB[8], bufC[8], bufD[8];
#define SELI(T, C) ((C) < 8 ? idxA[T] : idxB[T])
#define SELC(T, C) ((C) < 8 ? coefA[T] : coefB[T])
#define L0OF(C) (8 * ((C) & 7))
#define CAOF(C) ((C) < 8 ? (C) : 99)
#define CBOF(C) ((C) < 8 ? 99 : (C) - 8)
                ISSUE(bufA, idxA[0], 0, rsD); ISSUE(bufB, idxA[1], 0, rsD); ISSUE(bufC, idxA[0], 8, rsD);
#pragma unroll 1
                for (int c0 = 0; c0 < 16; c0 += 2) { const int c1 = c0 + 1, c2 = c0 < 14 ? c0 + 2 : 15, c3 = c0 < 14 ? c0 + 3 : 15;
                    ISSUE(bufD, SELI(1, c1), L0OF(c1), rsD); CONSUME_DOWN(bufA, 0, preA[0], preB[0], CAOF(c0), CBOF(c0));
                    ISSUE(bufA, SELI(0, c2), L0OF(c2), rsD); CONSUME_DOWN(bufB, 1, preA[1], preB[1], CAOF(c0), CBOF(c0));
                    ISSUE(bufB, SELI(1, c2), L0OF(c2), rsD); CONSUME_DOWN(bufC, 0, preA[0], preB[0], CAOF(c1), CBOF(c1));
                    ISSUE(bufC, SELI(0, c3), L0OF(c3), rsD); CONSUME_DOWN(bufD, 1, preA[1], preB[1], CAOF(c1), CBOF(c1)); }
                float coefA[TT], coefB[TT];
#pragma unroll
                for (int t = 0; t < TT; ++t) { const float pa = preA[t] * EdS[idxA[t]], pb = preB[t] * EdS[idxB[t]];
                    coefA[t] = gA[t] * gelu_as(pa) * EuS[idxA[t]]; coefB[t] = gB[t] * gelu_as(pb) * EuS[idxB[t]]; }
                float acc[TT][16];
#pragma unroll
                for (int t = 0; t < TT; ++t)
#pragma unroll
                    for (int j = 0; j < 16; ++j) acc[t][j] = 0.f;
                ISSUE(bufA, idxA[0], 0, rsU); ISSUE(bufB, idxA[1], 0, rsU); ISSUE(bufC, idxA[0], 8, rsU);
#pragma unroll 1
                for (int c0 = 0; c0 < 16; c0 += 2) { const int c1 = c0 + 1, c2 = c0 < 14 ? c0 + 2 : 15, c3 = c0 < 14 ? c0 + 3 : 15;
                    ISSUE(bufD, SELI(1, c1), L0OF(c1), rsU); CONSUME_UP(bufA, 0, SELC(0, c0), L0OF(c0));
                    ISSUE(bufA, SELI(0, c2), L0OF(c2), rsU); CONSUME_UP(bufB, 1, SELC(1, c0), L0OF(c0));
                    ISSUE(bufB, SELI(1, c2), L0OF(c2), rsU); CONSUME_UP(bufC, 0, SELC(0, c1), L0OF(c1));
                    ISSUE(bufC, SELI(0, c3), L0OF(c3), rsU); CONSUME_UP(bufD, 1, SELC(1, c1), L0OF(c1)); }
#undef CBOF
#undef CAOF
#undef L0OF
#undef SELC
#undef SELI
#undef CONSUME_UP
#undef UP_SLOT
#undef FMIX
#undef CONSUME_DOWN
#undef DOT16
#undef ISSUE
#undef CVT8
#pragma unroll
                for (int t = 0; t < TT; ++t) {
                    float* orow = out + (size_t)(tok0 + NWAVES * t) * DM;
                    f32x4 xv[4]; xv[0] = *(const f32x4*)(orow + lane * 8); xv[1] = *(const f32x4*)(orow + lane * 8 + 4); xv[2] = *(const f32x4*)(orow + 512 + lane * 8); xv[3] = *(const f32x4*)(orow + 512 + lane * 8 + 4);
                    float ss = 0.f;
#pragma unroll
                    for (int q = 0; q < 4; ++q) { const int cb = (q >> 1) * 512 + lane * 8 + (q & 1) * 4; const f32x4 g2 = *(const LAS f32x4*)(G2 + cb);
                        xv[q].x += g2.x * acc[t][4 * q + 0]; xv[q].y += g2.y * acc[t][4 * q + 1]; xv[q].z += g2.z * acc[t][4 * q + 2]; xv[q].w += g2.w * acc[t][4 * q + 3];
                        ss += (xv[q].x * xv[q].x + xv[q].y * xv[q].y) + (xv[q].z * xv[q].z + xv[q].w * xv[q].w); }
                    const float rstd = rsqrtf(wave_total(ss) * (1.f / DM) + EPS);
#pragma unroll
                    for (int q = 0; q < 4; ++q) { const int cb = (q >> 1) * 512 + lane * 8 + (q & 1) * 4; const f32x4 gf = *(const LAS f32x4*)(GF + cb);
                        *(f32x4*)(orow + cb) = xv[q] * rstd * gf; }
                    __builtin_amdgcn_sched_barrier(0);
                }
            }
        }
    }
#undef IN
#undef BOTH
#undef GRID_BAR
}


#if defined(DBG_CHECK)
constexpr size_t WS_FLAGS = 32 * 1024, WS_SNAP = 12 * MiB;
constexpr int NSAMP_TOK = 64;
__device__ __forceinline__ unsigned hash32(unsigned x) { x ^= x >> 16; x *= 0x7feb352du; x ^= x >> 15; x *= 0x846ca68bu; x ^= x >> 16; return x; }
__device__ __forceinline__ void chk(unsigned* flags, int id, float got, float ref, float atol, float rtol) { if (!(fabsf(got - ref) <= atol + rtol * fabsf(ref))) atomicAdd(&flags[id], 1u); }
__device__ __forceinline__ int samp_tok(int j) { return (j < 8) ? j * 4681 % M : (j < 16 ? ((j - 8) & 3) * 8192 + (j & 1) * 127 + (j >> 2 & 1) * 4000 : (int)(hash32(j * 977u + 5u) % M)); }
__global__ void dbg_check(Args args, int which) {
    unsigned char* ws = args.ws; unsigned* flags = (unsigned*)(ws + WS_FLAGS);
    const float* x = args.in[0]; const float* cvec = args.in[1]; const float* w_ada = args.in[2]; const float* b_ada = args.in[3];
    const float* g_norm1 = args.in[4]; const float* w_in = args.in[5]; const float* w_pool = args.in[6]; const float* pool_scale = args.in[7];
    const float* sgu_ln_g = args.in[8]; const float* sgu_ln_b = args.in[9]; const float* w_spatial = args.in[10]; const float* b_spatial = args.in[11];
    const float* w_out = args.in[12]; const float* g_norm2 = args.in[13]; const float* w_query = args.in[14]; const float* sub_keys = args.in[15];
    const float* expert_down = args.in[16]; const float* expert_up = args.in[17]; const float* g_final = args.in[18];
    const float* mod = (const float*)(ws + WS_MOD);
    const _Float16* H1 = (const _Float16*)(ws + WS_H1); const _Float16* PROJ = (const _Float16*)(ws + WS_PROJ); const _Float16* MIX = (const _Float16*)(ws + WS_MIX); const _Float16* H2 = (const _Float16*)(ws + WS_H2);
    const float* SC = (const float*)(ws + WS_SC); float* snap = (float*)(ws + WS_SNAP); const float* out = args.out;
    const unsigned gt = blockIdx.x * blockDim.x + threadIdx.x, NGT = gridDim.x * blockDim.x;
    if (which == 1) {
        for (unsigned i = gt; i < BATCH * NMOD; i += NGT) { const int b = i / NMOD, e = i % NMOD; float s = b_ada[e];
            for (int d = 0; d < DM; ++d) { const float c = cvec[b * DM + d]; s += (c / (1.f + expf(-c))) * w_ada[(size_t)d * NMOD + e]; }
            chk(flags, 1, mod[i], s, 1e-3f, 1e-3f); }
    } else if (which == 2) {
        for (unsigned i = gt; i < 4096 * 16; i += NGT) { const int row = hash32(i >> 4) % M, c0 = (i & 15) * 64, b = row >> 13; float ss = 0.f;
            for (int c = 0; c < DM; ++c) { const float v = x[(size_t)row * DM + c]; ss += v * v; }
            const float rstd = rsqrtf(ss / DM + EPS);
            for (int c = c0; c < c0 + 64; ++c) { const float ref = x[(size_t)row * DM + c] * rstd * g_norm1[c] * (1.f + mod[b * NMOD + DM + c]) + mod[b * NMOD + c];
                chk(flags, 2, (float)H1[(size_t)row * DM + c], ref, 4e-3f, 2e-3f); } }
    } else if (which == 3) {
        for (unsigned i = gt; i < 65536; i += NGT) { const unsigned h = hash32(i * 3u + 1u); const int row = h % M, col = (h >> 15) % NPROJ; float s = 0.f;
            for (int k = 0; k < DM; ++k) s += (float)H1[(size_t)row * DM + k] * w_in[(size_t)k * NPROJ + col];
            chk(flags, 3, (float)PROJ[(size_t)row * NPROJ + col], s, 1e-2f, 5e-3f); }
    } else if (which == 4) {
        for (unsigned i = gt; i < 32768; i += NGT) { const unsigned h = hash32(i * 5u + 2u); const int row = (i < 2048) ? ((i & 7) * 8192 % M + (i >> 3) % 32) : (int)(h % M), col = (h >> 15) % DM, pos = row & 8191; float ref;
            if (col < 512) { const int g = col >> 7, d = col & 127, w = 2 << g; const int cnt = (pos + 1 < w) ? pos + 1 : w; float acc = 0.f;
                for (int c = 0; c < 128; ++c) { float sm = 0.f; for (int j = 0; j < cnt; ++j) sm += (float)PROJ[(size_t)(row - j) * NPROJ + g * 128 + c];
                    acc += (sm / (float)cnt - (float)PROJ[(size_t)row * NPROJ + g * 128 + c]) * w_pool[(g * 128 + c) * 128 + d]; }
                ref = acc * pool_scale[col]; }
            else { const int cc = col - 512, hh = cc >> 7, t = row & 127, r0 = row - t; float acc = 0.f;
                for (int s2 = 0; s2 <= t; ++s2) { float mean = 0.f, var = 0.f; const _Float16* vr = PROJ + (size_t)(r0 + s2) * NPROJ + 1024;
                    for (int k = 0; k < 512; ++k) mean += (float)vr[k]; mean /= 512.f; for (int k = 0; k < 512; ++k) { const float dd = (float)vr[k] - mean; var += dd * dd; }
                    const float vn = ((float)vr[cc] - mean) * rsqrtf(var / 512.f + EPS) * sgu_ln_g[cc] + sgu_ln_b[cc]; acc += w_spatial[(hh * 128 + t) * 128 + s2] * vn; }
                ref = (float)PROJ[(size_t)row * NPROJ + 512 + cc] * (acc + b_spatial[hh * 128 + t]); }
            chk(flags, 4, (float)MIX[(size_t)row * DM + col], ref, 3e-2f, 1e-2f); }
    } else if (which == 5) {
        for (unsigned i = gt; i < 65536; i += NGT) { const unsigned h = hash32(i * 7u + 3u); const int row = h % M, col = (h >> 15) % DM, b = row >> 13; float s = 0.f;
            for (int k = 0; k < DM; ++k) s += (float)MIX[(size_t)row * DM + k] * w_out[(size_t)k * DM + col];
            chk(flags, 5, out[(size_t)row * DM + col], x[(size_t)row * DM + col] + mod[b * NMOD + 2 * DM + col] * s, 2e-2f, 5e-3f); }
    } else if (which == 6) {
        for (unsigned i = gt; i < 4096 * 16; i += NGT) { const int row = hash32((i >> 4) + 777u) % M, c0 = (i & 15) * 64, b = row >> 13; float ss = 0.f;
            for (int c = 0; c < DM; ++c) { const float v = out[(size_t)row * DM + c]; ss += v * v; }
            const float rstd = rsqrtf(ss / DM + EPS);
            for (int c = c0; c < c0 + 64; ++c) { const float ref = out[(size_t)row * DM + c] * rstd * g_norm2[c] * (1.f + mod[b * NMOD + 4 * DM + c]) + mod[b * NMOD + 3 * DM + c];
                chk(flags, 6, (float)H2[(size_t)row * DM + c], ref, 4e-3f, 2e-3f); } }
        for (unsigned i = gt; i < NSAMP_TOK * DM; i += NGT) snap[i] = out[(size_t)samp_tok(i / DM) * DM + (i % DM)];
    } else if (which == 8) {
        const _Float16* Ed = (const _Float16*)(ws + WS_ED); const _Float16* Eu = (const _Float16*)(ws + WS_EU);
        for (unsigned i = gt; i < 262144; i += NGT) { const size_t j = (size_t)(hash32(i * 13u + 6u) % (unsigned)(NEXP * DM));
            chk(flags, 8, (float)Ed[j], expert_down[j], 1e-5f, 1e-3f); chk(flags, 8, (float)Eu[j], expert_up[j], 1e-5f, 1e-3f); }
    } else if (which == 7) {
        for (unsigned i = gt; i < 16384; i += NGT) { const unsigned h = hash32(i * 11u + 4u); const int row = h % M, n = (h >> 15) % NQK, hp = n >> 7, k = n & 127; float s = 0.f;
            for (int d = 0; d < 128; ++d) { float q = 0.f; for (int kk = 0; kk < DM; ++kk) q += (float)H2[(size_t)row * DM + kk] * w_query[(size_t)kk * NQK + hp * 128 + d];
                s += q * sub_keys[(size_t)(hp * 128 + k) * 128 + d]; }
            chk(flags, 7, SC[(size_t)row * NQK + n], s, 2e-2f, 5e-3f); }
    }
}
__global__ void dbg_check_peer(Args args) {
    __shared__ float sc[2048]; __shared__ float stop[16][16]; __shared__ int itop[16][16]; __shared__ float cand[8][256]; __shared__ float gate[128]; __shared__ int eidx[128]; __shared__ float red[256];
    unsigned char* ws = args.ws; unsigned* flags = (unsigned*)(ws + WS_FLAGS);
    const float* expert_down = args.in[16]; const float* expert_up = args.in[17]; const float* g_final = args.in[18];
    const float* mod = (const float*)(ws + WS_MOD); const _Float16* H2 = (const _Float16*)(ws + WS_H2); const float* SC = (const float*)(ws + WS_SC); const float* snap = (const float*)(ws + WS_SNAP);
    const int j = blockIdx.x, tok = samp_tok(j), t = threadIdx.x, b = tok >> 13;
    for (int i = t; i < 2048; i += 256) sc[i] = SC[(size_t)tok * NQK + i];
    __syncthreads();
    if (t < 16) { for (int r = 0; r < 16; ++r) { int bi = 0; float bv = -3e38f; for (int k = 0; k < 128; ++k) { const float v = sc[t * 128 + k]; if (v > bv) { bv = v; bi = k; } } stop[t][r] = bv; itop[t][r] = bi; sc[t * 128 + bi] = -3e38f; } }
    __syncthreads();
    for (int i = t; i < 2048; i += 256) { const int h = i >> 8, a = (i >> 4) & 15, c = i & 15; cand[h][a * 16 + c] = stop[2 * h][a] + stop[2 * h + 1][c]; }
    __syncthreads();
    if (t < 8) { float bv[16]; float mx = -3e38f; for (int r = 0; r < 16; ++r) { int bi = 0; float v0 = -3e38f; for (int k = 0; k < 256; ++k) { const float v = cand[t][k]; if (v > v0) { v0 = v; bi = k; } }
            cand[t][bi] = -3e38f; gate[t * 16 + r] = v0; eidx[t * 16 + r] = itop[2 * t][bi >> 4] * 128 + itop[2 * t + 1][bi & 15]; mx = fmaxf(mx, v0); }
        float sm = 0.f; for (int r = 0; r < 16; ++r) { const float e = expf(gate[t * 16 + r] - mx); gate[t * 16 + r] = e; sm += e; } for (int r = 0; r < 16; ++r) gate[t * 16 + r] /= sm; }
    __syncthreads();
    const unsigned* DI = (const unsigned*)(ws + 400 * MiB); const float* DG = (const float*)(ws + 416 * MiB); const float* DC = (const float*)(ws + 432 * MiB);
    __shared__ int fidx[128]; __shared__ float fcoef[128];
    if (t < 128) { const int h = t >> 4; const unsigned fi = DI[(size_t)tok * 128 + t]; const float fg = DG[(size_t)tok * 128 + t]; int found = -1;
        for (int r = 0; r < 16; ++r) if (eidx[h * 16 + r] == (int)fi) found = r;
        if (found < 0 || fi >= (unsigned)NEXP) atomicAdd(&flags[10], 1u); else chk(flags, 11, fg, gate[h * 16 + found], 2e-3f, 1e-2f);
        const unsigned fic = fi < (unsigned)NEXP ? fi : 0u; fidx[t] = (int)fic;
        float s = 0.f; const float* ur = expert_down + (size_t)fic * DM; for (int d = 0; d < DM; ++d) s += ur[d] * (float)H2[(size_t)tok * DM + d];
        const float cref = fg * 0.5f * s * (1.f + erff(s * 0.70710678f)); const float fc = DC[(size_t)tok * 128 + t];
        chk(flags, 12, fc, cref, 2e-3f, 1e-2f); fcoef[t] = fc; }
    __syncthreads();
    float x2[4]; float ss = 0.f;
    for (int q = 0; q < 4; ++q) { const int c = t + 256 * q; float o = 0.f; for (int k = 0; k < 128; ++k) o += fcoef[k] * expert_up[(size_t)fidx[k] * DM + c];
        x2[q] = snap[(size_t)j * DM + c] + mod[b * NMOD + 5 * DM + c] * o; ss += x2[q] * x2[q]; }
    red[t] = ss; __syncthreads();
    for (int o = 128; o > 0; o >>= 1) { if (t < o) red[t] += red[t + o]; __syncthreads(); }
    const float rstd = rsqrtf(red[0] / DM + EPS);
    for (int q = 0; q < 4; ++q) { const int c = t + 256 * q; chk(flags, 13, args.out[(size_t)tok * DM + c], x2[q] * rstd * g_final[c], 2e-2f, 1e-2f); }
}
__global__ void dbg_report(Args args) {
    const unsigned* flags = (const unsigned*)(args.ws + WS_FLAGS); int id = 0;
    for (int k = 1; k < 16; ++k) if (flags[k] > ((k == 10 || k == 11) ? 40u : 0u) && !id) id = k;
    if (!id) return; float f = 1.f + 2.f * id; if (id >= 10) { const float fr = (float)flags[id] / 8192.f; f = 1.f + (float)id + 0.9f * (fr > 1.f ? 1.f : fr); }
    for (size_t i = (size_t)blockIdx.x * blockDim.x + threadIdx.x; i < (size_t)M * DM; i += (size_t)gridDim.x * blockDim.x) args.out[i] *= f;
}
#endif
extern "C" void kernel_launch(void* const* d_in, const int* in_sizes, int n_in, void* d_out, int out_size, void* d_ws, size_t ws_size, hipStream_t stream) {
    static int grid = 0;
    if (grid == 0) {
        if (n_in != 19 || out_size != M * DM || ws_size < WS_END) { fprintf(stderr, "kernel_launch: unexpected shapes (n_in %d out %d ws %zu)\n", n_in, out_size, ws_size); grid = -1; return; }
        int dev = 0, cus = 0, per_cu = 0;
        if (hipGetDevice(&dev) != hipSuccess || hipDeviceGetAttribute(&cus, hipDeviceAttributeMultiprocessorCount, dev) != hipSuccess) { grid = -1; return; }
        if (hipFuncSetAttribute((const void*)fwd_kernel, hipFuncAttributeMaxDynamicSharedMemorySize, LDS_BYTES) != hipSuccess) { fprintf(stderr, "kernel_launch: hipFuncSetAttribute failed\n"); grid = -1; return; }
        if (hipOccupancyMaxActiveBlocksPerMultiprocessor(&per_cu, (const void*)fwd_kernel, NTHR, LDS_BYTES) != hipSuccess || per_cu < 1) { fprintf(stderr, "kernel_launch: occupancy query says %d\n", per_cu); }
        (void)hipGetLastError();
        grid = cus;
    }
    if (grid < 0) return;
    (void)hipMemsetAsync((char*)d_ws + WS_CTL, 0, CTL_ZERO_BYTES, stream);
    Args a{};
    for (int i = 0; i < 19; ++i) a.in[i] = (const float*)d_in[i];
    a.out = (float*)d_out; a.ws = (unsigned char*)d_ws;
    if (N_LAUNCHES == 1) {
        a.ph_lo = 0; a.ph_hi = N_PHASES;
        void* kargs[] = {&a};
        hipError_t e = hipLaunchCooperativeKernel((const void*)fwd_kernel, dim3(grid), dim3(NTHR), kargs, LDS_BYTES, stream);
        if (e != hipSuccess) fprintf(stderr, "kernel_launch: cooperative launch failed: %s (grid %d)\n", hipGetErrorString(e), grid);
    } else {
        for (int p = 0; p < N_PHASES; ++p) { a.ph_lo = p; a.ph_hi = p + 1; hipLaunchKernelGGL(fwd_kernel, dim3(grid), dim3(NTHR), LDS_BYTES, stream, a);
#if defined(DBG_CHECK)
            if (p >= 1 && p <= 6) hipLaunchKernelGGL(dbg_check, dim3(1024), dim3(256), 0, stream, a, p);
            if (p == 0) hipLaunchKernelGGL(dbg_check, dim3(1024), dim3(256), 0, stream, a, 8);
            if (p == 6) hipLaunchKernelGGL(dbg_check, dim3(1024), dim3(256), 0, stream, a, 7);
            if (p == 7) { hipLaunchKernelGGL(dbg_check_peer, dim3(NSAMP_TOK), dim3(256), 0, stream, a); hipLaunchKernelGGL(dbg_report, dim3(1024), dim3(256), 0, stream, a); }
#endif
        }
    }
}
```

```cpp
#include <hip/hip_runtime.h>
#include <cstdio>
#include <cstdint>

#ifndef MK_N_LAUNCHES
#define MK_N_LAUNCHES 1
#endif

#define LAS __attribute__((address_space(3)))
#define GAS __attribute__((address_space(1)))
typedef unsigned short f16_t;
typedef _Float16 f16x8 __attribute__((ext_vector_type(8)));
typedef _Float16 f16x4 __attribute__((ext_vector_type(4)));
typedef _Float16 f16x2 __attribute__((ext_vector_type(2)));
typedef float f32x4 __attribute__((ext_vector_type(4)));
typedef unsigned u32x4 __attribute__((ext_vector_type(4)));
typedef unsigned u32x2 __attribute__((ext_vector_type(2)));

__device__ __forceinline__ f16x2 as_h2(unsigned u) { return __builtin_bit_cast(f16x2, u); }
__device__ __forceinline__ float as_f(unsigned u) { return __builtin_bit_cast(float, u); }
__device__ __forceinline__ unsigned as_u(float f) { return __builtin_bit_cast(unsigned, f); }
__device__ __forceinline__ unsigned pk_f16(float lo, float hi) { f16x2 v = {(_Float16)lo, (_Float16)hi}; return __builtin_bit_cast(unsigned, v); }

namespace pg8 {
constexpr int BM = 256, BK = 64, HALF = 128, HTB = HALF * BK * 2, STAGE_BYTES = 8 * HTB, NXCD = 8, WGM = 8;
__host__ __device__ __forceinline__ int lds_byte(int r, int c) { const int st = (r >> 4) * 2 + (c >> 5), rr = r & 15, cc = c & 31, ob = rr * 64 + cc * 2; return st * 1024 + (ob ^ (((ob >> 9) & 1) << 5)); }
__host__ __device__ __forceinline__ void stage_rc(int b, int& R, int& C) { const int st = b / 1024, sb = b % 1024, swz = sb ^ (((sb >> 9) & 1) << 5); R = (st >> 1) * 16 + swz / 64; C = (st & 1) * 32 + (swz % 64) / 2; }
__host__ __device__ __forceinline__ int perm32(int rho) { const int n = rho >> 4, i = rho & 15; return 8 * (i >> 2) + 4 * n + (i & 3); }
struct Unit { int pm, pn; };
struct Gemm { const f16_t* A; const f16_t* Bt; int M, N, K; };
struct StaticOrder {
    int nM, nN, nwg, G, c;
    __host__ __device__ void init(int M, int N, int G_, int c_) { nM = M / BM; nN = N / BM; nwg = nM * nN; G = G_; c = c_; }
    __host__ __device__ bool next(int i, Unit& u) const {
        const long L = (long)i * G + c; if (L >= nwg) return false;
        int wgid = (int)L; { const int q = nwg / NXCD, r = nwg % NXCD, xcd = wgid % NXCD, off = wgid / NXCD; wgid = (xcd < r ? xcd * (q + 1) : r * (q + 1) + (xcd - r) * q) + off; }
        const int nig = WGM * nN, gid = wgid / nig, fm = gid * WGM, gsz = (nM - fm) < WGM ? (nM - fm) : WGM;
        u.pm = fm + ((wgid % nig) % gsz); u.pn = (wgid % nig) / gsz; return true;
    }
    __device__ __forceinline__ void a_ready(const Unit&) const {}
    __device__ __forceinline__ void done(const Unit&) const {}
};
struct EpiF16 {
    static constexpr bool PERM = true, AFTER_DRAIN = false;
    f16_t* O; int ldc;
    __device__ __forceinline__ void operator()(const f32x4 (&acc)[2][2][4][2], const Unit& u, int wr, int wc, int fr, int fq) const {
        const int row0 = u.pm * BM + wr * 64 + fr, col0 = u.pn * BM + wc * 32 + 8 * fq;
#pragma unroll
        for (int ai = 0; ai < 2; ++ai)
#pragma unroll
            for (int m = 0; m < 4; ++m) { f16_t* rowp = O + (size_t)(row0 + ai * HALF + m * 16) * ldc + col0;
#pragma unroll
                for (int bj = 0; bj < 2; ++bj) { const f32x4 v0 = acc[ai][bj][m][0], v1 = acc[ai][bj][m][1];
                    u32x4 w; w.x = pk_f16(v0[0], v0[1]); w.y = pk_f16(v0[2], v0[3]); w.z = pk_f16(v1[0], v1[1]); w.w = pk_f16(v1[2], v1[3]);
                    *(u32x4*)(rowp + bj * HALF) = w; } }
    }
};
struct EpiF32 {
    static constexpr bool PERM = false, AFTER_DRAIN = false;
    float* C; int ldc;
    __device__ __forceinline__ void operator()(const f32x4 (&acc)[2][2][4][2], const Unit& u, int wr, int wc, int fr, int fq) const {
        const int row0 = u.pm * BM + wr * 64 + fr, col0 = u.pn * BM + wc * 32 + 4 * fq;
#pragma unroll
        for (int ai = 0; ai < 2; ++ai)
#pragma unroll
            for (int m = 0; m < 4; ++m) { float* rowp = C + (size_t)(row0 + ai * HALF + m * 16) * ldc + col0;
#pragma unroll
                for (int bj = 0; bj < 2; ++bj)
#pragma unroll
                    for (int n = 0; n < 2; ++n) *(f32x4*)(rowp + bj * HALF + n * 16) = acc[ai][bj][m][n]; }
    }
};
struct EpiRes {
    static constexpr bool PERM = false, AFTER_DRAIN = false;
    const float* X; float* O; const float* gate; int ldc;
    __device__ __forceinline__ void operator()(const f32x4 (&acc)[2][2][4][2], const Unit& u, int wr, int wc, int fr, int fq) const {
        const int row0 = u.pm * BM + wr * 64 + fr, col0 = u.pn * BM + wc * 32 + 4 * fq;
        const float* g = gate + (size_t)((u.pm * BM) >> 13) * 6144;
        f32x4 gv[2][2];
#pragma unroll
        for (int bj = 0; bj < 2; ++bj)
#pragma unroll
            for (int n = 0; n < 2; ++n) gv[bj][n] = *(const f32x4*)(g + col0 + bj * HALF + n * 16);
#pragma unroll
        for (int ai = 0; ai < 2; ++ai)
#pragma unroll
            for (int m = 0; m < 4; ++m) { const size_t off = (size_t)(row0 + ai * HALF + m * 16) * ldc + col0;
#pragma unroll
                for (int bj = 0; bj < 2; ++bj)
#pragma unroll
                    for (int n = 0; n < 2; ++n) { const f32x4 xv = *(const f32x4*)(X + off + bj * HALF + n * 16); *(f32x4*)(O + off + bj * HALF + n * 16) = xv + gv[bj][n] * acc[ai][bj][m][n]; }
                if (m & 1) asm volatile("" ::: "memory"); }
    }
};

template <class Epi, class Sched, bool ALIGN_EPI = false, bool SP2 = false>
__device__ __forceinline__ void gemm_phase(LAS unsigned char* lds, const Gemm g, const Sched& S, const Epi& E) {
    const int tid = threadIdx.x, wid = __builtin_amdgcn_readfirstlane(tid >> 6), lane = tid & 63, wr = wid >> 2, wc = wid & 3, fr = lane & 15, fq = lane >> 4;
    const int K = g.K, nt = K / BK;
    unsigned voffA[2], voffB[2];
#pragma unroll
    for (int i = 0; i < 2; ++i) { int R, C; stage_rc(tid * 16 + i * 8192, R, C); const int Rb = Epi::PERM ? ((R & ~31) + perm32(R & 31)) : R;
        voffA[i] = (unsigned)(R * K + C) * 2u; voffB[i] = (unsigned)(Rb * K + C) * 2u; }
    const size_t kstep = (size_t)(BK * 2);
    const size_t hstep = (size_t)HALF * K * 2;
    const size_t tstep = 2 * hstep;
    const unsigned ldsw = (unsigned)wid * 1024u;
    const int aoff = lds_byte(wr * 64 + fr, fq * 8), boff = lds_byte(wc * 32 + fr, fq * 8);
#define PG8_SA(b, h) (((b) * 2 + (h)) * HTB)
#define PG8_SB(b, h) ((4 + (b) * 2 + (h)) * HTB)
#define PG8_STAGE(bufoff, gbase, voff) do { _Pragma("unroll") for (int _i = 0; _i < 2; ++_i) \
        __builtin_amdgcn_global_load_lds((const unsigned*)((const char*)(gbase) + (voff)[_i]), (LAS unsigned*)(lds + (bufoff) + ldsw + _i * 8192), 16, 0, 0); } while (0)
#define PG8_LDA(dst, b, h) do { _Pragma("unroll") for (int m = 0; m < 4; ++m) _Pragma("unroll") for (int k = 0; k < 2; ++k) dst[m][k] = *(const LAS f16x8*)(lds + PG8_SA(b, h) + aoff + m * 2048 + k * 1024); } while (0)
#define PG8_LDB(dst, b, h) do { _Pragma("unroll") for (int n = 0; n < 2; ++n) _Pragma("unroll") for (int k = 0; k < 2; ++k) dst[n][k] = *(const LAS f16x8*)(lds + PG8_SB(b, h) + boff + n * 2048 + k * 1024); } while (0)
#define PG8_MMA(ai, bj, At, Bt) do { __builtin_amdgcn_s_setprio(1); _Pragma("unroll") for (int m = 0; m < 4; ++m) _Pragma("unroll") for (int n = 0; n < 2; ++n) _Pragma("unroll") for (int k = 0; k < 2; ++k) \
        acc[ai][bj][m][n] = __builtin_amdgcn_mfma_f32_16x16x32_f16(Bt[n][k], At[m][k], acc[ai][bj][m][n], 0, 0, 0); __builtin_amdgcn_s_setprio(0); } while (0)
#define PG8_WAIT_V(n) asm volatile("s_waitcnt vmcnt(" #n ")" ::: "memory")
#define PG8_WAIT_L(n) asm volatile("s_waitcnt lgkmcnt(" #n ")" ::: "memory")
#define PG8_BAR __builtin_amdgcn_s_barrier()
#define PG8_SCHED __builtin_amdgcn_sched_barrier(0)
    Unit cur, nxt; int ui = 0;
    if (!S.next(0, cur)) return;
    f32x4 acc[2][2][4][2];
#pragma unroll
    for (int a = 0; a < 2; ++a)
#pragma unroll
        for (int b = 0; b < 2; ++b)
#pragma unroll
            for (int m = 0; m < 4; ++m)
#pragma unroll
                for (int n = 0; n < 2; ++n) acc[a][b][m][n] = (f32x4){0.f, 0.f, 0.f, 0.f};
    f16x8 At[4][2], B0[2][2], B1[2][2];
    const char* cA = (const char*)g.A + (size_t)cur.pm * tstep; const char* cB = (const char*)g.Bt + (size_t)cur.pn * tstep;
    S.a_ready(cur);
    if constexpr (SP2) {
        PG8_STAGE(PG8_SB(0, 0), cB, voffB); PG8_STAGE(PG8_SB(0, 1), cB + hstep, voffB); PG8_STAGE(PG8_SA(0, 0), cA, voffA); PG8_STAGE(PG8_SA(0, 1), cA + hstep, voffA);
        if (wr == 1) PG8_BAR;
        PG8_WAIT_V(2); PG8_BAR;
        PG8_STAGE(PG8_SB(1, 0), cB + kstep, voffB); PG8_STAGE(PG8_SA(1, 0), cA + kstep, voffA); PG8_STAGE(PG8_SB(1, 1), cB + hstep + kstep, voffB);
        PG8_WAIT_V(6); PG8_BAR;
    } else {
        PG8_STAGE(PG8_SB(0, 0), cB, voffB); PG8_STAGE(PG8_SA(0, 0), cA, voffA); PG8_STAGE(PG8_SB(0, 1), cB + hstep, voffB); PG8_STAGE(PG8_SA(0, 1), cA + hstep, voffA);
        if (wr == 1) PG8_BAR;
        PG8_WAIT_V(4); PG8_BAR;
        PG8_STAGE(PG8_SB(1, 0), cB + kstep, voffB); PG8_STAGE(PG8_SA(1, 0), cA + kstep, voffA); PG8_STAGE(PG8_SB(1, 1), cB + hstep + kstep, voffB);
        PG8_WAIT_V(6); PG8_BAR;
    }
    for (;;) {
        const bool has_next = S.next(ui + 1, nxt);
        const char* nA = has_next ? (const char*)g.A + (size_t)nxt.pm * tstep : cA; const char* nB = has_next ? (const char*)g.Bt + (size_t)nxt.pn * tstep : cB;
        for (int t = 0; t < nt; t += 2) {
            const bool last = (t == nt - 2);
            const char* a1 = cA + (size_t)(t + 1) * kstep;
            const char* a2 = last ? nA : cA + (size_t)(t + 2) * kstep; const char* b2 = last ? nB : cB + (size_t)(t + 2) * kstep;
            const char* a3 = a2 + kstep; const char* b3 = b2 + kstep;
            if (last && has_next) S.a_ready(nxt);
            if constexpr (SP2) {
            PG8_LDB(B0, 0, 0); PG8_LDB(B1, 0, 1); PG8_SCHED; PG8_LDA(At, 0, 0); PG8_STAGE(PG8_SA(1, 1), a1 + hstep, voffA);
            PG8_WAIT_V(8); PG8_WAIT_L(0); PG8_BAR; PG8_MMA(0, 0, At, B0); PG8_MMA(0, 1, At, B1); PG8_BAR; PG8_SCHED;
            PG8_LDA(At, 0, 1); PG8_STAGE(PG8_SB(0, 0), b2, voffB); PG8_STAGE(PG8_SB(0, 1), b2 + hstep, voffB); PG8_STAGE(PG8_SA(0, 0), a2, voffA);
            PG8_WAIT_V(8); PG8_WAIT_L(0); PG8_BAR; PG8_MMA(1, 0, At, B0); PG8_MMA(1, 1, At, B1); PG8_BAR; PG8_SCHED;
            PG8_LDB(B0, 1, 0); PG8_LDB(B1, 1, 1); PG8_SCHED; PG8_LDA(At, 1, 0); PG8_STAGE(PG8_SA(0, 1), a2 + hstep, voffA);
            PG8_WAIT_V(8); PG8_WAIT_L(0); PG8_BAR; PG8_MMA(0, 0, At, B0); PG8_MMA(0, 1, At, B1); PG8_BAR; PG8_SCHED;
            PG8_LDA(At, 1, 1); PG8_STAGE(PG8_SB(1, 0), b3, voffB); PG8_STAGE(PG8_SB(1, 1), b3 + hstep, voffB); PG8_STAGE(PG8_SA(1, 0), a3, voffA);
            PG8_WAIT_V(8); PG8_WAIT_L(0); PG8_BAR; PG8_MMA(1, 0, At, B0); PG8_MMA(1, 1, At, B1); PG8_BAR; PG8_SCHED;
            } else {
            PG8_LDB(B0, 0, 0); PG8_SCHED; PG8_LDA(At, 0, 0); PG8_STAGE(PG8_SA(1, 1), a1 + hstep, voffA);
            PG8_WAIT_L(8); PG8_BAR; PG8_WAIT_L(0); PG8_MMA(0, 0, At, B0); PG8_BAR; PG8_SCHED;
            PG8_LDB(B1, 0, 1); PG8_STAGE(PG8_SB(0, 0), b2, voffB);
            PG8_BAR; PG8_WAIT_L(0); PG8_MMA(0, 1, At, B1); PG8_BAR;
            PG8_LDA(At, 0, 1); PG8_STAGE(PG8_SA(0, 0), a2, voffA);
            PG8_BAR; PG8_WAIT_L(0); PG8_MMA(1, 0, At, B0); PG8_BAR; PG8_SCHED;
            PG8_STAGE(PG8_SB(0, 1), b2 + hstep, voffB);
            PG8_WAIT_V(6); PG8_BAR; PG8_MMA(1, 1, At, B1); PG8_BAR;
            PG8_LDB(B0, 1, 0); PG8_SCHED; PG8_LDA(At, 1, 0); PG8_STAGE(PG8_SA(0, 1), a2 + hstep, voffA);
            PG8_WAIT_L(8); PG8_BAR; PG8_WAIT_L(0); PG8_MMA(0, 0, At, B0); PG8_BAR; PG8_SCHED;
            PG8_LDB(B1, 1, 1); PG8_STAGE(PG8_SB(1, 0), b3, voffB);
            PG8_BAR; PG8_WAIT_L(0); PG8_MMA(0, 1, At, B1); PG8_BAR;
            PG8_LDA(At, 1, 1); PG8_STAGE(PG8_SA(1, 0), a3, voffA);
            PG8_BAR; PG8_WAIT_L(0); PG8_MMA(1, 0, At, B0); PG8_BAR; PG8_SCHED;
            PG8_STAGE(PG8_SB(1, 1), b3 + hstep, voffB);
            PG8_WAIT_V(6); PG8_BAR; PG8_MMA(1, 1, At, B1); PG8_BAR;
            }
        }
        if constexpr (ALIGN_EPI) { if (wr == 0) PG8_BAR; }
        if constexpr (!Epi::AFTER_DRAIN) { E(acc, cur, wr, wc, fr, fq); S.done(cur); }
        if (!has_next) break;
#pragma unroll
        for (int a = 0; a < 2; ++a)
#pragma unroll
            for (int b = 0; b < 2; ++b)
#pragma unroll
                for (int m = 0; m < 4; ++m)
#pragma unroll
                    for (int n = 0; n < 2; ++n) acc[a][b][m][n] = (f32x4){0.f, 0.f, 0.f, 0.f};
        cur = nxt; cA = nA; cB = nB; ++ui;
        if constexpr (ALIGN_EPI) { if (wr == 1) PG8_BAR; }
    }
    PG8_WAIT_V(0);
    if constexpr (!ALIGN_EPI) { if (wr == 0) PG8_BAR; }
    PG8_BAR;
#undef PG8_SA
#undef PG8_SB
#undef PG8_STAGE
#undef PG8_LDA
#undef PG8_LDB
#undef PG8_MMA
#undef PG8_WAIT_V
#undef PG8_WAIT_L
#undef PG8_BAR
#undef PG8_SCHED
}
}

constexpr int NWAVES = 8, NTHR = NWAVES * 64;
constexpr int N_LAUNCHES = MK_N_LAUNCHES, N_PHASES = 8;
constexpr int BATCH = 4, SEQ = 8192, DM = 1024, M = BATCH * SEQ;
constexpr int NPROJ = 1536, NQK = 2048, NEXP = 16384, NMOD = 6 * DM;
constexpr float EPS = 1e-6f;

constexpr size_t MiB = 1u << 20;
constexpr size_t WS_CTL = 0, CTL_ZERO_BYTES = 128 * 1024;
constexpr size_t WS_XSYNC = 64 * 1024;
constexpr size_t WS_MOD = 256 * 1024;
constexpr size_t WS_MODP = 1 * MiB;
constexpr size_t WS_WIN = 2 * MiB;
constexpr size_t WS_WOUT = 5 * MiB;
constexpr size_t WS_WQK = 7 * MiB;
constexpr size_t WS_WPOOL = 11 * MiB;
constexpr size_t WS_WSP = 11 * MiB + 256 * 1024;
constexpr size_t WS_ED = 16 * MiB, WS_EU = 32 * MiB;
constexpr size_t WS_EDS = 13 * MiB, WS_EUS = 13 * MiB + 65536;
constexpr size_t WS_H2 = 80 * MiB;
constexpr size_t WS_SC = 144 * MiB;
constexpr size_t WS_H1 = 144 * MiB, WS_PROJ = 208 * MiB, WS_MIX = 304 * MiB;
constexpr size_t WS_END = 400 * MiB;
constexpr int CW_BAR = 1024;

constexpr int RING_BYTES = 131072;
constexpr int MISC_OFF = 160 * 1024 - 256;
constexpr int LDS_BYTES = 160 * 1024;

#define RLX_AGENT __ATOMIC_RELAXED, __HIP_MEMORY_SCOPE_AGENT
#define LDS_WAIT() asm volatile("s_waitcnt lgkmcnt(0)" ::: "memory")
#define VM_WAIT() asm volatile("s_waitcnt vmcnt(0)" ::: "memory")

#define XB_TMO      128
#define XB_XCNT(j)  (256  + 64 * (j))
#define XB_XSUB(j)  (1280 + 64 * (j))
#define XB_XGEN(j)  (2304 + 64 * (j))
#define XB_TOP      3328
#define XB_TOPGEN   3392
#define XCD_BAR_WORDS 3456
#define XB_SPIN_CAP (1u << 22)
__device__ __forceinline__ unsigned xb_ld(unsigned* p)              { return __hip_atomic_load(p, __ATOMIC_RELAXED, __HIP_MEMORY_SCOPE_AGENT); }
__device__ __forceinline__ unsigned xb_add(unsigned* p, unsigned v) { return __hip_atomic_fetch_add(p, v, __ATOMIC_RELAXED, __HIP_MEMORY_SCOPE_AGENT); }
__device__ __forceinline__ unsigned xb_xcc_id() { return (unsigned)__builtin_amdgcn_s_getreg((3 << 11) | 20) & 0xFu; }
#define XB_SPIN(cond, bar) do { unsigned _sp = 0; while (cond) { __builtin_amdgcn_s_sleep(1); \
    if ((++_sp & 255u) == 0u) { if (xb_ld(&(bar)[XB_TMO])) break; if (_sp > XB_SPIN_CAP) { atomicAdd(&(bar)[XB_TMO], 1u); break; } } } } while (0)
struct XcdBarrier { unsigned* bar; unsigned x; volatile LAS unsigned* st; };
__device__ __forceinline__ XcdBarrier xcd_barrier_post(unsigned* bar, volatile LAS unsigned* st) {
    XcdBarrier b; b.bar = bar; b.x = xb_xcc_id(); b.st = st;
    if (threadIdx.x == 0) (void)xb_add(&bar[XB_XCNT(b.x)], 1u);
    return b;
}
__device__ __forceinline__ void xcd_barrier_complete(unsigned* bar, unsigned x, unsigned& nloc, unsigned& nx) {
    const unsigned G = gridDim.x * gridDim.y * gridDim.z;
    unsigned sum, cnt, mine, sp = 0u;
    for (;;) {
        sum = 0u; cnt = 0u; mine = 0u;
#pragma unroll
        for (unsigned j = 0; j < 16; ++j) { const unsigned c = xb_ld(&bar[XB_XCNT(j)]); sum += c; cnt += (c > 0u) ? 1u : 0u; mine = (j == x) ? c : mine; }
        if (sum == G) break;
        __builtin_amdgcn_s_sleep(1);
        if ((++sp & 255u) == 0u) { if (xb_ld(&bar[XB_TMO])) break; if (sp > XB_SPIN_CAP) { atomicAdd(&bar[XB_TMO], 1u); break; } }
    }
    nloc = mine > 0u ? mine : 1u; nx = cnt > 0u ? cnt : 1u;
}
__device__ __forceinline__ void xcd_barrier(const XcdBarrier& b) {
    asm volatile("s_waitcnt vmcnt(0)" ::: "memory");
    __syncthreads();
    if (threadIdx.x == 0) {
        unsigned* bar = b.bar;
        __builtin_amdgcn_s_waitcnt(0);
        unsigned nloc = b.st[0], nx = b.st[1];
        if (nloc == 0u) { xcd_barrier_complete(bar, b.x, nloc, nx); b.st[0] = nloc; b.st[1] = nx; }
        const unsigned old = xb_add(&bar[XB_XSUB(b.x)], 1u);
        const unsigned gen = old / nloc;
        if (old + 1u == (gen + 1u) * nloc) {
            __builtin_amdgcn_fence(__ATOMIC_RELEASE, "agent");
            asm volatile("s_waitcnt vmcnt(0)" ::: "memory");
            const unsigned og = xb_add(&bar[XB_TOP], 1u);
            const unsigned tg = og / nx;
            if (og + 1u == (tg + 1u) * nx) xb_add(&bar[XB_TOPGEN], 1u);
            else XB_SPIN(xb_ld(&bar[XB_TOPGEN]) == tg, bar);
            __builtin_amdgcn_fence(__ATOMIC_ACQUIRE, "agent");
            xb_add(&bar[XB_XGEN(b.x)], 1u);
            asm volatile("s_waitcnt vmcnt(0)" ::: "memory");
        } else {
            XB_SPIN(xb_ld(&bar[XB_XGEN(b.x)]) == gen, bar);
            __builtin_amdgcn_fence(__ATOMIC_ACQUIRE, "agent");
            asm volatile("s_waitcnt vmcnt(0)" ::: "memory");
        }
    }
    __syncthreads();
}

__device__ __forceinline__ float wave_sum(float v) {
#pragma unroll
    for (int o = 1; o < 64; o <<= 1) v += __shfl_xor(v, o);
    return v;
}
template <int CTRL> __device__ __forceinline__ unsigned dppu(unsigned x) { return (unsigned)__builtin_amdgcn_update_dpp((int)x, (int)x, CTRL, 0xF, 0xF, false); }
template <int CTRL> __device__ __forceinline__ float dppf(float x) { return __builtin_bit_cast(float, __builtin_amdgcn_update_dpp(__builtin_bit_cast(int, x), __builtin_bit_cast(int, x), CTRL, 0xF, 0xF, false)); }
__device__ __forceinline__ unsigned umax_(unsigned a, unsigned b) { return a > b ? a : b; }
__device__ __forceinline__ unsigned umin_(unsigned a, unsigned b) { return a < b ? a : b; }
__device__ __forceinline__ unsigned rowmax16u(unsigned x) {
    x = umax_(x, dppu<0xB1>(x)); x = umax_(x, dppu<0x4E>(x)); x = umax_(x, dppu<0x141>(x)); x = umax_(x, dppu<0x140>(x)); return x; }
__device__ __forceinline__ float rowmax16f(float x) {
    x = fmaxf(x, dppf<0xB1>(x)); x = fmaxf(x, dppf<0x4E>(x)); x = fmaxf(x, dppf<0x141>(x)); x = fmaxf(x, dppf<0x140>(x)); return x; }
__device__ __forceinline__ float rowsum16f(float x) {
    x += dppf<0xB1>(x); x += dppf<0x4E>(x); x += dppf<0x141>(x); x += dppf<0x140>(x); return x; }
__device__ __forceinline__ unsigned fkey(float f) { const unsigned u = __builtin_bit_cast(unsigned, f); return (u & 0x80000000u) ? ~u : (u | 0x80000000u); }
__device__ __forceinline__ float fval(unsigned k, unsigned lowmask) {
    unsigned u = (k & 0x80000000u) ? (k & 0x7fffffffu) : ~k; u &= ~lowmask; return __builtin_bit_cast(float, u); }
#define CE_DESC(a, b) do { const unsigned _hi = umax_(a, b), _lo = umin_(a, b); a = _hi; b = _lo; } while (0)

__device__ __forceinline__ float gelu_as(float v) {
    const float av = fabsf(v), t = __builtin_amdgcn_rcpf(av * 0.2316418882f + 1.0f);
    float q = t * 0.5307027145f + (-0.7265760135f); q = q * t + 0.7107068705f; q = q * t + (-0.142248368f); q = q * t + 0.127414796f; q = q * t;
    const float e = __builtin_amdgcn_exp2f(v * v * (-0.72134752044f)), m = v * (q * e);
    return v < 0.f ? m : v - m;
}
__device__ __forceinline__ float wave_max(float v) {
    v = fmaxf(v, dppf<0xB1>(v)); v = fmaxf(v, dppf<0x4E>(v)); v = fmaxf(v, dppf<0x141>(v)); v = fmaxf(v, dppf<0x140>(v));
    { const auto a = __builtin_amdgcn_permlane16_swap(as_u(v), as_u(v), false, false); v = fmaxf(as_f(a[0]), as_f(a[1])); }
    { const auto a = __builtin_amdgcn_permlane32_swap(as_u(v), as_u(v), false, false); v = fmaxf(as_f(a[0]), as_f(a[1])); }
    return v;
}
__device__ __forceinline__ float wave_total(float v) {
    v += dppf<0xB1>(v); v += dppf<0x4E>(v); v += dppf<0x141>(v); v += dppf<0x140>(v);
    { const auto a = __builtin_amdgcn_permlane16_swap(as_u(v), as_u(v), false, false); v = as_f(a[0]) + as_f(a[1]); }
    { const auto a = __builtin_amdgcn_permlane32_swap(as_u(v), as_u(v), false, false); v = as_f(a[0]) + as_f(a[1]); }
    return v;
}

__device__ __forceinline__ void topk_token(const float* sc, LAS unsigned* tk, LAS unsigned* pe_idx, LAS float* pe_gate, int lane) {
    const int l16 = lane & 15, row = lane >> 4, hsel = lane >> 5;
    for (int ps = 0; ps < 4; ++ps) {
        const f32x4 sa = *(const f32x4*)(sc + ps * 512 + lane * 8), sb = *(const f32x4*)(sc + ps * 512 + lane * 8 + 4);
        unsigned k0 = fkey(sa.x), k1 = fkey(sa.y), k2 = fkey(sa.z), k3 = fkey(sa.w), k4 = fkey(sb.x), k5 = fkey(sb.y), k6 = fkey(sb.z), k7 = fkey(sb.w);
        const unsigned ib = 127u - (unsigned)(l16 * 8);
        k0 = (k0 & ~127u) | (ib - 0u); k1 = (k1 & ~127u) | (ib - 1u); k2 = (k2 & ~127u) | (ib - 2u); k3 = (k3 & ~127u) | (ib - 3u);
        k4 = (k4 & ~127u) | (ib - 4u); k5 = (k5 & ~127u) | (ib - 5u); k6 = (k6 & ~127u) | (ib - 6u); k7 = (k7 & ~127u) | (ib - 7u);
        CE_DESC(k0, k1); CE_DESC(k2, k3); CE_DESC(k4, k5); CE_DESC(k6, k7);
        CE_DESC(k0, k2); CE_DESC(k1, k3); CE_DESC(k4, k6); CE_DESC(k5, k7);
        CE_DESC(k1, k2); CE_DESC(k5, k6);
        CE_DESC(k0, k4); CE_DESC(k1, k5); CE_DESC(k2, k6); CE_DESC(k3, k7);
        CE_DESC(k2, k4); CE_DESC(k3, k5);
        CE_DESC(k1, k2); CE_DESC(k3, k4); CE_DESC(k5, k6);
        unsigned top = 0u;
#pragma unroll
        for (int rr = 0; rr < 16; ++rr) {
            const unsigned m = rowmax16u(k0);
            top = (l16 == rr) ? m : top;
            const bool pop = (k0 == m);
            k0 = pop ? k1 : k0; k1 = pop ? k2 : k1; k2 = pop ? k3 : k2; k3 = pop ? k4 : k3; k4 = pop ? k5 : k4; k5 = pop ? k6 : k5; k6 = pop ? k7 : k6; k7 = pop ? 0u : k7;
        }
        tk[lane] = top;
        __builtin_amdgcn_wave_barrier(); LDS_WAIT();
        const LAS unsigned* ab = tk + 32 * hsel; const LAS unsigned* bb = ab + 16;
        const unsigned aik = ab[l16], a0k = ab[0], bik = bb[l16];
        const u32x4 bq0 = *(const LAS u32x4*)bb, bq1 = *(const LAS u32x4*)(bb + 4);
        const float vai = fval(aik, 127u), va0 = fval(a0k, 127u), vbi = fval(bik, 127u);
        const unsigned bk[8] = {bq0.x, bq0.y, bq0.z, bq0.w, bq1.x, bq1.y, bq1.z, bq1.w};
        unsigned L[8];
#pragma unroll
        for (int e = 0; e < 8; ++e) { const float sv = vai + fval(bk[e], 127u); const unsigned kk = (fkey(sv) & ~255u) | (255u - (unsigned)(l16 * 16 + e));
            L[e] = ((l16 + 1) * (e + 1) <= 16) ? kk : 0u; }
        { const float sv = va0 + vbi; const unsigned kk = (fkey(sv) & ~255u) | (255u - (unsigned)l16); L[1] = (l16 >= 8) ? kk : L[1]; }
        CE_DESC(L[0], L[1]);
        unsigned best = 0u;
#pragma unroll
        for (int rr = 0; rr < 16; ++rr) {
            const unsigned m = rowmax16u(L[0]);
            best = (l16 == rr) ? m : best;
            const bool pop = (L[0] == m);
            L[0] = pop ? L[1] : L[0]; L[1] = pop ? L[2] : L[1]; L[2] = pop ? L[3] : L[2]; L[3] = pop ? L[4] : L[3]; L[4] = pop ? L[5] : L[4]; L[5] = pop ? L[6] : L[5]; L[6] = pop ? L[7] : L[6]; L[7] = pop ? 0u : L[7];
        }
        const unsigned flat = 255u - (best & 255u), ci = flat >> 4, cj = flat & 15u;
        const unsigned ak = ab[ci], bk2 = bb[cj];
        const float sval = fval(ak, 127u) + fval(bk2, 127u);
        const unsigned eidx = (127u - (ak & 127u)) * 128u + (127u - (bk2 & 127u));
        const float mx = rowmax16f(sval), ex = __expf(sval - mx), sm = rowsum16f(ex), gt = ex / sm;
        if ((row & 1) == 0) { const int hd = 2 * ps + hsel; pe_idx[hd * 16 + l16] = eidx; pe_gate[hd * 16 + l16] = gt; }
        __builtin_amdgcn_wave_barrier(); LDS_WAIT();
    }
}

struct Args { const float* in[19]; float* out; unsigned char* ws; int ph_lo, ph_hi; };

__device__ __forceinline__ void p0_transpose_item(const float* W, int K, int N, f16_t* WT, LAS float* scr, int item, int lane) {
    const int nblk = N / 32, kb = item / nblk, nb = item % nblk, k0 = 64 * kb, n0 = 32 * nb;
#pragma unroll 8
    for (int i = 0; i < 32; ++i) { const int kk = 2 * i + (lane >> 5); scr[kk * 33 + (lane & 31)] = W[(size_t)(k0 + kk) * N + n0 + (lane & 31)]; }
    LDS_WAIT(); asm volatile("" ::: "memory");
    const int c = lane & 7;
#pragma unroll
    for (int j = 0; j < 4; ++j) { const int n = (lane >> 3) + 8 * j; const LAS float* s = scr + (8 * c) * 33 + n;
        u32x4 o; o.x = pk_f16(s[0 * 33], s[1 * 33]); o.y = pk_f16(s[2 * 33], s[3 * 33]); o.z = pk_f16(s[4 * 33], s[5 * 33]); o.w = pk_f16(s[6 * 33], s[7 * 33]);
        *(u32x4*)(WT + (size_t)(n0 + n) * K + k0 + 8 * c) = o; }
    LDS_WAIT(); asm volatile("" ::: "memory");
}

__device__ __forceinline__ void norm_rows(const float* src, f16_t* dst, const LAS float* A, const LAS float* S, int row0, int nrows, int wave, int lane) {
    for (int r = wave; r < nrows; r += NWAVES) {
        const f32x4* xr = (const f32x4*)(src + (size_t)(row0 + r) * DM) + lane;
        f32x4 v[4]; float s = 0.f;
#pragma unroll
        for (int j = 0; j < 4; ++j) { v[j] = xr[64 * j]; s += (v[j].x * v[j].x + v[j].y * v[j].y) + (v[j].z * v[j].z + v[j].w * v[j].w); }
        const float rstd = rsqrtf(wave_sum(s) * (1.f / DM) + EPS);
        unsigned long long* o8 = (unsigned long long*)(dst + (size_t)(row0 + r) * DM) + lane;
#pragma unroll
        for (int j = 0; j < 4; ++j) { const f32x4 a = *(const LAS f32x4*)(A + 4 * (64 * j + lane)), sh = *(const LAS f32x4*)(S + 4 * (64 * j + lane));
            const f32x4 h = v[j] * rstd * a + sh;
            o8[64 * j] = (unsigned long long)pk_f16(h.x, h.y) | ((unsigned long long)pk_f16(h.z, h.w) << 32); }
    }
}

__device__ __forceinline__ void xcd_pace(unsigned* cnt, unsigned target) {
    __syncthreads();
    if (threadIdx.x == 0 && target) {
        (void)__hip_atomic_fetch_add(cnt, 1u, __ATOMIC_RELAXED, __HIP_MEMORY_SCOPE_AGENT);
        const unsigned need = target - (target >> 2);
        for (int sp = 0; sp < 4096; ++sp) { if (__hip_atomic_load(cnt, __ATOMIC_RELAXED, __HIP_MEMORY_SCOPE_AGENT) >= need) break; __builtin_amdgcn_s_sleep(8); }
    }
    __syncthreads();
}

__global__ void __launch_bounds__(NTHR, 2) fwd_kernel(Args args) {
    extern __shared__ __attribute__((aligned(16))) unsigned char lds_raw[];
    LAS unsigned char* lds = (LAS unsigned char*)lds_raw;
    volatile LAS unsigned* MISC = (volatile LAS unsigned*)(lds + MISC_OFF);
    const int tid = threadIdx.x, lane = tid & 63, wave = __builtin_amdgcn_readfirstlane(tid >> 6);
    const int G = gridDim.x, wg = blockIdx.x;
    unsigned char* ws = args.ws;
    unsigned* ctl = (unsigned*)(ws + WS_CTL);

    const float* x = args.in[0]; const float* cvec = args.in[1]; const float* w_ada = args.in[2]; const float* b_ada = args.in[3];
    const float* g_norm1 = args.in[4]; const float* w_in = args.in[5]; const float* w_pool = args.in[6]; const float* pool_scale = args.in[7];
    const float* sgu_ln_g = args.in[8]; const float* sgu_ln_b = args.in[9]; const float* w_spatial = args.in[10]; const float* b_spatial = args.in[11];
    const float* w_out = args.in[12]; const float* g_norm2 = args.in[13]; const float* w_query = args.in[14]; const float* sub_keys = args.in[15];
    const float* expert_down = args.in[16]; const float* expert_up = args.in[17]; const float* g_final = args.in[18];
    float* out = args.out;
    float* mod = (float*)(ws + WS_MOD); float* modp = (float*)(ws + WS_MODP);
    f16_t* WinT = (f16_t*)(ws + WS_WIN); f16_t* WoutT = (f16_t*)(ws + WS_WOUT); f16_t* WqkT = (f16_t*)(ws + WS_WQK);
    f16_t* WpoolT = (f16_t*)(ws + WS_WPOOL); f16_t* Wsp = (f16_t*)(ws + WS_WSP);
    unsigned char* Ed8 = ws + WS_ED; unsigned char* Eu8 = ws + WS_EU; float* EdS = (float*)(ws + WS_EDS); float* EuS = (float*)(ws + WS_EUS);
    f16_t* H1 = (f16_t*)(ws + WS_H1); f16_t* PROJ = (f16_t*)(ws + WS_PROJ); f16_t* MIX = (f16_t*)(ws + WS_MIX); f16_t* H2 = (f16_t*)(ws + WS_H2);
    float* SC = (float*)(ws + WS_SC);

    if (tid < 64) MISC[tid] = 0u;
    __syncthreads();
    XcdBarrier bar; bar.bar = ctl + CW_BAR; bar.x = 0; bar.st = MISC + 8;
    if (N_LAUNCHES == 1) bar = xcd_barrier_post(ctl + CW_BAR, MISC + 8);
#define GRID_BAR() do { if (N_LAUNCHES == 1) xcd_barrier(bar); } while (0)
    const int lo = args.ph_lo, hi = args.ph_hi;
#define IN(k) (lo <= (k) && (k) < hi)
#define BOTH(k) (IN(k) && IN((k) + 1))

    if (IN(0)) {
        LAS float* cact = (LAS float*)lds;
        for (int i = tid; i < BATCH * DM; i += NTHR) { const float v = cvec[i]; cact[i] = v / (1.f + __expf(-v)); }
        __syncthreads();
        const int gw = wg * NWAVES + wave, NGW = G * NWAVES;
        for (int it = gw; it < 96 * 8; it += NGW) {
            const int cc = it % 96, ks = it / 96, e = cc * 64 + lane;
            const float* wp = w_ada + (size_t)(ks * 128) * NMOD + e; const LAS float* ca = cact + ks * 128;
            float a0 = 0.f, a1 = 0.f, a2 = 0.f, a3 = 0.f;
#pragma unroll 8
            for (int k = 0; k < 128; ++k) { const float w = wp[(size_t)k * NMOD]; a0 += ca[k] * w; a1 += ca[DM + k] * w; a2 += ca[2 * DM + k] * w; a3 += ca[3 * DM + k] * w; }
            float* mp = modp + (size_t)(ks * 4) * NMOD + e; mp[0] = a0; mp[NMOD] = a1; mp[2 * NMOD] = a2; mp[3 * NMOD] = a3;
        }
        { LAS float* scr = (LAS float*)(lds + 16384 + wave * 12288);
          constexpr int I_IN = (DM / 64) * (NPROJ / 32), I_OUT = (DM / 64) * (DM / 32), I_POOL = (128 / 64) * (128 / 32);
          for (int it = gw; it < I_IN + I_OUT + 4 * I_POOL; it += NGW) {
              int r = it;
              if (r < I_IN) { p0_transpose_item(w_in, DM, NPROJ, WinT, scr, r, lane); continue; } r -= I_IN;
              if (r < I_OUT) { p0_transpose_item(w_out, DM, DM, WoutT, scr, r, lane); continue; } r -= I_OUT;
              const int g = r / I_POOL; p0_transpose_item(w_pool + g * 16384, 128, 128, WpoolT + g * 16384, scr, r % I_POOL, lane);
          } }
        { const int gt = wg * NTHR + tid, NGT = G * NTHR;
          for (int i = gt; i < 8192; i += NGT) { const int base = i * 8, t = (base >> 7) & 127, s0 = base & 127;
              const f32x4 a = *(const f32x4*)(w_spatial + base), b = *(const f32x4*)(w_spatial + base + 4);
              float v[8] = {a.x, a.y, a.z, a.w, b.x, b.y, b.z, b.w};
#pragma unroll
              for (int e = 0; e < 8; ++e) v[e] = (s0 + e <= t) ? v[e] : 0.f;
              u32x4 o; o.x = pk_f16(v[0], v[1]); o.y = pk_f16(v[2], v[3]); o.z = pk_f16(v[4], v[5]); o.w = pk_f16(v[6], v[7]);
              *(u32x4*)(Wsp + base) = o; }
          }
        for (int rowi = gw; rowi < 2 * NEXP; rowi += NGW) {
            const int tb = rowi >= NEXP, er = tb ? rowi - NEXP : rowi;
            const float* src = (tb ? expert_up : expert_down) + (size_t)er * DM;
            const f32x4 a0 = *(const f32x4*)(src + lane * 8), a1 = *(const f32x4*)(src + lane * 8 + 4), b0 = *(const f32x4*)(src + 512 + lane * 8), b1 = *(const f32x4*)(src + 512 + lane * 8 + 4);
            float m = fmaxf(fmaxf(fmaxf(fabsf(a0.x), fabsf(a0.y)), fmaxf(fabsf(a0.z), fabsf(a0.w))), fmaxf(fmaxf(fabsf(a1.x), fabsf(a1.y)), fmaxf(fabsf(a1.z), fabsf(a1.w))));
            m = fmaxf(m, fmaxf(fmaxf(fmaxf(fabsf(b0.x), fabsf(b0.y)), fmaxf(fabsf(b0.z), fabsf(b0.w))), fmaxf(fmaxf(fabsf(b1.x), fabsf(b1.y)), fmaxf(fabsf(b1.z), fabsf(b1.w)))));
            m = wave_max(m);
            const float sc = m > 0.f ? m * (1.f / 432.f) : 1.f, inv = 1.f / sc;
            int w0 = 0, w1 = 0, w2 = 0, w3 = 0;
            w0 = __builtin_amdgcn_cvt_pk_fp8_f32(a0.x * inv, a0.y * inv, w0, false); w0 = __builtin_amdgcn_cvt_pk_fp8_f32(a0.z * inv, a0.w * inv, w0, true);
            w1 = __builtin_amdgcn_cvt_pk_fp8_f32(a1.x * inv, a1.y * inv, w1, false); w1 = __builtin_amdgcn_cvt_pk_fp8_f32(a1.z * inv, a1.w * inv, w1, true);
            w2 = __builtin_amdgcn_cvt_pk_fp8_f32(b0.x * inv, b0.y * inv, w2, false); w2 = __builtin_amdgcn_cvt_pk_fp8_f32(b0.z * inv, b0.w * inv, w2, true);
            w3 = __builtin_amdgcn_cvt_pk_fp8_f32(b1.x * inv, b1.y * inv, w3, false); w3 = __builtin_amdgcn_cvt_pk_fp8_f32(b1.z * inv, b1.w * inv, w3, true);
            u32x4 o; o.x = (unsigned)w0; o.y = (unsigned)w1; o.z = (unsigned)w2; o.w = (unsigned)w3;
            *(u32x4*)((tb ? Eu8 : Ed8) + (size_t)er * 1024 + lane * 16) = o;
            if (lane == 0) (tb ? EuS : EdS)[er] = sc;
        }
        __syncthreads();
        for (int item = wg; item < 256; item += G) {
            const int hp = item >> 4, D0 = (item & 15) * 64;
            LAS float* SKs = (LAS float*)lds;
            LAS float* WQs = (LAS float*)(lds + 128 * 129 * 4);
            for (int i = tid; i < 128 * 32; i += NTHR) { const int k = i >> 5, d4 = (i & 31) * 4; const f32x4 v = *(const f32x4*)(sub_keys + (size_t)(hp * 128 + k) * 128 + d4);
                LAS float* p = SKs + k * 129 + d4; p[0] = v.x; p[1] = v.y; p[2] = v.z; p[3] = v.w; }
            for (int i = tid; i < 64 * 32; i += NTHR) { const int dd = i >> 5, d4 = (i & 31) * 4; const f32x4 v = *(const f32x4*)(w_query + (size_t)(D0 + dd) * NQK + hp * 128 + d4);
                LAS float* p = WQs + dd * 129 + d4; p[0] = v.x; p[1] = v.y; p[2] = v.z; p[3] = v.w; }
            __syncthreads();
            const int tk = tid >> 4, td = tid & 15;
            float acc[4][4];
#pragma unroll
            for (int i = 0; i < 4; ++i)
#pragma unroll
                for (int j = 0; j < 4; ++j) acc[i][j] = 0.f;
            for (int d = 0; d < 128; ++d) { float a[4], b[4];
#pragma unroll
                for (int i = 0; i < 4; ++i) { a[i] = SKs[(4 * tk + i) * 129 + d]; b[i] = WQs[(4 * td + i) * 129 + d]; }
#pragma unroll
                for (int i = 0; i < 4; ++i)
#pragma unroll
                    for (int j = 0; j < 4; ++j) acc[i][j] += a[i] * b[j]; }
#pragma unroll
            for (int i = 0; i < 4; ++i) { u32x2 o; o.x = pk_f16(acc[i][0], acc[i][1]); o.y = pk_f16(acc[i][2], acc[i][3]);
                *(u32x2*)(WqkT + (size_t)(hp * 128 + 4 * tk + i) * DM + D0 + 4 * td) = o; }
            __syncthreads();
        }
        if (BOTH(0)) GRID_BAR();
    }

    if (IN(1)) {
        LAS float* A = (LAS float*)lds; LAS float* S = A + DM;
        for (int i = wg * NTHR + tid; i < BATCH * NMOD; i += G * NTHR) { const int b = i / NMOD, e = i % NMOD; float s = b_ada[e];
#pragma unroll
            for (int ks = 0; ks < 8; ++ks) s += modp[(size_t)(ks * 4 + b) * NMOD + e];
            mod[i] = s; }
        for (int tile = wg; tile < M / 128; tile += G) {
            const int b = tile >> 6;
            __syncthreads();
            for (int c = tid; c < DM; c += NTHR) { float sh = b_ada[c], sc = b_ada[DM + c];
#pragma unroll
                for (int ks = 0; ks < 8; ++ks) { sh += modp[(size_t)(ks * 4 + b) * NMOD + c]; sc += modp[(size_t)(ks * 4 + b) * NMOD + DM + c]; }
                A[c] = g_norm1[c] * (1.f + sc); S[c] = sh; }
            __syncthreads();
            norm_rows(x, H1, A, S, tile * 128, 128, wave, lane);
        }
        if (BOTH(1)) GRID_BAR();
    }

    if (IN(2)) {
        pg8::Gemm g{H1, WinT, M, NPROJ, DM}; pg8::StaticOrder S; S.init(M, NPROJ, G, wg);
        pg8::EpiF16 E{PROJ, NPROJ};
        pg8::gemm_phase<pg8::EpiF16, pg8::StaticOrder, true, true>(lds, g, S, E);
        if (BOTH(2)) GRID_BAR();
    }

#if defined(DBG_NAIVE_P3)
    if (IN(3)) {
        LAS float* stats = (LAS float*)lds;
        for (int tile = wg; tile < M / 128; tile += G) {
            const int row0 = tile * 128;
            __syncthreads();
            for (int r = wave; r < 128; r += NWAVES) {
                const f16x8 v = *(const f16x8*)(PROJ + (size_t)(row0 + r) * NPROJ + 1024 + lane * 8);
                float s = 0.f;
                for (int e = 0; e < 8; ++e) s += (float)v[e];
                const float mean = wave_sum(s) * (1.f / 512.f); float q = 0.f;
                for (int e = 0; e < 8; ++e) { const float d = (float)v[e] - mean; q += d * d; }
                const float rstd = rsqrtf(wave_sum(q) * (1.f / 512.f) + EPS);
                if (lane == 0) { stats[2 * r] = mean; stats[2 * r + 1] = rstd; }
            }
            __syncthreads();
            const _Float16* PH = (const _Float16*)PROJ;
            for (int i = tid; i < 128 * DM; i += NTHR) {
                const int t = i >> 10, col = i & 1023, row = row0 + t, pos = row & 8191;
                float outv;
                if (col < 512) { const int g = col >> 7, d = col & 127, w = 2 << g; const int cnt = (pos + 1 < w) ? pos + 1 : w; float acc = 0.f;
                    for (int c = 0; c < 128; ++c) { float sm = 0.f; for (int j = 0; j < cnt; ++j) sm += (float)PH[(size_t)(row - j) * NPROJ + g * 128 + c];
                        const float pooled = sm / (float)cnt - (float)PH[(size_t)row * NPROJ + g * 128 + c]; acc += pooled * w_pool[(g * 128 + c) * 128 + d]; }
                    outv = acc * pool_scale[col]; }
                else { const int cc = col - 512, h = cc >> 7; float acc = 0.f;
                    for (int s2 = 0; s2 <= t; ++s2) { const float vn = ((float)PH[(size_t)(row0 + s2) * NPROJ + 1024 + cc] - stats[2 * s2]) * stats[2 * s2 + 1] * sgu_ln_g[cc] + sgu_ln_b[cc];
                        acc += w_spatial[(h * 128 + t) * 128 + s2] * vn; }
                    acc += b_spatial[h * 128 + t];
                    outv = (float)PH[(size_t)row * NPROJ + 512 + cc] * acc; }
                ((_Float16*)MIX)[(size_t)row * DM + col] = (_Float16)outv;
            }
        }
        if (BOTH(3)) GRID_BAR();
    }
#else
    if (IN(3)) {
        constexpr int PITCH = 272;
        LAS unsigned char* img = lds;
        LAS float* stats = (LAS float*)(lds + 512 * PITCH);
        const int fr = lane & 15, fq = lane >> 4;
        for (int tile = wg; tile < M / 128; tile += G) {
            const int row0 = tile * 128;
            __syncthreads();
            for (int r = wave; r < 128; r += NWAVES) {
                const f16x8 v = *(const f16x8*)(PROJ + (size_t)(row0 + r) * NPROJ + 1024 + lane * 8);
                float s = 0.f;
#pragma unroll
                for (int e = 0; e < 8; ++e) s += (float)v[e];
                const float mean = wave_sum(s) * (1.f / 512.f); float q = 0.f;
#pragma unroll
                for (int e = 0; e < 8; ++e) { const float d = (float)v[e] - mean; q += d * d; }
                const float rstd = rsqrtf(wave_sum(q) * (1.f / 512.f) + EPS);
                if (lane == 0) { stats[2 * r] = mean; stats[2 * r + 1] = rstd; }
            }
            __syncthreads();
            { const int cp = tid & 255; const float g0 = sgu_ln_g[2 * cp], g1 = sgu_ln_g[2 * cp + 1], b0 = sgu_ln_b[2 * cp], b1 = sgu_ln_b[2 * cp + 1];
              for (int sb = tid >> 8; sb < 16; sb += 2) {
                  float v0[8], v1[8];
#pragma unroll
                  for (int e = 0; e < 8; ++e) { const int s = sb * 8 + e; const f16x2 hv = *(const f16x2*)(PROJ + (size_t)(row0 + s) * NPROJ + 1024 + 2 * cp);
                      const float mean = stats[2 * s], rstd = stats[2 * s + 1];
                      v0[e] = ((float)hv.x - mean) * rstd * g0 + b0; v1[e] = ((float)hv.y - mean) * rstd * g1 + b1; }
                  u32x4 o0, o1; o0.x = pk_f16(v0[0], v0[1]); o0.y = pk_f16(v0[2], v0[3]); o0.z = pk_f16(v0[4], v0[5]); o0.w = pk_f16(v0[6], v0[7]);
                  o1.x = pk_f16(v1[0], v1[1]); o1.y = pk_f16(v1[2], v1[3]); o1.z = pk_f16(v1[4], v1[5]); o1.w = pk_f16(v1[6], v1[7]);
                  *(LAS u32x4*)(img + (2 * cp) * PITCH + sb * 16) = o0; *(LAS u32x4*)(img + (2 * cp + 1) * PITCH + sb * 16) = o1; } }
            __syncthreads();
            { const int h = wave >> 1, th = wave & 1, t0 = 64 * th;
              const int nks = th ? 4 : 2;
#pragma unroll 1
              for (int ch = 0; ch < 2; ++ch) {
                  f32x4 acc[4][4];
#pragma unroll
                  for (int m = 0; m < 4; ++m)
#pragma unroll
                      for (int n = 0; n < 4; ++n) acc[m][n] = (f32x4){0.f, 0.f, 0.f, 0.f};
                  const f16_t* wbase = Wsp + (size_t)(h * 128 + t0 + fr) * 128 + 8 * fq;
                  const LAS unsigned char* vbase = img + (h * 128 + 64 * ch + fr) * PITCH + 16 * fq;
#pragma unroll 1
                  for (int ks = 0; ks < nks; ++ks) {
                      f16x8 wf[4], vf[4];
#pragma unroll
                      for (int m = 0; m < 4; ++m) wf[m] = *(const f16x8*)(wbase + (16 * m) * 128 + 32 * ks);
#pragma unroll
                      for (int n = 0; n < 4; ++n) vf[n] = *(const LAS f16x8*)(vbase + (16 * n) * PITCH + 64 * ks);
#pragma unroll
                      for (int m = 0; m < 4; ++m)
#pragma unroll
                          for (int n = 0; n < 4; ++n) acc[m][n] = __builtin_amdgcn_mfma_f32_16x16x32_f16(vf[n], wf[m], acc[m][n], 0, 0, 0);
                  }
#pragma unroll
                  for (int m = 0; m < 4; ++m) { const int t = t0 + 16 * m + fr; const float bs = b_spatial[h * 128 + t];
                      const int cb0 = h * 128 + 64 * ch + 4 * fq;
                      const f16_t* up = PROJ + (size_t)(row0 + t) * NPROJ + 512 + cb0; f16_t* op = MIX + (size_t)(row0 + t) * DM + 512 + cb0;
#pragma unroll
                      for (int n = 0; n < 4; ++n) {
                          const f16x4 u = *(const f16x4*)(up + 16 * n);
                          u32x2 o; o.x = pk_f16((float)u[0] * (acc[m][n][0] + bs), (float)u[1] * (acc[m][n][1] + bs)); o.y = pk_f16((float)u[2] * (acc[m][n][2] + bs), (float)u[3] * (acc[m][n][3] + bs));
                          *(u32x2*)(op + 16 * n) = o; } }
              } }
            __syncthreads();
            { const int cp = tid & 255, thh = tid >> 8, g = cp >> 6, w = 2 << g, cl = (2 * cp) & 127;
              const int p0 = (tile & 63) * 128;
              const f16_t* ap = PROJ + (size_t)row0 * NPROJ + 2 * cp;
              float s0 = 0.f, s1 = 0.f;
              const int tt0 = 64 * thh;
              for (int j = 1; j <= w; ++j) { if (p0 + tt0 - j >= 0) { const f16x2 hv = *(const f16x2*)(ap + (ptrdiff_t)(tt0 - j) * NPROJ); s0 += (float)hv.x; s1 += (float)hv.y; } }
              for (int tb = 0; tb < 64; tb += 8) {
                  f16x2 cur[8], old[8];
#pragma unroll
                  for (int e = 0; e < 8; ++e) { const int tt = tt0 + tb + e; cur[e] = *(const f16x2*)(ap + (ptrdiff_t)tt * NPROJ);
                      const bool ok = (p0 + tt - w >= 0); old[e] = ok ? *(const f16x2*)(ap + (ptrdiff_t)(tt - w) * NPROJ) : (f16x2){(_Float16)0.f, (_Float16)0.f}; }
#pragma unroll
                  for (int e = 0; e < 8; ++e) { const int tt = tt0 + tb + e; const int pos = p0 + tt + 1;
                      s0 += (float)cur[e].x; s1 += (float)cur[e].y; s0 -= (float)old[e].x; s1 -= (float)old[e].y;
                      const float inv = 1.f / (float)(pos < w ? pos : w);
                      *(LAS unsigned*)(img + (g * 128 + tt) * PITCH + cl * 2) = pk_f16(s0 * inv - (float)cur[e].x, s1 * inv - (float)cur[e].y); }
              } }
            __syncthreads();
            { const int g = wave >> 1, th = wave & 1, t0 = 64 * th;
#pragma unroll 1
              for (int ch = 0; ch < 2; ++ch) {
                  f32x4 acc[4][4];
#pragma unroll
                  for (int m = 0; m < 4; ++m)
#pragma unroll
                      for (int n = 0; n < 4; ++n) acc[m][n] = (f32x4){0.f, 0.f, 0.f, 0.f};
                  const LAS unsigned char* pbase = img + (g * 128 + t0 + fr) * PITCH + 16 * fq;
                  const f16_t* wbase = WpoolT + (size_t)(g * 128 + 64 * ch + fr) * 128 + 8 * fq;
#pragma unroll 1
                  for (int ks = 0; ks < 4; ++ks) {
                      f16x8 pf[4], wf[4];
#pragma unroll
                      for (int m = 0; m < 4; ++m) pf[m] = *(const LAS f16x8*)(pbase + (16 * m) * PITCH + 64 * ks);
#pragma unroll
                      for (int n = 0; n < 4; ++n) wf[n] = *(const f16x8*)(wbase + (16 * n) * 128 + 32 * ks);
#pragma unroll
                      for (int m = 0; m < 4; ++m)
#pragma unroll
                          for (int n = 0; n < 4; ++n) acc[m][n] = __builtin_amdgcn_mfma_f32_16x16x32_f16(wf[n], pf[m], acc[m][n], 0, 0, 0);
                  }
                  const int cb0 = g * 128 + 64 * ch + 4 * fq;
#pragma unroll
                  for (int m = 0; m < 4; ++m) { const int t = t0 + 16 * m + fr; f16_t* op = MIX + (size_t)(row0 + t) * DM + cb0;
#pragma unroll
                      for (int n = 0; n < 4; ++n) { const f32x4 ps = *(const f32x4*)(pool_scale + cb0 + 16 * n);
                          u32x2 o; o.x = pk_f16(acc[m][n][0] * ps.x, acc[m][n][1] * ps.y); o.y = pk_f16(acc[m][n][2] * ps.z, acc[m][n][3] * ps.w);
                          *(u32x2*)(op + 16 * n) = o; } }
              } }
        }
        if (BOTH(3)) GRID_BAR();
    }
#endif

    if (IN(4)) {
        pg8::Gemm g{MIX, WoutT, M, DM, DM}; pg8::StaticOrder S; S.init(M, DM, G, wg);
        pg8::EpiRes E{x, out, mod + 2 * DM, DM};
        pg8::gemm_phase<pg8::EpiRes, pg8::StaticOrder, true, true>(lds, g, S, E);
        if (BOTH(4)) GRID_BAR();
    }

    if (IN(5)) {
        LAS float* A = (LAS float*)lds; LAS float* S = A + DM;
        for (int tile = wg; tile < M / 128; tile += G) {
            const int b = tile >> 6;
            __syncthreads();
            for (int c = tid; c < DM; c += NTHR) { A[c] = g_norm2[c] * (1.f + mod[b * NMOD + 4 * DM + c]); S[c] = mod[b * NMOD + 3 * DM + c]; }
            __syncthreads();
            norm_rows(out, H2, A, S, tile * 128, 128, wave, lane);
        }
        if (BOTH(5)) GRID_BAR();
    }

    if (IN(6)) {
        pg8::Gemm g{H2, WqkT, M, NQK, DM}; pg8::StaticOrder S; S.init(M, NQK, G, wg);
        pg8::EpiF32 E{SC, NQK};
        pg8::gemm_phase<pg8::EpiF32, pg8::StaticOrder, true, true>(lds, g, S, E);
        if (BOTH(6)) GRID_BAR();
    }

    if (IN(7)) {
        constexpr int TT = 4; static_assert(TT == 4, "the sweeps are written out for four tokens");
        const __amdgpu_buffer_rsrc_t rsD = __builtin_amdgcn_make_buffer_rsrc((void*)Ed8, 0, NEXP * 1024, 0x00020000), rsU = __builtin_amdgcn_make_buffer_rsrc((void*)Eu8, 0, NEXP * 1024, 0x00020000);
        const unsigned lane16 = (unsigned)lane * 16u;
        LAS float* G2 = (LAS float*)lds; LAS float* GF = G2 + DM;
        LAS unsigned* wl = (LAS unsigned*)(lds + 8192 + wave * 8192);
        LAS unsigned* tk = wl; LAS unsigned* pe_idx = wl + 256; LAS float* pe_gate = (LAS float*)(wl + 256 + TT * 128);
        const unsigned pace_n = (N_LAUNCHES == 1 && G == M / 128) ? MISC[8] : 0u;
        unsigned* pace = (unsigned*)(ws + WS_XSYNC) + (bar.x & 15u) * 1024u;
        for (int tile = wg; tile < M / 128; tile += G) {
            const int b = tile >> 6;
            __syncthreads();
            for (int c = tid; c < DM; c += NTHR) { G2[c] = mod[b * NMOD + 5 * DM + c]; GF[c] = g_final[c]; }
            __syncthreads();
#pragma unroll 1
            for (int rnd = 0; rnd < 16 / TT; ++rnd) {
                const int tok0 = tile * 128 + wave + NWAVES * (rnd * TT);
#pragma unroll 1
                for (int t = 0; t < TT; ++t) {
                    LAS unsigned* pi = pe_idx + t * 128; LAS float* pg = pe_gate + t * 128;
                    topk_token(SC + (size_t)(tok0 + NWAVES * t) * NQK, tk, pi, pg, lane);
                    const unsigned ia = pi[lane], ib = pi[64 + lane]; const float ga = pg[lane], gb = pg[64 + lane];
                    unsigned posA = 0, posB = 0, base = 0;
#pragma unroll
                    for (int bd = 0; bd < 16; ++bd) { const bool inA = (ia >> 10) == (unsigned)bd, inB = (ib >> 10) == (unsigned)bd;
                        const unsigned long long ma = __ballot(inA), mb = __ballot(inB);
                        const unsigned ra = __builtin_amdgcn_mbcnt_hi((unsigned)(ma >> 32), __builtin_amdgcn_mbcnt_lo((unsigned)ma, 0u)), rb = __builtin_amdgcn_mbcnt_hi((unsigned)(mb >> 32), __builtin_amdgcn_mbcnt_lo((unsigned)mb, 0u));
                        const unsigned ca = (unsigned)__builtin_popcountll(ma), cb = (unsigned)__builtin_popcountll(mb);
                        posA = inA ? base + ra : posA; posB = inB ? base + ca + rb : posB; base += ca + cb; }
                    __builtin_amdgcn_wave_barrier(); LDS_WAIT();
                    pi[posA] = ia; pi[posB] = ib; pg[posA] = ga; pg[posB] = gb;
                    __builtin_amdgcn_wave_barrier(); LDS_WAIT();
                }
                unsigned idxA[TT], idxB[TT]; float gA[TT], gB[TT], preA[TT], preB[TT]; u32x4 hA[TT], hB[TT];
#pragma unroll
                for (int t = 0; t < TT; ++t) { idxA[t] = pe_idx[t * 128 + lane]; idxB[t] = pe_idx[t * 128 + 64 + lane]; gA[t] = pe_gate[t * 128 + lane]; gB[t] = pe_gate[t * 128 + 64 + lane];
                    const f16_t* hp = H2 + (size_t)(tok0 + NWAVES * t) * DM; hA[t] = *(const u32x4*)(hp + lane * 8); hB[t] = *(const u32x4*)(hp + 512 + lane * 8); preA[t] = 0.f; preB[t] = 0.f; }
                const int rsel = (lane & 7) * 8;
#define CVT8(u, hi) __builtin_amdgcn_cvt_scalef32_pk_f16_fp8((u), 1.0f, (hi))
#define ISSUE(BUF, IDX, L0, RS) do { _Pragma("unroll") for (int j = 0; j < 8; ++j) { const unsigned _e = (unsigned)__builtin_amdgcn_readlane((int)(IDX), (L0) + j); \
            BUF[j] = __builtin_amdgcn_raw_buffer_load_b128(RS, lane16, _e * 1024u, 0); } } while (0)
#define DOT16(R, T, OUT) do { const u32x4 _r = (R); float _sd = 0.f; \
        _sd = __builtin_amdgcn_fdot2(CVT8(_r.x, false), as_h2(hA[T].x), _sd, false); _sd = __builtin_amdgcn_fdot2(CVT8(_r.x, true), as_h2(hA[T].y), _sd, false); \
        _sd = __builtin_amdgcn_fdot2(CVT8(_r.y, false), as_h2(hA[T].z), _sd, false); _sd = __builtin_amdgcn_fdot2(CVT8(_r.y, true), as_h2(hA[T].w), _sd, false); \
        _sd = __builtin_amdgcn_fdot2(CVT8(_r.z, false), as_h2(hB[T].x), _sd, false); _sd = __builtin_amdgcn_fdot2(CVT8(_r.z, true), as_h2(hB[T].y), _sd, false); \
        _sd = __builtin_amdgcn_fdot2(CVT8(_r.w, false), as_h2(hB[T].z), _sd, false); _sd = __builtin_amdgcn_fdot2(CVT8(_r.w, true), as_h2(hB[T].w), _sd, false); OUT = _sd; __builtin_amdgcn_sched_barrier(0); } while (0)
#define CONSUME_DOWN(BUF, T, PREA, PREB, CA, CB) do { float _p[8]; _Pragma("unroll") for (int j = 0; j < 8; ++j) DOT16(BUF[j], T, _p[j]); \
        _Pragma("unroll") for (int j = 0; j < 4; ++j) { const auto _s = __builtin_amdgcn_permlane32_swap(as_u(_p[j]), as_u(_p[j + 4]), false, false); _p[j] = as_f(_s[0]) + as_f(_s[1]); } \
        _Pragma("unroll") for (int j = 0; j < 2; ++j) { const auto _s = __builtin_amdgcn_permlane16_swap(as_u(_p[j]), as_u(_p[j + 2]), false, false); _p[j] = as_f(_s[0]) + as_f(_s[1]); } \
        { const bool _up = (lane & 8) != 0; const float _keep = _up ? _p[1] : _p[0], _send = _up ? _p[0] : _p[1]; float _v = _keep + dppf<0x128>(_send); \
          _v += dppf<0xB1>(_v); _v += dppf<0x4E>(_v); _v += dppf<0x141>(_v); \
          const float _g = __shfl(_v, rsel); PREA = ((lane >> 3) == (CA)) ? _g : PREA; PREB = ((lane >> 3) == (CB)) ? _g : PREB; } } while (0)
#define FMIX(ACC, Q, CSV) do { asm("v_fma_mix_f32 %0, %1, %2, %0 op_sel_hi:[1,0,0]" : "+v"(ACC[0]) : "v"(Q), "s"(CSV)); asm("v_fma_mix_f32 %0, %1, %2, %0 op_sel:[1,0,0] op_sel_hi:[1,0,0]" : "+v"(ACC[1]) : "v"(Q), "s"(CSV)); } while (0)
#define UP_SLOT(R, T, CS) do { const u32x4 _r = (R); const float _cs = (CS); \
        { const f16x2 q0 = CVT8(_r.x, false), q1 = CVT8(_r.x, true), q2 = CVT8(_r.y, false), q3 = CVT8(_r.y, true); \
          FMIX((&acc[T][0]), q0, _cs); FMIX((&acc[T][2]), q1, _cs); FMIX((&acc[T][4]), q2, _cs); FMIX((&acc[T][6]), q3, _cs); } \
        { const f16x2 q4 = CVT8(_r.z, false), q5 = CVT8(_r.z, true), q6 = CVT8(_r.w, false), q7 = CVT8(_r.w, true); \
          FMIX((&acc[T][8]), q4, _cs); FMIX((&acc[T][10]), q5, _cs); FMIX((&acc[T][12]), q6, _cs); FMIX((&acc[T][14]), q7, _cs); } \
        __builtin_amdgcn_sched_barrier(0); } while (0)
#define CONSUME_UP(BUF, T, COEF, L0) do { _Pragma("unroll") for (int j = 0; j < 8; ++j) UP_SLOT(BUF[j], T, as_f((unsigned)__builtin_amdgcn_readlane((int)as_u(COEF), (L0) + j))); } while (0)
                u32x4 bufX[8], bufY[8];
#define SELI(T, C) ((C) < 8 ? idxA[T] : idxB[T])
#define SELC(T, C) ((C) < 8 ? coefA[T] : coefB[T])
#define L0OF(C) (8 * ((C) & 7))
#define CAOF(C) ((C) < 8 ? (C) : 99)
#define CBOF(C) ((C) < 8 ? 99 : (C) - 8)
                xcd_pace(pace + (rnd * 2) * 16, pace_n);
                ISSUE(bufX, idxA[0], 0, rsD);
#pragma unroll 1
                for (int ch = 0; ch < 16; ++ch) { const int chn = ch < 15 ? ch + 1 : 15;
                    ISSUE(bufY, SELI(1, ch), L0OF(ch), rsD); CONSUME_DOWN(bufX, 0, preA[0], preB[0], CAOF(ch), CBOF(ch));
                    ISSUE(bufX, SELI(2, ch), L0OF(ch), rsD); CONSUME_DOWN(bufY, 1, preA[1], preB[1], CAOF(ch), CBOF(ch));
                    ISSUE(bufY, SELI(3, ch), L0OF(ch), rsD); CONSUME_DOWN(bufX, 2, preA[2], preB[2], CAOF(ch), CBOF(ch));
                    ISSUE(bufX, SELI(0, chn), L0OF(chn), rsD); CONSUME_DOWN(bufY, 3, preA[3], preB[3], CAOF(ch), CBOF(ch)); }
                float coefA[TT], coefB[TT];
#pragma unroll
                for (int t = 0; t < TT; ++t) { const float pa = preA[t] * EdS[idxA[t]], pb = preB[t] * EdS[idxB[t]];
                    coefA[t] = gA[t] * gelu_as(pa) * EuS[idxA[t]]; coefB[t] = gB[t] * gelu_as(pb) * EuS[idxB[t]]; }
                float acc[TT][16];
#pragma unroll
                for (int t = 0; t < TT; ++t)
#pragma unroll
                    for (int j = 0; j < 16; ++j) acc[t][j] = 0.f;
                xcd_pace(pace + (rnd * 2 + 1) * 16, pace_n);
                ISSUE(bufX, idxA[0], 0, rsU);
#pragma unroll 1
                for (int ch = 0; ch < 16; ++ch) { const int chn = ch < 15 ? ch + 1 : 15;
                    ISSUE(bufY, SELI(1, ch), L0OF(ch), rsU); CONSUME_UP(bufX, 0, SELC(0, ch), L0OF(ch));
                    ISSUE(bufX, SELI(2, ch), L0OF(ch), rsU); CONSUME_UP(bufY, 1, SELC(1, ch), L0OF(ch));
                    ISSUE(bufY, SELI(3, ch), L0OF(ch), rsU); CONSUME_UP(bufX, 2, SELC(2, ch), L0OF(ch));
                    ISSUE(bufX, SELI(0, chn), L0OF(chn), rsU); CONSUME_UP(bufY, 3, SELC(3, ch), L0OF(ch)); }
#undef CBOF
#undef CAOF
#undef L0OF
#undef SELC
#undef SELI
#undef CONSUME_UP
#undef UP_SLOT
#undef FMIX
#undef CONSUME_DOWN
#undef DOT16
#undef ISSUE
#undef CVT8
#pragma unroll
                for (int t = 0; t < TT; ++t) {
                    float* orow = out + (size_t)(tok0 + NWAVES * t) * DM;
                    f32x4 xv[4]; xv[0] = *(const f32x4*)(orow + lane * 8); xv[1] = *(const f32x4*)(orow + lane * 8 + 4); xv[2] = *(const f32x4*)(orow + 512 + lane * 8); xv[3] = *(const f32x4*)(orow + 512 + lane * 8 + 4);
                    float ss = 0.f;
#pragma unroll
                    for (int q = 0; q < 4; ++q) { const int cb = (q >> 1) * 512 + lane * 8 + (q & 1) * 4; const f32x4 g2 = *(const LAS f32x4*)(G2 + cb);
                        xv[q].x += g2.x * acc[t][4 * q + 0]; xv[q].y += g2.y * acc[t][4 * q + 1]; xv[q].z += g2.z * acc[t][4 * q + 2]; xv[q].w += g2.w * acc[t][4 * q + 3];
                        ss += (xv[q].x * xv[q].x + xv[q].y * xv[q].y) + (xv[q].z * xv[q].z + xv[q].w * xv[q].w); }
                    const float rstd = rsqrtf(wave_total(ss) * (1.f / DM) + EPS);
#pragma unroll
                    for (int q = 0; q < 4; ++q) { const int cb = (q >> 1) * 512 + lane * 8 + (q & 1) * 4; const f32x4 gf = *(const LAS f32x4*)(GF + cb);
                        *(f32x4*)(orow + cb) = xv[q] * rstd * gf; }
                    __builtin_amdgcn_sched_barrier(0);
                }
            }
        }
    }
#undef IN
#undef BOTH
#undef GRID_BAR
}


#if defined(DBG_CHECK)
constexpr size_t WS_FLAGS = 32 * 1024, WS_SNAP = 12 * MiB;
constexpr int NSAMP_TOK = 64;
__device__ __forceinline__ unsigned hash32(unsigned x) { x ^= x >> 16; x *= 0x7feb352du; x ^= x >> 15; x *= 0x846ca68bu; x ^= x >> 16; return x; }
__device__ __forceinline__ void chk(unsigned* flags, int id, float got, float ref, float atol, float rtol) { if (!(fabsf(got - ref) <= atol + rtol * fabsf(ref))) atomicAdd(&flags[id], 1u); }
__device__ __forceinline__ int samp_tok(int j) { return (j < 8) ? j * 4681 % M : (j < 16 ? ((j - 8) & 3) * 8192 + (j & 1) * 127 + (j >> 2 & 1) * 4000 : (int)(hash32(j * 977u + 5u) % M)); }
__global__ void dbg_check(Args args, int which) {
    unsigned char* ws = args.ws; unsigned* flags = (unsigned*)(ws + WS_FLAGS);
    const float* x = args.in[0]; const float* cvec = args.in[1]; const float* w_ada = args.in[2]; const float* b_ada = args.in[3];
    const float* g_norm1 = args.in[4]; const float* w_in = args.in[5]; const float* w_pool = args.in[6]; const float* pool_scale = args.in[7];
    const float* sgu_ln_g = args.in[8]; const float* sgu_ln_b = args.in[9]; const float* w_spatial = args.in[10]; const float* b_spatial = args.in[11];
    const float* w_out = args.in[12]; const float* g_norm2 = args.in[13]; const float* w_query = args.in[14]; const float* sub_keys = args.in[15];
    const float* expert_down = args.in[16]; const float* expert_up = args.in[17]; const float* g_final = args.in[18];
    const float* mod = (const float*)(ws + WS_MOD);
    const _Float16* H1 = (const _Float16*)(ws + WS_H1); const _Float16* PROJ = (const _Float16*)(ws + WS_PROJ); const _Float16* MIX = (const _Float16*)(ws + WS_MIX); const _Float16* H2 = (const _Float16*)(ws + WS_H2);
    const float* SC = (const float*)(ws + WS_SC); float* snap = (float*)(ws + WS_SNAP); const float* out = args.out;
    const unsigned gt = blockIdx.x * blockDim.x + threadIdx.x, NGT = gridDim.x * blockDim.x;
    if (which == 1) {
        for (unsigned i = gt; i < BATCH * NMOD; i += NGT) { const int b = i / NMOD, e = i % NMOD; float s = b_ada[e];
            for (int d = 0; d < DM; ++d) { const float c = cvec[b * DM + d]; s += (c / (1.f + expf(-c))) * w_ada[(size_t)d * NMOD + e]; }
            chk(flags, 1, mod[i], s, 1e-3f, 1e-3f); }
    } else if (which == 2) {
        for (unsigned i = gt; i < 4096 * 16; i += NGT) { const int row = hash32(i >> 4) % M, c0 = (i & 15) * 64, b = row >> 13; float ss = 0.f;
            for (int c = 0; c < DM; ++c) { const float v = x[(size_t)row * DM + c]; ss += v * v; }
            const float rstd = rsqrtf(ss / DM + EPS);
            for (int c = c0; c < c0 + 64; ++c) { const float ref = x[(size_t)row * DM + c] * rstd * g_norm1[c] * (1.f + mod[b * NMOD + DM + c]) + mod[b * NMOD + c];
                chk(flags, 2, (float)H1[(size_t)row * DM + c], ref, 4e-3f, 2e-3f); } }
    } else if (which == 3) {
        for (unsigned i = gt; i < 65536; i += NGT) { const unsigned h = hash32(i * 3u + 1u); const int row = h % M, col = (h >> 15) % NPROJ; float s = 0.f;
            for (int k = 0; k < DM; ++k) s += (float)H1[(size_t)row * DM + k] * w_in[(size_t)k * NPROJ + col];
            chk(flags, 3, (float)PROJ[(size_t)row * NPROJ + col], s, 1e-2f, 5e-3f); }
    } else if (which == 4) {
        for (unsigned i = gt; i < 32768; i += NGT) { const unsigned h = hash32(i * 5u + 2u); const int row = (i < 2048) ? ((i & 7) * 8192 % M + (i >> 3) % 32) : (int)(h % M), col = (h >> 15) % DM, pos = row & 8191; float ref;
            if (col < 512) { const int g = col >> 7, d = col & 127, w = 2 << g; const int cnt = (pos + 1 < w) ? pos + 1 : w; float acc = 0.f;
                for (int c = 0; c < 128; ++c) { float sm = 0.f; for (int j = 0; j < cnt; ++j) sm += (float)PROJ[(size_t)(row - j) * NPROJ + g * 128 + c];
                    acc += (sm / (float)cnt - (float)PROJ[(size_t)row * NPROJ + g * 128 + c]) * w_pool[(g * 128 + c) * 128 + d]; }
                ref = acc * pool_scale[col]; }
            else { const int cc = col - 512, hh = cc >> 7, t = row & 127, r0 = row - t; float acc = 0.f;
                for (int s2 = 0; s2 <= t; ++s2) { float mean = 0.f, var = 0.f; const _Float16* vr = PROJ + (size_t)(r0 + s2) * NPROJ + 1024;
                    for (int k = 0; k < 512; ++k) mean += (float)vr[k]; mean /= 512.f; for (int k = 0; k < 512; ++k) { const float dd = (float)vr[k] - mean; var += dd * dd; }
                    const float vn = ((float)vr[cc] - mean) * rsqrtf(var / 512.f + EPS) * sgu_ln_g[cc] + sgu_ln_b[cc]; acc += w_spatial[(hh * 128 + t) * 128 + s2] * vn; }
                ref = (float)PROJ[(size_t)row * NPROJ + 512 + cc] * (acc + b_spatial[hh * 128 + t]); }
            chk(flags, 4, (float)MIX[(size_t)row * DM + col], ref, 3e-2f, 1e-2f); }
    } else if (which == 5) {
        for (unsigned i = gt; i < 65536; i += NGT) { const unsigned h = hash32(i * 7u + 3u); const int row = h % M, col = (h >> 15) % DM, b = row >> 13; float s = 0.f;
            for (int k = 0; k < DM; ++k) s += (float)MIX[(size_t)row * DM + k] * w_out[(size_t)k * DM + col];
            chk(flags, 5, out[(size_t)row * DM + col], x[(size_t)row * DM + col] + mod[b * NMOD + 2 * DM + col] * s, 2e-2f, 5e-3f); }
    } else if (which == 6) {
        for (unsigned i = gt; i < 4096 * 16; i += NGT) { const int row = hash32((i >> 4) + 777u) % M, c0 = (i & 15) * 64, b = row >> 13; float ss = 0.f;
            for (int c = 0; c < DM; ++c) { const float v = out[(size_t)row * DM + c]; ss += v * v; }
            const float rstd = rsqrtf(ss / DM + EPS);
            for (int c = c0; c < c0 + 64; ++c) { const float ref = out[(size_t)row * DM + c] * rstd * g_norm2[c] * (1.f + mod[b * NMOD + 4 * DM + c]) + mod[b * NMOD + 3 * DM + c];
                chk(flags, 6, (float)H2[(size_t)row * DM + c], ref, 4e-3f, 2e-3f); } }
        for (unsigned i = gt; i < NSAMP_TOK * DM; i += NGT) snap[i] = out[(size_t)samp_tok(i / DM) * DM + (i % DM)];
    } else if (which == 8) {
        const _Float16* Ed = (const _Float16*)(ws + WS_ED); const _Float16* Eu = (const _Float16*)(ws + WS_EU);
        for (unsigned i = gt; i < 262144; i += NGT) { const size_t j = (size_t)(hash32(i * 13u + 6u) % (unsigned)(NEXP * DM));
            chk(flags, 8, (float)Ed[j], expert_down[j], 1e-5f, 1e-3f); chk(flags, 8, (float)Eu[j], expert_up[j], 1e-5f, 1e-3f); }
    } else if (which == 7) {
        for (unsigned i = gt; i < 16384; i += NGT) { const unsigned h = hash32(i * 11u + 4u); const int row = h % M, n = (h >> 15) % NQK, hp = n >> 7, k = n & 127; float s = 0.f;
            for (int d = 0; d < 128; ++d) { float q = 0.f; for (int kk = 0; kk < DM; ++kk) q += (float)H2[(size_t)row * DM + kk] * w_query[(size_t)kk * NQK + hp * 128 + d];
                s += q * sub_keys[(size_t)(hp * 128 + k) * 128 + d]; }
            chk(flags, 7, SC[(size_t)row * NQK + n], s, 2e-2f, 5e-3f); }
    }
}
__global__ void dbg_check_peer(Args args) {
    __shared__ float sc[2048]; __shared__ float stop[16][16]; __shared__ int itop[16][16]; __shared__ float cand[8][256]; __shared__ float gate[128]; __shared__ int eidx[128]; __shared__ float red[256];
    unsigned char* ws = args.ws; unsigned* flags = (unsigned*)(ws + WS_FLAGS);
    const float* expert_down = args.in[16]; const float* expert_up = args.in[17]; const float* g_final = args.in[18];
    const float* mod = (const float*)(ws + WS_MOD); const _Float16* H2 = (const _Float16*)(ws + WS_H2); const float* SC = (const float*)(ws + WS_SC); const float* snap = (const float*)(ws + WS_SNAP);
    const int j = blockIdx.x, tok = samp_tok(j), t = threadIdx.x, b = tok >> 13;
    for (int i = t; i < 2048; i += 256) sc[i] = SC[(size_t)tok * NQK + i];
    __syncthreads();
    if (t < 16) { for (int r = 0; r < 16; ++r) { int bi = 0; float bv = -3e38f; for (int k = 0; k < 128; ++k) { const float v = sc[t * 128 + k]; if (v > bv) { bv = v; bi = k; } } stop[t][r] = bv; itop[t][r] = bi; sc[t * 128 + bi] = -3e38f; } }
    __syncthreads();
    for (int i = t; i < 2048; i += 256) { const int h = i >> 8, a = (i >> 4) & 15, c = i & 15; cand[h][a * 16 + c] = stop[2 * h][a] + stop[2 * h + 1][c]; }
    __syncthreads();
    if (t < 8) { float bv[16]; float mx = -3e38f; for (int r = 0; r < 16; ++r) { int bi = 0; float v0 = -3e38f; for (int k = 0; k < 256; ++k) { const float v = cand[t][k]; if (v > v0) { v0 = v; bi = k; } }
            cand[t][bi] = -3e38f; gate[t * 16 + r] = v0; eidx[t * 16 + r] = itop[2 * t][bi >> 4] * 128 + itop[2 * t + 1][bi & 15]; mx = fmaxf(mx, v0); }
        float sm = 0.f; for (int r = 0; r < 16; ++r) { const float e = expf(gate[t * 16 + r] - mx); gate[t * 16 + r] = e; sm += e; } for (int r = 0; r < 16; ++r) gate[t * 16 + r] /= sm; }
    __syncthreads();
    const unsigned* DI = (const unsigned*)(ws + 400 * MiB); const float* DG = (const float*)(ws + 416 * MiB); const float* DC = (const float*)(ws + 432 * MiB);
    __shared__ int fidx[128]; __shared__ float fcoef[128];
    if (t < 128) { const int h = t >> 4; const unsigned fi = DI[(size_t)tok * 128 + t]; const float fg = DG[(size_t)tok * 128 + t]; int found = -1;
        for (int r = 0; r < 16; ++r) if (eidx[h * 16 + r] == (int)fi) found = r;
        if (found < 0 || fi >= (unsigned)NEXP) atomicAdd(&flags[10], 1u); else chk(flags, 11, fg, gate[h * 16 + found], 2e-3f, 1e-2f);
        const unsigned fic = fi < (unsigned)NEXP ? fi : 0u; fidx[t] = (int)fic;
        float s = 0.f; const float* ur = expert_down + (size_t)fic * DM; for (int d = 0; d < DM; ++d) s += ur[d] * (float)H2[(size_t)tok * DM + d];
        const float cref = fg * 0.5f * s * (1.f + erff(s * 0.70710678f)); const float fc = DC[(size_t)tok * 128 + t];
        chk(flags, 12, fc, cref, 2e-3f, 1e-2f); fcoef[t] = fc; }
    __syncthreads();
    float x2[4]; float ss = 0.f;
    for (int q = 0; q < 4; ++q) { const int c = t + 256 * q; float o = 0.f; for (int k = 0; k < 128; ++k) o += fcoef[k] * expert_up[(size_t)fidx[k] * DM + c];
        x2[q] = snap[(size_t)j * DM + c] + mod[b * NMOD + 5 * DM + c] * o; ss += x2[q] * x2[q]; }
    red[t] = ss; __syncthreads();
    for (int o = 128; o > 0; o >>= 1) { if (t < o) red[t] += red[t + o]; __syncthreads(); }
    const float rstd = rsqrtf(red[0] / DM + EPS);
    for (int q = 0; q < 4; ++q) { const int c = t + 256 * q; chk(flags, 13, args.out[(size_t)tok * DM + c], x2[q] * rstd * g_final[c], 2e-2f, 1e-2f); }
}
__global__ void dbg_report(Args args) {
    const unsigned* flags = (const unsigned*)(args.ws + WS_FLAGS); int id = 0;
    for (int k = 1; k < 16; ++k) if (flags[k] > ((k == 10 || k == 11) ? 40u : 0u) && !id) id = k;
    if (!id) return; float f = 1.f + 2.f * id; if (id >= 10) { const float fr = (float)flags[id] / 8192.f; f = 1.f + (float)id + 0.9f * (fr > 1.f ? 1.f : fr); }
    for (size_t i = (size_t)blockIdx.x * blockDim.x + threadIdx.x; i < (size_t)M * DM; i += (size_t)gridDim.x * blockDim.x) args.out[i] *= f;
}
#endif
extern "C" void kernel_launch(void* const* d_in, const int* in_sizes, int n_in, void* d_out, int out_size, void* d_ws, size_t ws_size, hipStream_t stream) {
    static int grid = 0;
    if (grid == 0) {
        if (n_in != 19 || out_size != M * DM || ws_size < WS_END) { fprintf(stderr, "kernel_launch: unexpected shapes (n_in %d out %d ws %zu)\n", n_in, out_size, ws_size); grid = -1; return; }
        int dev = 0, cus = 0, per_cu = 0;
        if (hipGetDevice(&dev) != hipSuccess || hipDeviceGetAttribute(&cus, hipDeviceAttributeMultiprocessorCount, dev) != hipSuccess) { grid = -1; return; }
        if (hipFuncSetAttribute((const void*)fwd_kernel, hipFuncAttributeMaxDynamicSharedMemorySize, LDS_BYTES) != hipSuccess) { fprintf(stderr, "kernel_launch: hipFuncSetAttribute failed\n"); grid = -1; return; }
        if (hipOccupancyMaxActiveBlocksPerMultiprocessor(&per_cu, (const void*)fwd_kernel, NTHR, LDS_BYTES) != hipSuccess || per_cu < 1) { fprintf(stderr, "kernel_launch: occupancy query says %d\n", per_cu); }
        (void)hipGetLastError();
        grid = cus;
    }
    if (grid < 0) return;
    (void)hipMemsetAsync((char*)d_ws + WS_CTL, 0, CTL_ZERO_BYTES, stream);
    Args a{};
    for (int i = 0; i < 19; ++i) a.in[i] = (const float*)d_in[i];
    a.out = (float*)d_out; a.ws = (unsigned char*)d_ws;
    if (N_LAUNCHES == 1) {
        a.ph_lo = 0; a.ph_hi = N_PHASES;
        void* kargs[] = {&a};
        hipError_t e = hipLaunchCooperativeKernel((const void*)fwd_kernel, dim3(grid), dim3(NTHR), kargs, LDS_BYTES, stream);
        if (e != hipSuccess) fprintf(stderr, "kernel_launch: cooperative launch failed: %s (grid %d)\n", hipGetErrorString(e), grid);
    } else {
        for (int p = 0; p < N_PHASES; ++p) { a.ph_lo = p; a.ph_hi = p + 1; hipLaunchKernelGGL(fwd_kernel, dim3(grid), dim3(NTHR), LDS_BYTES, stream, a);
#if defined(DBG_CHECK)
            if (p >= 1 && p <= 6) hipLaunchKernelGGL(dbg_check, dim3(1024), dim3(256), 0, stream, a, p);
            if (p == 0) hipLaunchKernelGGL(dbg_check, dim3(1024), dim3(256), 0, stream, a, 8);
            if (p == 6) hipLaunchKernelGGL(dbg_check, dim3(1024), dim3(256), 0, stream, a, 7);
            if (p == 7) { hipLaunchKernelGGL(dbg_check_peer, dim3(NSAMP_TOK), dim3(256), 0, stream, a); hipLaunchKernelGGL(dbg_report, dim3(1024), dim3(256), 0, stream, a); }
#endif
        }
    }
}
```

```cpp
#include <hip/hip_runtime.h>
#include <cstdio>
#include <cstdint>

#ifndef MK_N_LAUNCHES
#define MK_N_LAUNCHES 1
#endif

#define LAS __attribute__((address_space(3)))
#define GAS __attribute__((address_space(1)))
typedef unsigned short f16_t;
typedef _Float16 f16x8 __attribute__((ext_vector_type(8)));
typedef _Float16 f16x4 __attribute__((ext_vector_type(4)));
typedef _Float16 f16x2 __attribute__((ext_vector_type(2)));
typedef float f32x4 __attribute__((ext_vector_type(4)));
typedef unsigned u32x4 __attribute__((ext_vector_type(4)));
typedef int i32x4 __attribute__((ext_vector_type(4)));
typedef unsigned u32x2 __attribute__((ext_vector_type(2)));

__device__ __forceinline__ f16x2 as_h2(unsigned u) { return __builtin_bit_cast(f16x2, u); }
__device__ __forceinline__ float as_f(unsigned u) { return __builtin_bit_cast(float, u); }
__device__ __forceinline__ unsigned as_u(float f) { return __builtin_bit_cast(unsigned, f); }
__device__ __forceinline__ unsigned pk_i8(float __attribute__((ext_vector_type(4))) v) {
    const int a = (int)__builtin_rintf(v.x), b = (int)__builtin_rintf(v.y), c = (int)__builtin_rintf(v.z), d = (int)__builtin_rintf(v.w);
    return ((unsigned)a & 255u) | (((unsigned)b & 255u) << 8) | (((unsigned)c & 255u) << 16) | ((unsigned)d << 24); }
__device__ __forceinline__ unsigned pk_f16(float lo, float hi) { f16x2 v = {(_Float16)lo, (_Float16)hi}; return __builtin_bit_cast(unsigned, v); }

namespace pg8 {
constexpr int BM = 256, BK = 64, HALF = 128, HTB = HALF * BK * 2, STAGE_BYTES = 8 * HTB, NXCD = 8, WGM = 8;
__host__ __device__ __forceinline__ int lds_byte(int r, int c) { const int st = (r >> 4) * 2 + (c >> 5), rr = r & 15, cc = c & 31, ob = rr * 64 + cc * 2; return st * 1024 + (ob ^ (((ob >> 9) & 1) << 5)); }
__host__ __device__ __forceinline__ void stage_rc(int b, int& R, int& C) { const int st = b / 1024, sb = b % 1024, swz = sb ^ (((sb >> 9) & 1) << 5); R = (st >> 1) * 16 + swz / 64; C = (st & 1) * 32 + (swz % 64) / 2; }
__host__ __device__ __forceinline__ int perm32(int rho) { const int n = rho >> 4, i = rho & 15; return 8 * (i >> 2) + 4 * n + (i & 3); }
struct Unit { int pm, pn; };
struct Gemm { const f16_t* A; const f16_t* Bt; int M, N, K; };
struct StaticOrder {
    int nM, nN, nwg, G, c;
    __host__ __device__ void init(int M, int N, int G_, int c_) { nM = M / BM; nN = N / BM; nwg = nM * nN; G = G_; c = c_; }
    __host__ __device__ bool next(int i, Unit& u) const {
        const long L = (long)i * G + c; if (L >= nwg) return false;
        int wgid = (int)L; { const int q = nwg / NXCD, r = nwg % NXCD, xcd = wgid % NXCD, off = wgid / NXCD; wgid = (xcd < r ? xcd * (q + 1) : r * (q + 1) + (xcd - r) * q) + off; }
        const int nig = WGM * nN, gid = wgid / nig, fm = gid * WGM, gsz = (nM - fm) < WGM ? (nM - fm) : WGM;
        u.pm = fm + ((wgid % nig) % gsz); u.pn = (wgid % nig) / gsz; return true;
    }
    __device__ __forceinline__ void a_ready(const Unit&) const {}
    __device__ __forceinline__ void done(const Unit&) const {}
};
struct EpiF16 {
    static constexpr bool PERM = true, AFTER_DRAIN = false;
    f16_t* O; int ldc;
    __device__ __forceinline__ void operator()(const f32x4 (&acc)[2][2][4][2], const Unit& u, int wr, int wc, int fr, int fq) const {
        const int row0 = u.pm * BM + wr * 64 + fr, col0 = u.pn * BM + wc * 32 + 8 * fq;
#pragma unroll
        for (int ai = 0; ai < 2; ++ai)
#pragma unroll
            for (int m = 0; m < 4; ++m) { f16_t* rowp = O + (size_t)(row0 + ai * HALF + m * 16) * ldc + col0;
#pragma unroll
                for (int bj = 0; bj < 2; ++bj) { const f32x4 v0 = acc[ai][bj][m][0], v1 = acc[ai][bj][m][1];
                    u32x4 w; w.x = pk_f16(v0[0], v0[1]); w.y = pk_f16(v0[2], v0[3]); w.z = pk_f16(v1[0], v1[1]); w.w = pk_f16(v1[2], v1[3]);
                    *(u32x4*)(rowp + bj * HALF) = w; } }
    }
};
struct EpiF32 {
    static constexpr bool PERM = false, AFTER_DRAIN = false;
    float* C; int ldc;
    __device__ __forceinline__ void operator()(const f32x4 (&acc)[2][2][4][2], const Unit& u, int wr, int wc, int fr, int fq) const {
        const int row0 = u.pm * BM + wr * 64 + fr, col0 = u.pn * BM + wc * 32 + 4 * fq;
#pragma unroll
        for (int ai = 0; ai < 2; ++ai)
#pragma unroll
            for (int m = 0; m < 4; ++m) { float* rowp = C + (size_t)(row0 + ai * HALF + m * 16) * ldc + col0;
#pragma unroll
                for (int bj = 0; bj < 2; ++bj)
#pragma unroll
                    for (int n = 0; n < 2; ++n) *(f32x4*)(rowp + bj * HALF + n * 16) = acc[ai][bj][m][n]; }
    }
};
struct EpiRes {
    static constexpr bool PERM = false, AFTER_DRAIN = false;
    const float* X; float* O; const float* gate; int ldc;
    __device__ __forceinline__ void operator()(const f32x4 (&acc)[2][2][4][2], const Unit& u, int wr, int wc, int fr, int fq) const {
        const int row0 = u.pm * BM + wr * 64 + fr, col0 = u.pn * BM + wc * 32 + 4 * fq;
        const float* g = gate + (size_t)((u.pm * BM) >> 13) * 6144;
        f32x4 gv[2][2];
#pragma unroll
        for (int bj = 0; bj < 2; ++bj)
#pragma unroll
            for (int n = 0; n < 2; ++n) gv[bj][n] = *(const f32x4*)(g + col0 + bj * HALF + n * 16);
#pragma unroll
        for (int ai = 0; ai < 2; ++ai)
#pragma unroll
            for (int m = 0; m < 4; ++m) { const size_t off = (size_t)(row0 + ai * HALF + m * 16) * ldc + col0;
#pragma unroll
                for (int bj = 0; bj < 2; ++bj)
#pragma unroll
                    for (int n = 0; n < 2; ++n) { const f32x4 xv = *(const f32x4*)(X + off + bj * HALF + n * 16); *(f32x4*)(O + off + bj * HALF + n * 16) = xv + gv[bj][n] * acc[ai][bj][m][n]; }
                if (m & 1) asm volatile("" ::: "memory"); }
    }
};

template <class Epi, class Sched, bool ALIGN_EPI = false, bool SP2 = false>
__device__ __forceinline__ void gemm_phase(LAS unsigned char* lds, const Gemm g, const Sched& S, const Epi& E) {
    const int tid = threadIdx.x, wid = __builtin_amdgcn_readfirstlane(tid >> 6), lane = tid & 63, wr = wid >> 2, wc = wid & 3, fr = lane & 15, fq = lane >> 4;
    const int K = g.K, nt = K / BK;
    unsigned voffA[2], voffB[2];
#pragma unroll
    for (int i = 0; i < 2; ++i) { int R, C; stage_rc(tid * 16 + i * 8192, R, C); const int Rb = Epi::PERM ? ((R & ~31) + perm32(R & 31)) : R;
        voffA[i] = (unsigned)(R * K + C) * 2u; voffB[i] = (unsigned)(Rb * K + C) * 2u; }
    const size_t kstep = (size_t)(BK * 2);
    const size_t hstep = (size_t)HALF * K * 2;
    const size_t tstep = 2 * hstep;
    const unsigned ldsw = (unsigned)wid * 1024u;
    const int aoff = lds_byte(wr * 64 + fr, fq * 8), boff = lds_byte(wc * 32 + fr, fq * 8);
#define PG8_SA(b, h) (((b) * 2 + (h)) * HTB)
#define PG8_SB(b, h) ((4 + (b) * 2 + (h)) * HTB)
#define PG8_STAGE(bufoff, gbase, voff) do { _Pragma("unroll") for (int _i = 0; _i < 2; ++_i) \
        __builtin_amdgcn_global_load_lds((const unsigned*)((const char*)(gbase) + (voff)[_i]), (LAS unsigned*)(lds + (bufoff) + ldsw + _i * 8192), 16, 0, 0); } while (0)
#define PG8_LDA(dst, b, h) do { _Pragma("unroll") for (int m = 0; m < 4; ++m) _Pragma("unroll") for (int k = 0; k < 2; ++k) dst[m][k] = *(const LAS f16x8*)(lds + PG8_SA(b, h) + aoff + m * 2048 + k * 1024); } while (0)
#define PG8_LDB(dst, b, h) do { _Pragma("unroll") for (int n = 0; n < 2; ++n) _Pragma("unroll") for (int k = 0; k < 2; ++k) dst[n][k] = *(const LAS f16x8*)(lds + PG8_SB(b, h) + boff + n * 2048 + k * 1024); } while (0)
#define PG8_MMA(ai, bj, At, Bt) do { __builtin_amdgcn_s_setprio(1); _Pragma("unroll") for (int m = 0; m < 4; ++m) _Pragma("unroll") for (int n = 0; n < 2; ++n) _Pragma("unroll") for (int k = 0; k < 2; ++k) \
        acc[ai][bj][m][n] = __builtin_amdgcn_mfma_f32_16x16x32_f16(Bt[n][k], At[m][k], acc[ai][bj][m][n], 0, 0, 0); __builtin_amdgcn_s_setprio(0); } while (0)
#define PG8_WAIT_V(n) asm volatile("s_waitcnt vmcnt(" #n ")" ::: "memory")
#define PG8_WAIT_L(n) asm volatile("s_waitcnt lgkmcnt(" #n ")" ::: "memory")
#define PG8_BAR __builtin_amdgcn_s_barrier()
#define PG8_SCHED __builtin_amdgcn_sched_barrier(0)
    Unit cur, nxt; int ui = 0;
    if (!S.next(0, cur)) return;
    f32x4 acc[2][2][4][2];
#pragma unroll
    for (int a = 0; a < 2; ++a)
#pragma unroll
        for (int b = 0; b < 2; ++b)
#pragma unroll
            for (int m = 0; m < 4; ++m)
#pragma unroll
                for (int n = 0; n < 2; ++n) acc[a][b][m][n] = (f32x4){0.f, 0.f, 0.f, 0.f};
    f16x8 At[4][2], B0[2][2], B1[2][2];
    const char* cA = (const char*)g.A + (size_t)cur.pm * tstep; const char* cB = (const char*)g.Bt + (size_t)cur.pn * tstep;
    S.a_ready(cur);
    if constexpr (SP2) {
        PG8_STAGE(PG8_SB(0, 0), cB, voffB); PG8_STAGE(PG8_SB(0, 1), cB + hstep, voffB); PG8_STAGE(PG8_SA(0, 0), cA, voffA); PG8_STAGE(PG8_SA(0, 1), cA + hstep, voffA);
        if (wr == 1) PG8_BAR;
        PG8_WAIT_V(2); PG8_BAR;
        PG8_STAGE(PG8_SB(1, 0), cB + kstep, voffB); PG8_STAGE(PG8_SA(1, 0), cA + kstep, voffA); PG8_STAGE(PG8_SB(1, 1), cB + hstep + kstep, voffB);
        PG8_WAIT_V(6); PG8_BAR;
    } else {
        PG8_STAGE(PG8_SB(0, 0), cB, voffB); PG8_STAGE(PG8_SA(0, 0), cA, voffA); PG8_STAGE(PG8_SB(0, 1), cB + hstep, voffB); PG8_STAGE(PG8_SA(0, 1), cA + hstep, voffA);
        if (wr == 1) PG8_BAR;
        PG8_WAIT_V(4); PG8_BAR;
        PG8_STAGE(PG8_SB(1, 0), cB + kstep, voffB); PG8_STAGE(PG8_SA(1, 0), cA + kstep, voffA); PG8_STAGE(PG8_SB(1, 1), cB + hstep + kstep, voffB);
        PG8_WAIT_V(6); PG8_BAR;
    }
    for (;;) {
        const bool has_next = S.next(ui + 1, nxt);
        const char* nA = has_next ? (const char*)g.A + (size_t)nxt.pm * tstep : cA; const char* nB = has_next ? (const char*)g.Bt + (size_t)nxt.pn * tstep : cB;
        for (int t = 0; t < nt; t += 2) {
            const bool last = (t == nt - 2);
            const char* a1 = cA + (size_t)(t + 1) * kstep;
            const char* a2 = last ? nA : cA + (size_t)(t + 2) * kstep; const char* b2 = last ? nB : cB + (size_t)(t + 2) * kstep;
            const char* a3 = a2 + kstep; const char* b3 = b2 + kstep;
            if (last && has_next) S.a_ready(nxt);
            if constexpr (SP2) {
            PG8_LDB(B0, 0, 0); PG8_LDB(B1, 0, 1); PG8_SCHED; PG8_LDA(At, 0, 0); PG8_STAGE(PG8_SA(1, 1), a1 + hstep, voffA);
            PG8_WAIT_V(8); PG8_WAIT_L(0); PG8_BAR; PG8_MMA(0, 0, At, B0); PG8_MMA(0, 1, At, B1); PG8_BAR; PG8_SCHED;
            PG8_LDA(At, 0, 1); PG8_STAGE(PG8_SB(0, 0), b2, voffB); PG8_STAGE(PG8_SB(0, 1), b2 + hstep, voffB); PG8_STAGE(PG8_SA(0, 0), a2, voffA);
            PG8_WAIT_V(8); PG8_WAIT_L(0); PG8_BAR; PG8_MMA(1, 0, At, B0); PG8_MMA(1, 1, At, B1); PG8_BAR; PG8_SCHED;
            PG8_LDB(B0, 1, 0); PG8_LDB(B1, 1, 1); PG8_SCHED; PG8_LDA(At, 1, 0); PG8_STAGE(PG8_SA(0, 1), a2 + hstep, voffA);
            PG8_WAIT_V(8); PG8_WAIT_L(0); PG8_BAR; PG8_MMA(0, 0, At, B0); PG8_MMA(0, 1, At, B1); PG8_BAR; PG8_SCHED;
            PG8_LDA(At, 1, 1); PG8_STAGE(PG8_SB(1, 0), b3, voffB); PG8_STAGE(PG8_SB(1, 1), b3 + hstep, voffB); PG8_STAGE(PG8_SA(1, 0), a3, voffA);
            PG8_WAIT_V(8); PG8_WAIT_L(0); PG8_BAR; PG8_MMA(1, 0, At, B0); PG8_MMA(1, 1, At, B1); PG8_BAR; PG8_SCHED;
            } else {
            PG8_LDB(B0, 0, 0); PG8_SCHED; PG8_LDA(At, 0, 0); PG8_STAGE(PG8_SA(1, 1), a1 + hstep, voffA);
            PG8_WAIT_L(8); PG8_BAR; PG8_WAIT_L(0); PG8_MMA(0, 0, At, B0); PG8_BAR; PG8_SCHED;
            PG8_LDB(B1, 0, 1); PG8_STAGE(PG8_SB(0, 0), b2, voffB);
            PG8_BAR; PG8_WAIT_L(0); PG8_MMA(0, 1, At, B1); PG8_BAR;
            PG8_LDA(At, 0, 1); PG8_STAGE(PG8_SA(0, 0), a2, voffA);
            PG8_BAR; PG8_WAIT_L(0); PG8_MMA(1, 0, At, B0); PG8_BAR; PG8_SCHED;
            PG8_STAGE(PG8_SB(0, 1), b2 + hstep, voffB);
            PG8_WAIT_V(6); PG8_BAR; PG8_MMA(1, 1, At, B1); PG8_BAR;
            PG8_LDB(B0, 1, 0); PG8_SCHED; PG8_LDA(At, 1, 0); PG8_STAGE(PG8_SA(0, 1), a2 + hstep, voffA);
            PG8_WAIT_L(8); PG8_BAR; PG8_WAIT_L(0); PG8_MMA(0, 0, At, B0); PG8_BAR; PG8_SCHED;
            PG8_LDB(B1, 1, 1); PG8_STAGE(PG8_SB(1, 0), b3, voffB);
            PG8_BAR; PG8_WAIT_L(0); PG8_MMA(0, 1, At, B1); PG8_BAR;
            PG8_LDA(At, 1, 1); PG8_STAGE(PG8_SA(1, 0), a3, voffA);
            PG8_BAR; PG8_WAIT_L(0); PG8_MMA(1, 0, At, B0); PG8_BAR; PG8_SCHED;
            PG8_STAGE(PG8_SB(1, 1), b3 + hstep, voffB);
            PG8_WAIT_V(6); PG8_BAR; PG8_MMA(1, 1, At, B1); PG8_BAR;
            }
        }
        if constexpr (ALIGN_EPI) { if (wr == 0) PG8_BAR; }
        if constexpr (!Epi::AFTER_DRAIN) { E(acc, cur, wr, wc, fr, fq); S.done(cur); }
        if (!has_next) break;
#pragma unroll
        for (int a = 0; a < 2; ++a)
#pragma unroll
            for (int b = 0; b < 2; ++b)
#pragma unroll
                for (int m = 0; m < 4; ++m)
#pragma unroll
                    for (int n = 0; n < 2; ++n) acc[a][b][m][n] = (f32x4){0.f, 0.f, 0.f, 0.f};
        cur = nxt; cA = nA; cB = nB; ++ui;
        if constexpr (ALIGN_EPI) { if (wr == 1) PG8_BAR; }
    }
    PG8_WAIT_V(0);
    if constexpr (!ALIGN_EPI) { if (wr == 0) PG8_BAR; }
    PG8_BAR;
#undef PG8_SA
#undef PG8_SB
#undef PG8_STAGE
#undef PG8_LDA
#undef PG8_LDB
#undef PG8_MMA
#undef PG8_WAIT_V
#undef PG8_WAIT_L
#undef PG8_BAR
#undef PG8_SCHED
}
}

constexpr int NWAVES = 8, NTHR = NWAVES * 64;
constexpr int N_LAUNCHES = MK_N_LAUNCHES, N_PHASES = 8;
constexpr int BATCH = 4, SEQ = 8192, DM = 1024, M = BATCH * SEQ;
constexpr int NPROJ = 1536, NQK = 2048, NEXP = 16384, NMOD = 6 * DM;
constexpr float EPS = 1e-6f;

constexpr size_t MiB = 1u << 20;
constexpr size_t WS_CTL = 0, CTL_ZERO_BYTES = 128 * 1024;
constexpr size_t WS_XSYNC = 64 * 1024;
constexpr size_t WS_MOD = 256 * 1024;
constexpr size_t WS_MODP = 1 * MiB;
constexpr size_t WS_WIN = 2 * MiB;
constexpr size_t WS_WOUT = 5 * MiB;
constexpr size_t WS_WQK = 7 * MiB;
constexpr size_t WS_WPOOL = 11 * MiB;
constexpr size_t WS_WSP = 11 * MiB + 256 * 1024;
constexpr size_t WS_ED = 16 * MiB, WS_EU = 32 * MiB;
constexpr size_t WS_EDS = 13 * MiB, WS_EUS = 13 * MiB + 65536;
constexpr size_t WS_H2 = 80 * MiB;
constexpr size_t WS_SC = 144 * MiB;
constexpr size_t WS_H1 = 144 * MiB, WS_PROJ = 208 * MiB, WS_MIX = 304 * MiB;
constexpr size_t WS_H2Q = 400 * MiB;
constexpr size_t WS_HSC = 13 * MiB + 262144;
constexpr size_t WS_END = 432 * MiB;
constexpr int CW_BAR = 1024;

constexpr int RING_BYTES = 131072;
constexpr int MISC_OFF = 160 * 1024 - 256;
constexpr int LDS_BYTES = 160 * 1024;

#define RLX_AGENT __ATOMIC_RELAXED, __HIP_MEMORY_SCOPE_AGENT
#define LDS_WAIT() asm volatile("s_waitcnt lgkmcnt(0)" ::: "memory")
#define VM_WAIT() asm volatile("s_waitcnt vmcnt(0)" ::: "memory")

#define XB_TMO      128
#define XB_XCNT(j)  (256  + 64 * (j))
#define XB_XSUB(j)  (1280 + 64 * (j))
#define XB_XGEN(j)  (2304 + 64 * (j))
#define XB_TOP      3328
#define XB_TOPGEN   3392
#define XCD_BAR_WORDS 3456
#define XB_SPIN_CAP (1u << 22)
__device__ __forceinline__ unsigned xb_ld(unsigned* p)              { return __hip_atomic_load(p, __ATOMIC_RELAXED, __HIP_MEMORY_SCOPE_AGENT); }
__device__ __forceinline__ unsigned xb_add(unsigned* p, unsigned v) { return __hip_atomic_fetch_add(p, v, __ATOMIC_RELAXED, __HIP_MEMORY_SCOPE_AGENT); }
__device__ __forceinline__ unsigned xb_xcc_id() { return (unsigned)__builtin_amdgcn_s_getreg((3 << 11) | 20) & 0xFu; }
#define XB_SPIN(cond, bar) do { unsigned _sp = 0; while (cond) { __builtin_amdgcn_s_sleep(1); \
    if ((++_sp & 255u) == 0u) { if (xb_ld(&(bar)[XB_TMO])) break; if (_sp > XB_SPIN_CAP) { atomicAdd(&(bar)[XB_TMO], 1u); break; } } } } while (0)
struct XcdBarrier { unsigned* bar; unsigned x; volatile LAS unsigned* st; };
__device__ __forceinline__ XcdBarrier xcd_barrier_post(unsigned* bar, volatile LAS unsigned* st) {
    XcdBarrier b; b.bar = bar; b.x = xb_xcc_id(); b.st = st;
    if (threadIdx.x == 0) (void)xb_add(&bar[XB_XCNT(b.x)], 1u);
    return b;
}
__device__ __forceinline__ void xcd_barrier_complete(unsigned* bar, unsigned x, unsigned& nloc, unsigned& nx) {
    const unsigned G = gridDim.x * gridDim.y * gridDim.z;
    unsigned sum, cnt, mine, sp = 0u;
    for (;;) {
        sum = 0u; cnt = 0u; mine = 0u;
#pragma unroll
        for (unsigned j = 0; j < 16; ++j) { const unsigned c = xb_ld(&bar[XB_XCNT(j)]); sum += c; cnt += (c > 0u) ? 1u : 0u; mine = (j == x) ? c : mine; }
        if (sum == G) break;
        __builtin_amdgcn_s_sleep(1);
        if ((++sp & 255u) == 0u) { if (xb_ld(&bar[XB_TMO])) break; if (sp > XB_SPIN_CAP) { atomicAdd(&bar[XB_TMO], 1u); break; } }
    }
    nloc = mine > 0u ? mine : 1u; nx = cnt > 0u ? cnt : 1u;
}
__device__ __forceinline__ void xcd_barrier(const XcdBarrier& b) {
    asm volatile("s_waitcnt vmcnt(0)" ::: "memory");
    __syncthreads();
    if (threadIdx.x == 0) {
        unsigned* bar = b.bar;
        __builtin_amdgcn_s_waitcnt(0);
        unsigned nloc = b.st[0], nx = b.st[1];
        if (nloc == 0u) { xcd_barrier_complete(bar, b.x, nloc, nx); b.st[0] = nloc; b.st[1] = nx; }
        const unsigned old = xb_add(&bar[XB_XSUB(b.x)], 1u);
        const unsigned gen = old / nloc;
        if (old + 1u == (gen + 1u) * nloc) {
            __builtin_amdgcn_fence(__ATOMIC_RELEASE, "agent");
            asm volatile("s_waitcnt vmcnt(0)" ::: "memory");
            const unsigned og = xb_add(&bar[XB_TOP], 1u);
            const unsigned tg = og / nx;
            if (og + 1u == (tg + 1u) * nx) xb_add(&bar[XB_TOPGEN], 1u);
            else XB_SPIN(xb_ld(&bar[XB_TOPGEN]) == tg, bar);
            __builtin_amdgcn_fence(__ATOMIC_ACQUIRE, "agent");
            xb_add(&bar[XB_XGEN(b.x)], 1u);
            asm volatile("s_waitcnt vmcnt(0)" ::: "memory");
        } else {
            XB_SPIN(xb_ld(&bar[XB_XGEN(b.x)]) == gen, bar);
            __builtin_amdgcn_fence(__ATOMIC_ACQUIRE, "agent");
            asm volatile("s_waitcnt vmcnt(0)" ::: "memory");
        }
    }
    __syncthreads();
}

__device__ __forceinline__ float wave_sum(float v) {
#pragma unroll
    for (int o = 1; o < 64; o <<= 1) v += __shfl_xor(v, o);
    return v;
}
template <int CTRL> __device__ __forceinline__ unsigned dppu(unsigned x) { return (unsigned)__builtin_amdgcn_update_dpp((int)x, (int)x, CTRL, 0xF, 0xF, false); }
template <int CTRL> __device__ __forceinline__ float dppf(float x) { return __builtin_bit_cast(float, __builtin_amdgcn_update_dpp(__builtin_bit_cast(int, x), __builtin_bit_cast(int, x), CTRL, 0xF, 0xF, false)); }
__device__ __forceinline__ unsigned umax_(unsigned a, unsigned b) { return a > b ? a : b; }
__device__ __forceinline__ unsigned umin_(unsigned a, unsigned b) { return a < b ? a : b; }
__device__ __forceinline__ unsigned rowmax16u(unsigned x) {
    x = umax_(x, dppu<0xB1>(x)); x = umax_(x, dppu<0x4E>(x)); x = umax_(x, dppu<0x141>(x)); x = umax_(x, dppu<0x140>(x)); return x; }
__device__ __forceinline__ float rowmax16f(float x) {
    x = fmaxf(x, dppf<0xB1>(x)); x = fmaxf(x, dppf<0x4E>(x)); x = fmaxf(x, dppf<0x141>(x)); x = fmaxf(x, dppf<0x140>(x)); return x; }
__device__ __forceinline__ float rowsum16f(float x) {
    x += dppf<0xB1>(x); x += dppf<0x4E>(x); x += dppf<0x141>(x); x += dppf<0x140>(x); return x; }
__device__ __forceinline__ unsigned fkey(float f) { const unsigned u = __builtin_bit_cast(unsigned, f); return (u & 0x80000000u) ? ~u : (u | 0x80000000u); }
__device__ __forceinline__ float fval(unsigned k, unsigned lowmask) {
    unsigned u = (k & 0x80000000u) ? (k & 0x7fffffffu) : ~k; u &= ~lowmask; return __builtin_bit_cast(float, u); }
#define CE_DESC(a, b) do { const unsigned _hi = umax_(a, b), _lo = umin_(a, b); a = _hi; b = _lo; } while (0)

__device__ __forceinline__ float gelu_as(float v) {
    const float av = fabsf(v), t = __builtin_amdgcn_rcpf(av * 0.2316418882f + 1.0f);
    float q = t * 0.5307027145f + (-0.7265760135f); q = q * t + 0.7107068705f; q = q * t + (-0.142248368f); q = q * t + 0.127414796f; q = q * t;
    const float e = __builtin_amdgcn_exp2f(v * v * (-0.72134752044f)), m = v * (q * e);
    return v < 0.f ? m : v - m;
}
__device__ __forceinline__ int rowsel_(int ia, int ib, int src, int lane) { const int a = __shfl(ia, src), b = __shfl(ib, src); return (lane & 8) ? b : a; }
__device__ __forceinline__ float wave_max(float v) {
    v = fmaxf(v, dppf<0xB1>(v)); v = fmaxf(v, dppf<0x4E>(v)); v = fmaxf(v, dppf<0x141>(v)); v = fmaxf(v, dppf<0x140>(v));
    { const auto a = __builtin_amdgcn_permlane16_swap(as_u(v), as_u(v), false, false); v = fmaxf(as_f(a[0]), as_f(a[1])); }
    { const auto a = __builtin_amdgcn_permlane32_swap(as_u(v), as_u(v), false, false); v = fmaxf(as_f(a[0]), as_f(a[1])); }
    return v;
}
__device__ __forceinline__ float wave_total(float v) {
    v += dppf<0xB1>(v); v += dppf<0x4E>(v); v += dppf<0x141>(v); v += dppf<0x140>(v);
    { const auto a = __builtin_amdgcn_permlane16_swap(as_u(v), as_u(v), false, false); v = as_f(a[0]) + as_f(a[1]); }
    { const auto a = __builtin_amdgcn_permlane32_swap(as_u(v), as_u(v), false, false); v = as_f(a[0]) + as_f(a[1]); }
    return v;
}

__device__ __forceinline__ void topk_token(const float* sc, LAS unsigned* tk, LAS unsigned* pe_idx, LAS float* pe_gate, int lane) {
    const int l16 = lane & 15, row = lane >> 4;
    f32x4 sv[8];
#pragma unroll
    for (int ps = 0; ps < 4; ++ps) { sv[2 * ps] = *(const f32x4*)(sc + ps * 512 + lane * 8); sv[2 * ps + 1] = *(const f32x4*)(sc + ps * 512 + lane * 8 + 4); }
#pragma unroll
    for (int ps = 0; ps < 4; ++ps) {
        const f32x4 sa = sv[2 * ps], sb = sv[2 * ps + 1];
        unsigned k0 = fkey(sa.x), k1 = fkey(sa.y), k2 = fkey(sa.z), k3 = fkey(sa.w), k4 = fkey(sb.x), k5 = fkey(sb.y), k6 = fkey(sb.z), k7 = fkey(sb.w);
        const unsigned ib = 127u - (unsigned)(l16 * 8);
        k0 = (k0 & ~127u) | (ib - 0u); k1 = (k1 & ~127u) | (ib - 1u); k2 = (k2 & ~127u) | (ib - 2u); k3 = (k3 & ~127u) | (ib - 3u);
        k4 = (k4 & ~127u) | (ib - 4u); k5 = (k5 & ~127u) | (ib - 5u); k6 = (k6 & ~127u) | (ib - 6u); k7 = (k7 & ~127u) | (ib - 7u);
        CE_DESC(k0, k1); CE_DESC(k2, k3); CE_DESC(k4, k5); CE_DESC(k6, k7);
        CE_DESC(k0, k2); CE_DESC(k1, k3); CE_DESC(k4, k6); CE_DESC(k5, k7);
        CE_DESC(k1, k2); CE_DESC(k5, k6);
        CE_DESC(k0, k4); CE_DESC(k1, k5); CE_DESC(k2, k6); CE_DESC(k3, k7);
        CE_DESC(k2, k4); CE_DESC(k3, k5);
        CE_DESC(k1, k2); CE_DESC(k3, k4); CE_DESC(k5, k6);
        unsigned top = 0u;
#pragma unroll
        for (int rr = 0; rr < 16; ++rr) {
            const unsigned m = rowmax16u(k0);
            top = (l16 == rr) ? m : top;
            const bool pop = (k0 == m);
            k0 = pop ? k1 : k0; k1 = pop ? k2 : k1; k2 = pop ? k3 : k2; k3 = pop ? k4 : k3; k4 = pop ? k5 : k4; k5 = pop ? k6 : k5; k6 = pop ? k7 : k6; k7 = pop ? 0u : k7;
        }
        tk[ps * 64 + lane] = top;
    }
    __builtin_amdgcn_wave_barrier(); LDS_WAIT();
#pragma unroll 1
    for (int s2 = 0; s2 < 2; ++s2) {
        const int hd = 4 * s2 + row;
        const LAS unsigned* ab = tk + ((hd >> 1) * 4 + 2 * (hd & 1)) * 16; const LAS unsigned* bb = ab + 16;
        const unsigned aik = ab[l16], a0k = ab[0], bik = bb[l16];
        const u32x4 bq0 = *(const LAS u32x4*)bb, bq1 = *(const LAS u32x4*)(bb + 4);
        const float vai = fval(aik, 127u), va0 = fval(a0k, 127u), vbi = fval(bik, 127u);
        const unsigned bk[8] = {bq0.x, bq0.y, bq0.z, bq0.w, bq1.x, bq1.y, bq1.z, bq1.w};
        unsigned L[8];
#pragma unroll
        for (int e = 0; e < 8; ++e) { const float sv = vai + fval(bk[e], 127u); const unsigned kk = (fkey(sv) & ~255u) | (255u - (unsigned)(l16 * 16 + e));
            L[e] = ((l16 + 1) * (e + 1) <= 16) ? kk : 0u; }
        { const float sv = va0 + vbi; const unsigned kk = (fkey(sv) & ~255u) | (255u - (unsigned)l16); L[1] = (l16 >= 8) ? kk : L[1]; }
        CE_DESC(L[0], L[1]);
        unsigned best = 0u;
#pragma unroll
        for (int rr = 0; rr < 16; ++rr) {
            const unsigned m = rowmax16u(L[0]);
            best = (l16 == rr) ? m : best;
            const bool pop = (L[0] == m);
            L[0] = pop ? L[1] : L[0]; L[1] = pop ? L[2] : L[1]; L[2] = pop ? L[3] : L[2]; L[3] = pop ? L[4] : L[3]; L[4] = pop ? L[5] : L[4]; L[5] = pop ? L[6] : L[5]; L[6] = pop ? L[7] : L[6]; L[7] = pop ? 0u : L[7];
        }
        const unsigned flat = 255u - (best & 255u), ci = flat >> 4, cj = flat & 15u;
        const unsigned ak = ab[ci], bk2 = bb[cj];
        const float sval = fval(ak, 127u) + fval(bk2, 127u);
        const unsigned eidx = (127u - (ak & 127u)) * 128u + (127u - (bk2 & 127u));
        const float mx = rowmax16f(sval), ex = __expf(sval - mx), sm = rowsum16f(ex), gt = ex / sm;
        pe_idx[hd * 16 + l16] = eidx; pe_gate[hd * 16 + l16] = gt;
    }
    __builtin_amdgcn_wave_barrier(); LDS_WAIT();
}

struct Args { const float* in[19]; float* out; unsigned char* ws; int ph_lo, ph_hi; };

__device__ __forceinline__ void p0_transpose_item(const float* W, int K, int N, f16_t* WT, LAS float* scr, int item, int lane) {
    const int nblk = N / 32, kb = item / nblk, nb = item % nblk, k0 = 64 * kb, n0 = 32 * nb;
#pragma unroll 8
    for (int i = 0; i < 32; ++i) { const int kk = 2 * i + (lane >> 5); scr[kk * 33 + (lane & 31)] = W[(size_t)(k0 + kk) * N + n0 + (lane & 31)]; }
    LDS_WAIT(); asm volatile("" ::: "memory");
    const int c = lane & 7;
#pragma unroll
    for (int j = 0; j < 4; ++j) { const int n = (lane >> 3) + 8 * j; const LAS float* s = scr + (8 * c) * 33 + n;
        u32x4 o; o.x = pk_f16(s[0 * 33], s[1 * 33]); o.y = pk_f16(s[2 * 33], s[3 * 33]); o.z = pk_f16(s[4 * 33], s[5 * 33]); o.w = pk_f16(s[6 * 33], s[7 * 33]);
        *(u32x4*)(WT + (size_t)(n0 + n) * K + k0 + 8 * c) = o; }
    LDS_WAIT(); asm volatile("" ::: "memory");
}

__device__ __forceinline__ void norm_rows(const float* src, f16_t* dst, const LAS float* A, const LAS float* S, int row0, int nrows, int wave, int lane) {
    for (int r = wave; r < nrows; r += NWAVES) {
        const f32x4* xr = (const f32x4*)(src + (size_t)(row0 + r) * DM) + lane;
        f32x4 v[4]; float s = 0.f;
#pragma unroll
        for (int j = 0; j < 4; ++j) { v[j] = xr[64 * j]; s += (v[j].x * v[j].x + v[j].y * v[j].y) + (v[j].z * v[j].z + v[j].w * v[j].w); }
        const float rstd = rsqrtf(wave_sum(s) * (1.f / DM) + EPS);
        unsigned long long* o8 = (unsigned long long*)(dst + (size_t)(row0 + r) * DM) + lane;
#pragma unroll
        for (int j = 0; j < 4; ++j) { const f32x4 a = *(const LAS f32x4*)(A + 4 * (64 * j + lane)), sh = *(const LAS f32x4*)(S + 4 * (64 * j + lane));
            const f32x4 h = v[j] * rstd * a + sh;
            o8[64 * j] = (unsigned long long)pk_f16(h.x, h.y) | ((unsigned long long)pk_f16(h.z, h.w) << 32); }
    }
}

__device__ __forceinline__ void pace_arrive(unsigned* cnt, unsigned target, int lane) { if (lane == 0 && target) (void)__hip_atomic_fetch_add(cnt, 1u, __ATOMIC_RELAXED, __HIP_MEMORY_SCOPE_AGENT); }
__device__ __forceinline__ void pace_wait(unsigned* cnt, unsigned target, volatile LAS unsigned* gen, unsigned seq, bool leader) {
    if (!target) return;
    if (leader) {
        const unsigned need = target - (target >> 2);
        for (int sp = 0; sp < 2048; ++sp) { const unsigned v = (unsigned)__builtin_amdgcn_readfirstlane((int)__hip_atomic_load(cnt, __ATOMIC_RELAXED, __HIP_MEMORY_SCOPE_AGENT)); if (v >= need) break; __builtin_amdgcn_s_sleep(16); }
        *gen = seq;
    } else {
        for (int sp = 0; sp < 200000; ++sp) { if (*gen >= seq) break; __builtin_amdgcn_s_sleep(4); }
    }
}
__device__ __forceinline__ void xcd_pace(unsigned* cnt, unsigned target) {
    __syncthreads();
    if (threadIdx.x == 0 && target) {
        (void)__hip_atomic_fetch_add(cnt, 1u, __ATOMIC_RELAXED, __HIP_MEMORY_SCOPE_AGENT);
        const unsigned need = target - (target >> 2);
        for (int sp = 0; sp < 4096; ++sp) { if (__hip_atomic_load(cnt, __ATOMIC_RELAXED, __HIP_MEMORY_SCOPE_AGENT) >= need) break; __builtin_amdgcn_s_sleep(8); }
    }
    __syncthreads();
}

__device__ __forceinline__ void norm_rows_q(const float* src, f16_t* dst, unsigned char* dq, float* dsc, const LAS float* A, const LAS float* S, int row0, int nrows, int wave, int lane) {
    for (int r = wave; r < nrows; r += NWAVES) {
        const f32x4* xr = (const f32x4*)(src + (size_t)(row0 + r) * DM) + lane;
        f32x4 v[4]; float s = 0.f;
#pragma unroll
        for (int j = 0; j < 4; ++j) { v[j] = xr[64 * j]; s += (v[j].x * v[j].x + v[j].y * v[j].y) + (v[j].z * v[j].z + v[j].w * v[j].w); }
        const float rstd = rsqrtf(wave_total(s) * (1.f / DM) + EPS);
        unsigned long long* o8 = (unsigned long long*)(dst + (size_t)(row0 + r) * DM) + lane;
        float m = 0.f;
#pragma unroll
        for (int j = 0; j < 4; ++j) { const f32x4 a = *(const LAS f32x4*)(A + 4 * (64 * j + lane)), sh = *(const LAS f32x4*)(S + 4 * (64 * j + lane));
            v[j] = v[j] * rstd * a + sh;
            o8[64 * j] = (unsigned long long)pk_f16(v[j].x, v[j].y) | ((unsigned long long)pk_f16(v[j].z, v[j].w) << 32);
            m = fmaxf(m, fmaxf(fmaxf(fabsf(v[j].x), fabsf(v[j].y)), fmaxf(fabsf(v[j].z), fabsf(v[j].w)))); }
        m = wave_max(m);
        const float sc = m > 0.f ? m * (1.f / 127.f) : 1.f, inv = 1.f / sc;
        unsigned* q4 = (unsigned*)(dq + (size_t)(row0 + r) * DM) + lane;
#pragma unroll
        for (int j = 0; j < 4; ++j) q4[64 * j] = pk_i8(v[j] * inv);
        if (lane == 0) dsc[row0 + r] = sc;
    }
}

__global__ void __launch_bounds__(NTHR, 2) fwd_kernel(Args args) {
    extern __shared__ __attribute__((aligned(16))) unsigned char lds_raw[];
    LAS unsigned char* lds = (LAS unsigned char*)lds_raw;
    volatile LAS unsigned* MISC = (volatile LAS unsigned*)(lds + MISC_OFF);
    const int tid = threadIdx.x, lane = tid & 63, wave = __builtin_amdgcn_readfirstlane(tid >> 6);
    const int G = gridDim.x, wg = blockIdx.x;
    unsigned char* ws = args.ws;
    unsigned* ctl = (unsigned*)(ws + WS_CTL);

    const float* x = args.in[0]; const float* cvec = args.in[1]; const float* w_ada = args.in[2]; const float* b_ada = args.in[3];
    const float* g_norm1 = args.in[4]; const float* w_in = args.in[5]; const float* w_pool = args.in[6]; const float* pool_scale = args.in[7];
    const float* sgu_ln_g = args.in[8]; const float* sgu_ln_b = args.in[9]; const float* w_spatial = args.in[10]; const float* b_spatial = args.in[11];
    const float* w_out = args.in[12]; const float* g_norm2 = args.in[13]; const float* w_query = args.in[14]; const float* sub_keys = args.in[15];
    const float* expert_down = args.in[16]; const float* expert_up = args.in[17]; const float* g_final = args.in[18];
    float* out = args.out;
    float* mod = (float*)(ws + WS_MOD); float* modp = (float*)(ws + WS_MODP);
    f16_t* WinT = (f16_t*)(ws + WS_WIN); f16_t* WoutT = (f16_t*)(ws + WS_WOUT); f16_t* WqkT = (f16_t*)(ws + WS_WQK);
    f16_t* WpoolT = (f16_t*)(ws + WS_WPOOL); f16_t* Wsp = (f16_t*)(ws + WS_WSP);
    unsigned char* Ed8 = ws + WS_ED; unsigned char* Eu8 = ws + WS_EU; float* EdS = (float*)(ws + WS_EDS); float* EuS = (float*)(ws + WS_EUS);
    unsigned char* H2Q = ws + WS_H2Q; float* HSC = (float*)(ws + WS_HSC);
    f16_t* H1 = (f16_t*)(ws + WS_H1); f16_t* PROJ = (f16_t*)(ws + WS_PROJ); f16_t* MIX = (f16_t*)(ws + WS_MIX); f16_t* H2 = (f16_t*)(ws + WS_H2);
    float* SC = (float*)(ws + WS_SC);

    if (tid < 64) MISC[tid] = 0u;
    __syncthreads();
    XcdBarrier bar; bar.bar = ctl + CW_BAR; bar.x = 0; bar.st = MISC + 8;
    if (N_LAUNCHES == 1) bar = xcd_barrier_post(ctl + CW_BAR, MISC + 8);
#define GRID_BAR() do { if (N_LAUNCHES == 1) xcd_barrier(bar); } while (0)
    const int lo = args.ph_lo, hi = args.ph_hi;
#define IN(k) (lo <= (k) && (k) < hi)
#define BOTH(k) (IN(k) && IN((k) + 1))

    if (IN(0)) {
        LAS float* cact = (LAS float*)lds;
        for (int i = tid; i < BATCH * DM; i += NTHR) { const float v = cvec[i]; cact[i] = v / (1.f + __expf(-v)); }
        __syncthreads();
        const int gw = wg * NWAVES + wave, NGW = G * NWAVES;
        for (int it = gw; it < 96 * 8; it += NGW) {
            const int cc = it % 96, ks = it / 96, e = cc * 64 + lane;
            const float* wp = w_ada + (size_t)(ks * 128) * NMOD + e; const LAS float* ca = cact + ks * 128;
            float a0 = 0.f, a1 = 0.f, a2 = 0.f, a3 = 0.f;
#pragma unroll 8
            for (int k = 0; k < 128; ++k) { const float w = wp[(size_t)k * NMOD]; a0 += ca[k] * w; a1 += ca[DM + k] * w; a2 += ca[2 * DM + k] * w; a3 += ca[3 * DM + k] * w; }
            float* mp = modp + (size_t)(ks * 4) * NMOD + e; mp[0] = a0; mp[NMOD] = a1; mp[2 * NMOD] = a2; mp[3 * NMOD] = a3;
        }
        { LAS float* scr = (LAS float*)(lds + 16384 + wave * 12288);
          constexpr int I_IN = (DM / 64) * (NPROJ / 32), I_OUT = (DM / 64) * (DM / 32), I_POOL = (128 / 64) * (128 / 32);
          for (int it = gw; it < I_IN + I_OUT + 4 * I_POOL; it += NGW) {
              int r = it;
              if (r < I_IN) { p0_transpose_item(w_in, DM, NPROJ, WinT, scr, r, lane); continue; } r -= I_IN;
              if (r < I_OUT) { p0_transpose_item(w_out, DM, DM, WoutT, scr, r, lane); continue; } r -= I_OUT;
              const int g = r / I_POOL; p0_transpose_item(w_pool + g * 16384, 128, 128, WpoolT + g * 16384, scr, r % I_POOL, lane);
          } }
        { const int gt = wg * NTHR + tid, NGT = G * NTHR;
          for (int i = gt; i < 8192; i += NGT) { const int base = i * 8, t = (base >> 7) & 127, s0 = base & 127;
              const f32x4 a = *(const f32x4*)(w_spatial + base), b = *(const f32x4*)(w_spatial + base + 4);
              float v[8] = {a.x, a.y, a.z, a.w, b.x, b.y, b.z, b.w};
#pragma unroll
              for (int e = 0; e < 8; ++e) v[e] = (s0 + e <= t) ? v[e] : 0.f;
              u32x4 o; o.x = pk_f16(v[0], v[1]); o.y = pk_f16(v[2], v[3]); o.z = pk_f16(v[4], v[5]); o.w = pk_f16(v[6], v[7]);
              *(u32x4*)(Wsp + base) = o; }
          }
        for (int rowi = gw; rowi < 2 * NEXP; rowi += NGW) {
            const int tb = rowi >= NEXP, er = tb ? rowi - NEXP : rowi;
            const float* src = (tb ? expert_up : expert_down) + (size_t)er * DM;
            const int o0 = tb ? lane * 8 : lane * 16, o1 = tb ? 512 + lane * 8 : lane * 16 + 8;
            const f32x4 a0 = *(const f32x4*)(src + o0), a1 = *(const f32x4*)(src + o0 + 4), b0 = *(const f32x4*)(src + o1), b1 = *(const f32x4*)(src + o1 + 4);
            float m = fmaxf(fmaxf(fmaxf(fabsf(a0.x), fabsf(a0.y)), fmaxf(fabsf(a0.z), fabsf(a0.w))), fmaxf(fmaxf(fabsf(a1.x), fabsf(a1.y)), fmaxf(fabsf(a1.z), fabsf(a1.w))));
            m = fmaxf(m, fmaxf(fmaxf(fmaxf(fabsf(b0.x), fabsf(b0.y)), fmaxf(fabsf(b0.z), fabsf(b0.w))), fmaxf(fmaxf(fabsf(b1.x), fabsf(b1.y)), fmaxf(fabsf(b1.z), fabsf(b1.w)))));
            m = wave_max(m);
            u32x4 o;
            if (tb) {
                const float sc = m > 0.f ? m * (1.f / 432.f) : 1.f, inv = 1.f / sc;
                int w0 = 0, w1 = 0, w2 = 0, w3 = 0;
                w0 = __builtin_amdgcn_cvt_pk_fp8_f32(a0.x * inv, a0.y * inv, w0, false); w0 = __builtin_amdgcn_cvt_pk_fp8_f32(a0.z * inv, a0.w * inv, w0, true);
                w1 = __builtin_amdgcn_cvt_pk_fp8_f32(a1.x * inv, a1.y * inv, w1, false); w1 = __builtin_amdgcn_cvt_pk_fp8_f32(a1.z * inv, a1.w * inv, w1, true);
                w2 = __builtin_amdgcn_cvt_pk_fp8_f32(b0.x * inv, b0.y * inv, w2, false); w2 = __builtin_amdgcn_cvt_pk_fp8_f32(b0.z * inv, b0.w * inv, w2, true);
                w3 = __builtin_amdgcn_cvt_pk_fp8_f32(b1.x * inv, b1.y * inv, w3, false); w3 = __builtin_amdgcn_cvt_pk_fp8_f32(b1.z * inv, b1.w * inv, w3, true);
                o.x = (unsigned)w0; o.y = (unsigned)w1; o.z = (unsigned)w2; o.w = (unsigned)w3;
                if (lane == 0) EuS[er] = sc;
            } else {
                const float sc = m > 0.f ? m * (1.f / 127.f) : 1.f, inv = 1.f / sc;
                o.x = pk_i8(a0 * inv); o.y = pk_i8(a1 * inv); o.z = pk_i8(b0 * inv); o.w = pk_i8(b1 * inv);
                if (lane == 0) EdS[er] = sc;
            }
            *(u32x4*)((tb ? Eu8 : Ed8) + (size_t)er * 1024 + lane * 16) = o;
        }
        __syncthreads();
        for (int item = wg; item < 256; item += G) {
            const int hp = item >> 4, D0 = (item & 15) * 64;
            LAS float* SKs = (LAS float*)lds;
            LAS float* WQs = (LAS float*)(lds + 128 * 129 * 4);
            for (int i = tid; i < 128 * 32; i += NTHR) { const int k = i >> 5, d4 = (i & 31) * 4; const f32x4 v = *(const f32x4*)(sub_keys + (size_t)(hp * 128 + k) * 128 + d4);
                LAS float* p = SKs + k * 129 + d4; p[0] = v.x; p[1] = v.y; p[2] = v.z; p[3] = v.w; }
            for (int i = tid; i < 64 * 32; i += NTHR) { const int dd = i >> 5, d4 = (i & 31) * 4; const f32x4 v = *(const f32x4*)(w_query + (size_t)(D0 + dd) * NQK + hp * 128 + d4);
                LAS float* p = WQs + dd * 129 + d4; p[0] = v.x; p[1] = v.y; p[2] = v.z; p[3] = v.w; }
            __syncthreads();
            const int tk = tid >> 4, td = tid & 15;
            float acc[4][4];
#pragma unroll
            for (int i = 0; i < 4; ++i)
#pragma unroll
                for (int j = 0; j < 4; ++j) acc[i][j] = 0.f;
            for (int d = 0; d < 128; ++d) { float a[4], b[4];
#pragma unroll
                for (int i = 0; i < 4; ++i) { a[i] = SKs[(4 * tk + i) * 129 + d]; b[i] = WQs[(4 * td + i) * 129 + d]; }
#pragma unroll
                for (int i = 0; i < 4; ++i)
#pragma unroll
                    for (int j = 0; j < 4; ++j) acc[i][j] += a[i] * b[j]; }
#pragma unroll
            for (int i = 0; i < 4; ++i) { u32x2 o; o.x = pk_f16(acc[i][0], acc[i][1]); o.y = pk_f16(acc[i][2], acc[i][3]);
                *(u32x2*)(WqkT + (size_t)(hp * 128 + 4 * tk + i) * DM + D0 + 4 * td) = o; }
            __syncthreads();
        }
        if (BOTH(0)) GRID_BAR();
    }

    if (IN(1)) {
        LAS float* A = (LAS float*)lds; LAS float* S = A + DM;
        for (int i = wg * NTHR + tid; i < BATCH * NMOD; i += G * NTHR) { const int b = i / NMOD, e = i % NMOD; float s = b_ada[e];
#pragma unroll
            for (int ks = 0; ks < 8; ++ks) s += modp[(size_t)(ks * 4 + b) * NMOD + e];
            mod[i] = s; }
        for (int tile = wg; tile < M / 128; tile += G) {
            const int b = tile >> 6;
            __syncthreads();
            for (int c = tid; c < DM; c += NTHR) { float sh = b_ada[c], sc = b_ada[DM + c];
#pragma unroll
                for (int ks = 0; ks < 8; ++ks) { sh += modp[(size_t)(ks * 4 + b) * NMOD + c]; sc += modp[(size_t)(ks * 4 + b) * NMOD + DM + c]; }
                A[c] = g_norm1[c] * (1.f + sc); S[c] = sh; }
            __syncthreads();
            norm_rows(x, H1, A, S, tile * 128, 128, wave, lane);
        }
        if (BOTH(1)) GRID_BAR();
    }

    if (IN(2)) {
        pg8::Gemm g{H1, WinT, M, NPROJ, DM}; pg8::StaticOrder S; S.init(M, NPROJ, G, wg);
        pg8::EpiF16 E{PROJ, NPROJ};
        pg8::gemm_phase<pg8::EpiF16, pg8::StaticOrder, true, true>(lds, g, S, E);
        if (BOTH(2)) GRID_BAR();
    }

#if defined(DBG_NAIVE_P3)
    if (IN(3)) {
        LAS float* stats = (LAS float*)lds;
        for (int tile = wg; tile < M / 128; tile += G) {
            const int row0 = tile * 128;
            __syncthreads();
            for (int r = wave; r < 128; r += NWAVES) {
                const f16x8 v = *(const f16x8*)(PROJ + (size_t)(row0 + r) * NPROJ + 1024 + lane * 8);
                float s = 0.f;
                for (int e = 0; e < 8; ++e) s += (float)v[e];
                const float mean = wave_sum(s) * (1.f / 512.f); float q = 0.f;
                for (int e = 0; e < 8; ++e) { const float d = (float)v[e] - mean; q += d * d; }
                const float rstd = rsqrtf(wave_sum(q) * (1.f / 512.f) + EPS);
                if (lane == 0) { stats[2 * r] = mean; stats[2 * r + 1] = rstd; }
            }
            __syncthreads();
            const _Float16* PH = (const _Float16*)PROJ;
            for (int i = tid; i < 128 * DM; i += NTHR) {
                const int t = i >> 10, col = i & 1023, row = row0 + t, pos = row & 8191;
                float outv;
                if (col < 512) { const int g = col >> 7, d = col & 127, w = 2 << g; const int cnt = (pos + 1 < w) ? pos + 1 : w; float acc = 0.f;
                    for (int c = 0; c < 128; ++c) { float sm = 0.f; for (int j = 0; j < cnt; ++j) sm += (float)PH[(size_t)(row - j) * NPROJ + g * 128 + c];
                        const float pooled = sm / (float)cnt - (float)PH[(size_t)row * NPROJ + g * 128 + c]; acc += pooled * w_pool[(g * 128 + c) * 128 + d]; }
                    outv = acc * pool_scale[col]; }
                else { const int cc = col - 512, h = cc >> 7; float acc = 0.f;
                    for (int s2 = 0; s2 <= t; ++s2) { const float vn = ((float)PH[(size_t)(row0 + s2) * NPROJ + 1024 + cc] - stats[2 * s2]) * stats[2 * s2 + 1] * sgu_ln_g[cc] + sgu_ln_b[cc];
                        acc += w_spatial[(h * 128 + t) * 128 + s2] * vn; }
                    acc += b_spatial[h * 128 + t];
                    outv = (float)PH[(size_t)row * NPROJ + 512 + cc] * acc; }
                ((_Float16*)MIX)[(size_t)row * DM + col] = (_Float16)outv;
            }
        }
        if (BOTH(3)) GRID_BAR();
    }
#else
    if (IN(3)) {
        constexpr int PITCH = 272;
        LAS unsigned char* img = lds;
        LAS float* stats = (LAS float*)(lds + 512 * PITCH);
        const int fr = lane & 15, fq = lane >> 4;
        for (int tile = wg; tile < M / 128; tile += G) {
            const int row0 = tile * 128;
            __syncthreads();
            for (int r = wave; r < 128; r += NWAVES) {
                const f16x8 v = *(const f16x8*)(PROJ + (size_t)(row0 + r) * NPROJ + 1024 + lane * 8);
                float s = 0.f;
#pragma unroll
                for (int e = 0; e < 8; ++e) s += (float)v[e];
                const float mean = wave_sum(s) * (1.f / 512.f); float q = 0.f;
#pragma unroll
                for (int e = 0; e < 8; ++e) { const float d = (float)v[e] - mean; q += d * d; }
                const float rstd = rsqrtf(wave_sum(q) * (1.f / 512.f) + EPS);
                if (lane == 0) { stats[2 * r] = mean; stats[2 * r + 1] = rstd; }
            }
            __syncthreads();
            { const int cp = tid & 255; const float g0 = sgu_ln_g[2 * cp], g1 = sgu_ln_g[2 * cp + 1], b0 = sgu_ln_b[2 * cp], b1 = sgu_ln_b[2 * cp + 1];
              for (int sb = tid >> 8; sb < 16; sb += 2) {
                  float v0[8], v1[8];
#pragma unroll
                  for (int e = 0; e < 8; ++e) { const int s = sb * 8 + e; const f16x2 hv = *(const f16x2*)(PROJ + (size_t)(row0 + s) * NPROJ + 1024 + 2 * cp);
                      const float mean = stats[2 * s], rstd = stats[2 * s + 1];
                      v0[e] = ((float)hv.x - mean) * rstd * g0 + b0; v1[e] = ((float)hv.y - mean) * rstd * g1 + b1; }
                  u32x4 o0, o1; o0.x = pk_f16(v0[0], v0[1]); o0.y = pk_f16(v0[2], v0[3]); o0.z = pk_f16(v0[4], v0[5]); o0.w = pk_f16(v0[6], v0[7]);
                  o1.x = pk_f16(v1[0], v1[1]); o1.y = pk_f16(v1[2], v1[3]); o1.z = pk_f16(v1[4], v1[5]); o1.w = pk_f16(v1[6], v1[7]);
                  *(LAS u32x4*)(img + (2 * cp) * PITCH + sb * 16) = o0; *(LAS u32x4*)(img + (2 * cp + 1) * PITCH + sb * 16) = o1; } }
            __syncthreads();
            { const int h = wave >> 1, th = wave & 1, t0 = 64 * th;
              const int nks = th ? 4 : 2;
#pragma unroll 1
              for (int ch = 0; ch < 2; ++ch) {
                  f32x4 acc[4][4];
#pragma unroll
                  for (int m = 0; m < 4; ++m)
#pragma unroll
                      for (int n = 0; n < 4; ++n) acc[m][n] = (f32x4){0.f, 0.f, 0.f, 0.f};
                  const f16_t* wbase = Wsp + (size_t)(h * 128 + t0 + fr) * 128 + 8 * fq;
                  const LAS unsigned char* vbase = img + (h * 128 + 64 * ch + fr) * PITCH + 16 * fq;
#pragma unroll 1
                  for (int ks = 0; ks < nks; ++ks) {
                      f16x8 wf[4], vf[4];
#pragma unroll
                      for (int m = 0; m < 4; ++m) wf[m] = *(const f16x8*)(wbase + (16 * m) * 128 + 32 * ks);
#pragma unroll
                      for (int n = 0; n < 4; ++n) vf[n] = *(const LAS f16x8*)(vbase + (16 * n) * PITCH + 64 * ks);
#pragma unroll
                      for (int m = 0; m < 4; ++m)
#pragma unroll
                          for (int n = 0; n < 4; ++n) acc[m][n] = __builtin_amdgcn_mfma_f32_16x16x32_f16(vf[n], wf[m], acc[m][n], 0, 0, 0);
                  }
#pragma unroll
                  for (int m = 0; m < 4; ++m) { const int t = t0 + 16 * m + fr; const float bs = b_spatial[h * 128 + t];
                      const int cb0 = h * 128 + 64 * ch + 4 * fq;
                      const f16_t* up = PROJ + (size_t)(row0 + t) * NPROJ + 512 + cb0; f16_t* op = MIX + (size_t)(row0 + t) * DM + 512 + cb0;
#pragma unroll
                      for (int n = 0; n < 4; ++n) {
                          const f16x4 u = *(const f16x4*)(up + 16 * n);
                          u32x2 o; o.x = pk_f16((float)u[0] * (acc[m][n][0] + bs), (float)u[1] * (acc[m][n][1] + bs)); o.y = pk_f16((float)u[2] * (acc[m][n][2] + bs), (float)u[3] * (acc[m][n][3] + bs));
                          *(u32x2*)(op + 16 * n) = o; } }
              } }
            __syncthreads();
            { const int cp = tid & 255, thh = tid >> 8, g = cp >> 6, w = 2 << g, cl = (2 * cp) & 127;
              const int p0 = (tile & 63) * 128;
              const f16_t* ap = PROJ + (size_t)row0 * NPROJ + 2 * cp;
              float s0 = 0.f, s1 = 0.f;
              const int tt0 = 64 * thh;
              for (int j = 1; j <= w; ++j) { if (p0 + tt0 - j >= 0) { const f16x2 hv = *(const f16x2*)(ap + (ptrdiff_t)(tt0 - j) * NPROJ); s0 += (float)hv.x; s1 += (float)hv.y; } }
              for (int tb = 0; tb < 64; tb += 8) {
                  f16x2 cur[8], old[8];
#pragma unroll
                  for (int e = 0; e < 8; ++e) { const int tt = tt0 + tb + e; cur[e] = *(const f16x2*)(ap + (ptrdiff_t)tt * NPROJ);
                      const bool ok = (p0 + tt - w >= 0); old[e] = ok ? *(const f16x2*)(ap + (ptrdiff_t)(tt - w) * NPROJ) : (f16x2){(_Float16)0.f, (_Float16)0.f}; }
#pragma unroll
                  for (int e = 0; e < 8; ++e) { const int tt = tt0 + tb + e; const int pos = p0 + tt + 1;
                      s0 += (float)cur[e].x; s1 += (float)cur[e].y; s0 -= (float)old[e].x; s1 -= (float)old[e].y;
                      const float inv = 1.f / (float)(pos < w ? pos : w);
                      *(LAS unsigned*)(img + (g * 128 + tt) * PITCH + cl * 2) = pk_f16(s0 * inv - (float)cur[e].x, s1 * inv - (float)cur[e].y); }
              } }
            __syncthreads();
            { const int g = wave >> 1, th = wave & 1, t0 = 64 * th;
#pragma unroll 1
              for (int ch = 0; ch < 2; ++ch) {
                  f32x4 acc[4][4];
#pragma unroll
                  for (int m = 0; m < 4; ++m)
#pragma unroll
                      for (int n = 0; n < 4; ++n) acc[m][n] = (f32x4){0.f, 0.f, 0.f, 0.f};
                  const LAS unsigned char* pbase = img + (g * 128 + t0 + fr) * PITCH + 16 * fq;
                  const f16_t* wbase = WpoolT + (size_t)(g * 128 + 64 * ch + fr) * 128 + 8 * fq;
#pragma unroll 1
                  for (int ks = 0; ks < 4; ++ks) {
                      f16x8 pf[4], wf[4];
#pragma unroll
                      for (int m = 0; m < 4; ++m) pf[m] = *(const LAS f16x8*)(pbase + (16 * m) * PITCH + 64 * ks);
#pragma unroll
                      for (int n = 0; n < 4; ++n) wf[n] = *(const f16x8*)(wbase + (16 * n) * 128 + 32 * ks);
#pragma unroll
                      for (int m = 0; m < 4; ++m)
#pragma unroll
                          for (int n = 0; n < 4; ++n) acc[m][n] = __builtin_amdgcn_mfma_f32_16x16x32_f16(wf[n], pf[m], acc[m][n], 0, 0, 0);
                  }
                  const int cb0 = g * 128 + 64 * ch + 4 * fq;
#pragma unroll
                  for (int m = 0; m < 4; ++m) { const int t = t0 + 16 * m + fr; f16_t* op = MIX + (size_t)(row0 + t) * DM + cb0;
#pragma unroll
                      for (int n = 0; n < 4; ++n) { const f32x4 ps = *(const f32x4*)(pool_scale + cb0 + 16 * n);
                          u32x2 o; o.x = pk_f16(acc[m][n][0] * ps.x, acc[m][n][1] * ps.y); o.y = pk_f16(acc[m][n][2] * ps.z, acc[m][n][3] * ps.w);
                          *(u32x2*)(op + 16 * n) = o; } }
              } }
        }
        if (BOTH(3)) GRID_BAR();
    }
#endif

    if (IN(4)) {
        pg8::Gemm g{MIX, WoutT, M, DM, DM}; pg8::StaticOrder S; S.init(M, DM, G, wg);
        pg8::EpiRes E{x, out, mod + 2 * DM, DM};
        pg8::gemm_phase<pg8::EpiRes, pg8::StaticOrder, true, true>(lds, g, S, E);
        if (BOTH(4)) GRID_BAR();
    }

    if (IN(5)) {
        LAS float* A = (LAS float*)lds; LAS float* S = A + DM;
        for (int tile = wg; tile < M / 128; tile += G) {
            const int b = tile >> 6;
            __syncthreads();
            for (int c = tid; c < DM; c += NTHR) { A[c] = g_norm2[c] * (1.f + mod[b * NMOD + 4 * DM + c]); S[c] = mod[b * NMOD + 3 * DM + c]; }
            __syncthreads();
            norm_rows_q(out, H2, H2Q, HSC, A, S, tile * 128, 128, wave, lane);
        }
        if (BOTH(5)) GRID_BAR();
    }

    if (IN(6)) {
        pg8::Gemm g{H2, WqkT, M, NQK, DM}; pg8::StaticOrder S; S.init(M, NQK, G, wg);
        pg8::EpiF32 E{SC, NQK};
        pg8::gemm_phase<pg8::EpiF32, pg8::StaticOrder, true, true>(lds, g, S, E);
        if (BOTH(6)) GRID_BAR();
    }

    if (IN(7)) {
        constexpr int TT = 4; static_assert(TT == 4, "the sweeps are written out for four tokens");
        const __amdgpu_buffer_rsrc_t rsD = __builtin_amdgcn_make_buffer_rsrc((void*)Ed8, 0, NEXP * 1024, 0x00020000), rsU = __builtin_amdgcn_make_buffer_rsrc((void*)Eu8, 0, NEXP * 1024, 0x00020000);
        const unsigned lane16 = (unsigned)lane * 16u;
        LAS float* G2 = (LAS float*)lds; LAS float* GF = G2 + DM;
        LAS unsigned* wl = (LAS unsigned*)(lds + 8192 + wave * 12288);
        LAS float* preS = (LAS float*)(wl + 256 + 4 * TT * 128);
        LAS unsigned* tk = wl;
        const int cohort = wave >> 2;
        const unsigned pace_n = (N_LAUNCHES == 1 && G == M / 128) ? MISC[8] * (NWAVES / 2) : 0u;
        unsigned* pace = (unsigned*)(ws + WS_XSYNC) + (bar.x & 15u) * 1024u + cohort * 512; unsigned pseq = 0;
#define TOPK_RANGE(RND, T0, T1) do { LAS unsigned* _pi0 = wl + 256; \
        _Pragma("unroll 1") for (int t = (T0); t < (T1); ++t) { LAS unsigned* pi = _pi0 + t * 128; LAS float* pg = (LAS float*)(_pi0 + TT * 128 + t * 128); \
            topk_token(SC + (size_t)(tok0 + t) * NQK, tk, pi, pg, lane); \
            const unsigned ia = pi[lane], ib = pi[64 + lane]; const float ga = pg[lane], gb = pg[64 + lane]; \
            unsigned posA = 0, posB = 0, base = 0; \
            _Pragma("unroll") for (int bd = 0; bd < 16; ++bd) { const bool inA = (ia >> 10) == (unsigned)bd, inB = (ib >> 10) == (unsigned)bd; \
                const unsigned long long ma = __ballot(inA), mb = __ballot(inB); \
                const unsigned ra = __builtin_amdgcn_mbcnt_hi((unsigned)(ma >> 32), __builtin_amdgcn_mbcnt_lo((unsigned)ma, 0u)), rb = __builtin_amdgcn_mbcnt_hi((unsigned)(mb >> 32), __builtin_amdgcn_mbcnt_lo((unsigned)mb, 0u)); \
                const unsigned ca = (unsigned)__builtin_popcountll(ma), cb = (unsigned)__builtin_popcountll(mb); \
                posA = inA ? base + ra : posA; posB = inB ? base + ca + rb : posB; base += ca + cb; } \
            __builtin_amdgcn_wave_barrier(); LDS_WAIT(); \
            pi[posA] = ia; pi[posB] = ib; pg[posA] = ga; pg[posB] = gb; \
            __builtin_amdgcn_wave_barrier(); LDS_WAIT(); } } while (0)
        for (int tile = wg; tile < M / 128; tile += G) {
            const int b = tile >> 6;
            __syncthreads();
            for (int c = tid; c < DM; c += NTHR) { G2[c] = mod[b * NMOD + 5 * DM + c]; GF[c] = g_final[c]; }
            __syncthreads();
            if (tid == 0) MISC[24] = 0u;
            __syncthreads();
#pragma unroll 1
            for (;;) {
                int rnd = 0; if (lane == 0) rnd = (int)__hip_atomic_fetch_add((LAS unsigned*)(MISC + 24), 1u, __ATOMIC_RELAXED, __HIP_MEMORY_SCOPE_WORKGROUP);
                rnd = __builtin_amdgcn_readfirstlane(rnd);
                if (rnd >= 128 / TT) break;
                const int tok0 = tile * 128 + rnd * TT;
                LAS unsigned* pe_idx = wl + 256; LAS float* pe_gate = (LAS float*)(pe_idx + TT * 128);
                TOPK_RANGE(0, 0, TT);
                unsigned idxA[TT], idxB[TT]; float gA[TT], gB[TT], preA[TT], preB[TT];
#pragma unroll
                for (int t = 0; t < TT; ++t) { idxA[t] = pe_idx[t * 128 + lane]; idxB[t] = pe_idx[t * 128 + 64 + lane]; gA[t] = pe_gate[t * 128 + lane]; gB[t] = pe_gate[t * 128 + 64 + lane];
                    preA[t] = 0.f; preB[t] = 0.f; }
                u32x4 hq[TT];
#pragma unroll
                for (int t = 0; t < TT; ++t) hq[t] = *(const u32x4*)(H2Q + (size_t)(tok0 + t) * DM + lane * 16);
                const int rsel = (lane & 7) * 8;
#define CVT8(u, hi) __builtin_amdgcn_cvt_scalef32_pk_f16_fp8((u), 1.0f, (hi))
#define ISSUE(BUF, IDX, L0, RS) do { _Pragma("unroll") for (int j = 0; j < 8; ++j) { const unsigned _e = (unsigned)__builtin_amdgcn_readlane((int)(IDX), (L0) + j); \
            BUF[j] = __builtin_amdgcn_raw_buffer_load_b128(RS, lane16, _e * 1024u, 0); } } while (0)
#define DOT16I(R, T, OUT) do { const u32x4 _r = (R); int _a = 0; _a = __builtin_amdgcn_sdot4((int)_r.x, (int)hq[T].x, _a, false); _a = __builtin_amdgcn_sdot4((int)_r.y, (int)hq[T].y, _a, false); \
        _a = __builtin_amdgcn_sdot4((int)_r.z, (int)hq[T].z, _a, false); _a = __builtin_amdgcn_sdot4((int)_r.w, (int)hq[T].w, _a, false); OUT = (float)_a; } while (0)
#define CONSUME_DOWN(BUF, T, PREA, PREB, CA, CB) do { float _p[8]; _Pragma("unroll") for (int j = 0; j < 8; ++j) DOT16I(BUF[j], T, _p[j]); \
        _Pragma("unroll") for (int j = 0; j < 4; ++j) { const auto _s = __builtin_amdgcn_permlane32_swap(as_u(_p[j]), as_u(_p[j + 4]), false, false); _p[j] = as_f(_s[0]) + as_f(_s[1]); } \
        _Pragma("unroll") for (int j = 0; j < 2; ++j) { const auto _s = __builtin_amdgcn_permlane16_swap(as_u(_p[j]), as_u(_p[j + 2]), false, false); _p[j] = as_f(_s[0]) + as_f(_s[1]); } \
        { const bool _up = (lane & 8) != 0; const float _keep = _up ? _p[1] : _p[0], _send = _up ? _p[0] : _p[1]; float _v = _keep + dppf<0x128>(_send); \
          _v += dppf<0xB1>(_v); _v += dppf<0x4E>(_v); _v += dppf<0x141>(_v); \
          const float _g = __shfl(_v, rsel); PREA = ((lane >> 3) == (CA)) ? _g : PREA; PREB = ((lane >> 3) == (CB)) ? _g : PREB; } } while (0)
#define FMIX(ACC, Q, CSV) do { asm("v_fma_mix_f32 %0, %1, %2, %0 op_sel_hi:[1,0,0]" : "+v"(ACC[0]) : "v"(Q), "s"(CSV)); asm("v_fma_mix_f32 %0, %1, %2, %0 op_sel:[1,0,0] op_sel_hi:[1,0,0]" : "+v"(ACC[1]) : "v"(Q), "s"(CSV)); } while (0)
#define UP_SLOT(R, T, CS) do { const u32x4 _r = (R); const float _cs = (CS); \
        { const f16x2 q0 = CVT8(_r.x, false), q1 = CVT8(_r.x, true), q2 = CVT8(_r.y, false), q3 = CVT8(_r.y, true); \
          FMIX((&acc[T][0]), q0, _cs); FMIX((&acc[T][2]), q1, _cs); FMIX((&acc[T][4]), q2, _cs); FMIX((&acc[T][6]), q3, _cs); } \
        { const f16x2 q4 = CVT8(_r.z, false), q5 = CVT8(_r.z, true), q6 = CVT8(_r.w, false), q7 = CVT8(_r.w, true); \
          FMIX((&acc[T][8]), q4, _cs); FMIX((&acc[T][10]), q5, _cs); FMIX((&acc[T][12]), q6, _cs); FMIX((&acc[T][14]), q7, _cs); } \
        __builtin_amdgcn_sched_barrier(0); } while (0)
#define CONSUME_UP(BUF, T, COEF, L0) do { _Pragma("unroll") for (int j = 0; j < 8; ++j) UP_SLOT(BUF[j], T, as_f((unsigned)__builtin_amdgcn_readlane((int)as_u(COEF), (L0) + j))); } while (0)
                u32x4 bufX[8], bufY[8];
#define SELI(T, C) ((C) < 8 ? idxA[T] : idxB[T])
#define SELC(T, C) ((C) < 8 ? coefA[T] : coefB[T])
#define L0OF(C) (8 * ((C) & 7))
#define CAOF(C) ((C) < 8 ? (C) : 99)
#define CBOF(C) ((C) < 8 ? 99 : (C) - 8)
                ISSUE(bufX, idxA[0], 0, rsD);
#pragma unroll 1
                for (int ch = 0; ch < 16; ++ch) { const int chn = ch < 15 ? ch + 1 : 15;
                    ISSUE(bufY, SELI(1, ch), L0OF(ch), rsD); CONSUME_DOWN(bufX, 0, preA[0], preB[0], CAOF(ch), CBOF(ch));
                    ISSUE(bufX, SELI(2, ch), L0OF(ch), rsD); CONSUME_DOWN(bufY, 1, preA[1], preB[1], CAOF(ch), CBOF(ch));
                    ISSUE(bufY, SELI(3, ch), L0OF(ch), rsD); CONSUME_DOWN(bufX, 2, preA[2], preB[2], CAOF(ch), CBOF(ch));
                    ISSUE(bufX, SELI(0, chn), L0OF(chn), rsD); CONSUME_DOWN(bufY, 3, preA[3], preB[3], CAOF(ch), CBOF(ch)); }
#pragma unroll
                for (int t = 0; t < TT; ++t) { const float hs = HSC[tok0 + t]; preA[t] *= hs; preB[t] *= hs; }
                float coefA[TT], coefB[TT];
#pragma unroll
                for (int t = 0; t < TT; ++t) { const float pa = preA[t] * EdS[idxA[t]], pb = preB[t] * EdS[idxB[t]];
                    coefA[t] = gA[t] * gelu_as(pa) * EuS[idxA[t]]; coefB[t] = gB[t] * gelu_as(pb) * EuS[idxB[t]]; }
                float acc[TT][16];
#pragma unroll
                for (int t = 0; t < TT; ++t)
#pragma unroll
                    for (int j = 0; j < 16; ++j) acc[t][j] = 0.f;
                ISSUE(bufX, idxA[0], 0, rsU);
#pragma unroll 1
                for (int ch = 0; ch < 16; ++ch) { const int chn = ch < 15 ? ch + 1 : 15;
                    ISSUE(bufY, SELI(1, ch), L0OF(ch), rsU); CONSUME_UP(bufX, 0, SELC(0, ch), L0OF(ch));
                    ISSUE(bufX, SELI(2, ch), L0OF(ch), rsU); CONSUME_UP(bufY, 1, SELC(1, ch), L0OF(ch));
                    ISSUE(bufY, SELI(3, ch), L0OF(ch), rsU); CONSUME_UP(bufX, 2, SELC(2, ch), L0OF(ch));
                    ISSUE(bufX, SELI(0, chn), L0OF(chn), rsU); CONSUME_UP(bufY, 3, SELC(3, ch), L0OF(ch)); }
#undef CBOF
#undef CAOF
#undef L0OF
#undef SELC
#undef SELI
#undef CONSUME_UP
#undef UP_SLOT
#undef FMIX
#undef CONSUME_DOWN
#undef DOT16I
#undef ISSUE
#undef CVT8
#pragma unroll
                for (int t = 0; t < TT; ++t) {
                    float* orow = out + (size_t)(tok0 + t) * DM;
                    f32x4 xv[4]; xv[0] = *(const f32x4*)(orow + lane * 8); xv[1] = *(const f32x4*)(orow + lane * 8 + 4); xv[2] = *(const f32x4*)(orow + 512 + lane * 8); xv[3] = *(const f32x4*)(orow + 512 + lane * 8 + 4);
                    float ss = 0.f;
#pragma unroll
                    for (int q = 0; q < 4; ++q) { const int cb = (q >> 1) * 512 + lane * 8 + (q & 1) * 4; const f32x4 g2 = *(const LAS f32x4*)(G2 + cb);
                        xv[q].x += g2.x * acc[t][4 * q + 0]; xv[q].y += g2.y * acc[t][4 * q + 1]; xv[q].z += g2.z * acc[t][4 * q + 2]; xv[q].w += g2.w * acc[t][4 * q + 3];
                        ss += (xv[q].x * xv[q].x + xv[q].y * xv[q].y) + (xv[q].z * xv[q].z + xv[q].w * xv[q].w); }
                    const float rstd = rsqrtf(wave_total(ss) * (1.f / DM) + EPS);
#pragma unroll
                    for (int q = 0; q < 4; ++q) { const int cb = (q >> 1) * 512 + lane * 8 + (q & 1) * 4; const f32x4 gf = *(const LAS f32x4*)(GF + cb);
                        *(f32x4*)(orow + cb) = xv[q] * rstd * gf; }
                    __builtin_amdgcn_sched_barrier(0);
                }
            }
        }
    }
#undef IN
#undef BOTH
#undef GRID_BAR
}


#if defined(DBG_CHECK)
constexpr size_t WS_FLAGS = 32 * 1024, WS_SNAP = 12 * MiB;
constexpr int NSAMP_TOK = 64;
__device__ __forceinline__ unsigned hash32(unsigned x) { x ^= x >> 16; x *= 0x7feb352du; x ^= x >> 15; x *= 0x846ca68bu; x ^= x >> 16; return x; }
__device__ __forceinline__ void chk(unsigned* flags, int id, float got, float ref, float atol, float rtol) { if (!(fabsf(got - ref) <= atol + rtol * fabsf(ref))) atomicAdd(&flags[id], 1u); }
__device__ __forceinline__ int samp_tok(int j) { return (j < 8) ? j * 4681 % M : (j < 16 ? ((j - 8) & 3) * 8192 + (j & 1) * 127 + (j >> 2 & 1) * 4000 : (int)(hash32(j * 977u + 5u) % M)); }
__global__ void dbg_check(Args args, int which) {
    unsigned char* ws = args.ws; unsigned* flags = (unsigned*)(ws + WS_FLAGS);
    const float* x = args.in[0]; const float* cvec = args.in[1]; const float* w_ada = args.in[2]; const float* b_ada = args.in[3];
    const float* g_norm1 = args.in[4]; const float* w_in = args.in[5]; const float* w_pool = args.in[6]; const float* pool_scale = args.in[7];
    const float* sgu_ln_g = args.in[8]; const float* sgu_ln_b = args.in[9]; const float* w_spatial = args.in[10]; const float* b_spatial = args.in[11];
    const float* w_out = args.in[12]; const float* g_norm2 = args.in[13]; const float* w_query = args.in[14]; const float* sub_keys = args.in[15];
    const float* expert_down = args.in[16]; const float* expert_up = args.in[17]; const float* g_final = args.in[18];
    const float* mod = (const float*)(ws + WS_MOD);
    const _Float16* H1 = (const _Float16*)(ws + WS_H1); const _Float16* PROJ = (const _Float16*)(ws + WS_PROJ); const _Float16* MIX = (const _Float16*)(ws + WS_MIX); const _Float16* H2 = (const _Float16*)(ws + WS_H2);
    const float* SC = (const float*)(ws + WS_SC); float* snap = (float*)(ws + WS_SNAP); const float* out = args.out;
    const unsigned gt = blockIdx.x * blockDim.x + threadIdx.x, NGT = gridDim.x * blockDim.x;
    if (which == 1) {
        for (unsigned i = gt; i < BATCH * NMOD; i += NGT) { const int b = i / NMOD, e = i % NMOD; float s = b_ada[e];
            for (int d = 0; d < DM; ++d) { const float c = cvec[b * DM + d]; s += (c / (1.f + expf(-c))) * w_ada[(size_t)d * NMOD + e]; }
            chk(flags, 1, mod[i], s, 1e-3f, 1e-3f); }
    } else if (which == 2) {
        for (unsigned i = gt; i < 4096 * 16; i += NGT) { const int row = hash32(i >> 4) % M, c0 = (i & 15) * 64, b = row >> 13; float ss = 0.f;
            for (int c = 0; c < DM; ++c) { const float v = x[(size_t)row * DM + c]; ss += v * v; }
            const float rstd = rsqrtf(ss / DM + EPS);
            for (int c = c0; c < c0 + 64; ++c) { const float ref = x[(size_t)row * DM + c] * rstd * g_norm1[c] * (1.f + mod[b * NMOD + DM + c]) + mod[b * NMOD + c];
                chk(flags, 2, (float)H1[(size_t)row * DM + c], ref, 4e-3f, 2e-3f); } }
    } else if (which == 3) {
        for (unsigned i = gt; i < 65536; i += NGT) { const unsigned h = hash32(i * 3u + 1u); const int row = h % M, col = (h >> 15) % NPROJ; float s = 0.f;
            for (int k = 0; k < DM; ++k) s += (float)H1[(size_t)row * DM + k] * w_in[(size_t)k * NPROJ + col];
            chk(flags, 3, (float)PROJ[(size_t)row * NPROJ + col], s, 1e-2f, 5e-3f); }
    } else if (which == 4) {
        for (unsigned i = gt; i < 32768; i += NGT) { const unsigned h = hash32(i * 5u + 2u); const int row = (i < 2048) ? ((i & 7) * 8192 % M + (i >> 3) % 32) : (int)(h % M), col = (h >> 15) % DM, pos = row & 8191; float ref;
            if (col < 512) { const int g = col >> 7, d = col & 127, w = 2 << g; const int cnt = (pos + 1 < w) ? pos + 1 : w; float acc = 0.f;
                for (int c = 0; c < 128; ++c) { float sm = 0.f; for (int j = 0; j < cnt; ++j) sm += (float)PROJ[(size_t)(row - j) * NPROJ + g * 128 + c];
                    acc += (sm / (float)cnt - (float)PROJ[(size_t)row * NPROJ + g * 128 + c]) * w_pool[(g * 128 + c) * 128 + d]; }
                ref = acc * pool_scale[col]; }
            else { const int cc = col - 512, hh = cc >> 7, t = row & 127, r0 = row - t; float acc = 0.f;
                for (int s2 = 0; s2 <= t; ++s2) { float mean = 0.f, var = 0.f; const _Float16* vr = PROJ + (size_t)(r0 + s2) * NPROJ + 1024;
                    for (int k = 0; k < 512; ++k) mean += (float)vr[k]; mean /= 512.f; for (int k = 0; k < 512; ++k) { const float dd = (float)vr[k] - mean; var += dd * dd; }
                    const float vn = ((float)vr[cc] - mean) * rsqrtf(var / 512.f + EPS) * sgu_ln_g[cc] + sgu_ln_b[cc]; acc += w_spatial[(hh * 128 + t) * 128 + s2] * vn; }
                ref = (float)PROJ[(size_t)row * NPROJ + 512 + cc] * (acc + b_spatial[hh * 128 + t]); }
            chk(flags, 4, (float)MIX[(size_t)row * DM + col], ref, 3e-2f, 1e-2f); }
    } else if (which == 5) {
        for (unsigned i = gt; i < 65536; i += NGT) { const unsigned h = hash32(i * 7u + 3u); const int row = h % M, col = (h >> 15) % DM, b = row >> 13; float s = 0.f;
            for (int k = 0; k < DM; ++k) s += (float)MIX[(size_t)row * DM + k] * w_out[(size_t)k * DM + col];
            chk(flags, 5, out[(size_t)row * DM + col], x[(size_t)row * DM + col] + mod[b * NMOD + 2 * DM + col] * s, 2e-2f, 5e-3f); }
    } else if (which == 6) {
        for (unsigned i = gt; i < 4096 * 16; i += NGT) { const int row = hash32((i >> 4) + 777u) % M, c0 = (i & 15) * 64, b = row >> 13; float ss = 0.f;
            for (int c = 0; c < DM; ++c) { const float v = out[(size_t)row * DM + c]; ss += v * v; }
            const float rstd = rsqrtf(ss / DM + EPS);
            for (int c = c0; c < c0 + 64; ++c) { const float ref = out[(size_t)row * DM + c] * rstd * g_norm2[c] * (1.f + mod[b * NMOD + 4 * DM + c]) + mod[b * NMOD + 3 * DM + c];
                chk(flags, 6, (float)H2[(size_t)row * DM + c], ref, 4e-3f, 2e-3f); } }
        for (unsigned i = gt; i < NSAMP_TOK * DM; i += NGT) snap[i] = out[(size_t)samp_tok(i / DM) * DM + (i % DM)];
    } else if (which == 8) {
        const _Float16* Ed = (const _Float16*)(ws + WS_ED); const _Float16* Eu = (const _Float16*)(ws + WS_EU);
        for (unsigned i = gt; i < 262144; i += NGT) { const size_t j = (size_t)(hash32(i * 13u + 6u) % (unsigned)(NEXP * DM));
            chk(flags, 8, (float)Ed[j], expert_down[j], 1e-5f, 1e-3f); chk(flags, 8, (float)Eu[j], expert_up[j], 1e-5f, 1e-3f); }
    } else if (which == 7) {
        for (unsigned i = gt; i < 16384; i += NGT) { const unsigned h = hash32(i * 11u + 4u); const int row = h % M, n = (h >> 15) % NQK, hp = n >> 7, k = n & 127; float s = 0.f;
            for (int d = 0; d < 128; ++d) { float q = 0.f; for (int kk = 0; kk < DM; ++kk) q += (float)H2[(size_t)row * DM + kk] * w_query[(size_t)kk * NQK + hp * 128 + d];
                s += q * sub_keys[(size_t)(hp * 128 + k) * 128 + d]; }
            chk(flags, 7, SC[(size_t)row * NQK + n], s, 2e-2f, 5e-3f); }
    }
}
__global__ void dbg_check_peer(Args args) {
    __shared__ float sc[2048]; __shared__ float stop[16][16]; __shared__ int itop[16][16]; __shared__ float cand[8][256]; __shared__ float gate[128]; __shared__ int eidx[128]; __shared__ float red[256];
    unsigned char* ws = args.ws; unsigned* flags = (unsigned*)(ws + WS_FLAGS);
    const float* expert_down = args.in[16]; const float* expert_up = args.in[17]; const float* g_final = args.in[18];
    const float* mod = (const float*)(ws + WS_MOD); const _Float16* H2 = (const _Float16*)(ws + WS_H2); const float* SC = (const float*)(ws + WS_SC); const float* snap = (const float*)(ws + WS_SNAP);
    const int j = blockIdx.x, tok = samp_tok(j), t = threadIdx.x, b = tok >> 13;
    for (int i = t; i < 2048; i += 256) sc[i] = SC[(size_t)tok * NQK + i];
    __syncthreads();
    if (t < 16) { for (int r = 0; r < 16; ++r) { int bi = 0; float bv = -3e38f; for (int k = 0; k < 128; ++k) { const float v = sc[t * 128 + k]; if (v > bv) { bv = v; bi = k; } } stop[t][r] = bv; itop[t][r] = bi; sc[t * 128 + bi] = -3e38f; } }
    __syncthreads();
    for (int i = t; i < 2048; i += 256) { const int h = i >> 8, a = (i >> 4) & 15, c = i & 15; cand[h][a * 16 + c] = stop[2 * h][a] + stop[2 * h + 1][c]; }
    __syncthreads();
    if (t < 8) { float bv[16]; float mx = -3e38f; for (int r = 0; r < 16; ++r) { int bi = 0; float v0 = -3e38f; for (int k = 0; k < 256; ++k) { const float v = cand[t][k]; if (v > v0) { v0 = v; bi = k; } }
            cand[t][bi] = -3e38f; gate[t * 16 + r] = v0; eidx[t * 16 + r] = itop[2 * t][bi >> 4] * 128 + itop[2 * t + 1][bi & 15]; mx = fmaxf(mx, v0); }
        float sm = 0.f; for (int r = 0; r < 16; ++r) { const float e = expf(gate[t * 16 + r] - mx); gate[t * 16 + r] = e; sm += e; } for (int r = 0; r < 16; ++r) gate[t * 16 + r] /= sm; }
    __syncthreads();
    const unsigned* DI = (const unsigned*)(ws + 400 * MiB); const float* DG = (const float*)(ws + 416 * MiB); const float* DC = (const float*)(ws + 432 * MiB);
    __shared__ int fidx[128]; __shared__ float fcoef[128];
    if (t < 128) { const int h = t >> 4; const unsigned fi = DI[(size_t)tok * 128 + t]; const float fg = DG[(size_t)tok * 128 + t]; int found = -1;
        for (int r = 0; r < 16; ++r) if (eidx[h * 16 + r] == (int)fi) found = r;
        if (found < 0 || fi >= (unsigned)NEXP) atomicAdd(&flags[10], 1u); else chk(flags, 11, fg, gate[h * 16 + found], 2e-3f, 1e-2f);
        const unsigned fic = fi < (unsigned)NEXP ? fi : 0u; fidx[t] = (int)fic;
        float s = 0.f; const float* ur = expert_down + (size_t)fic * DM; for (int d = 0; d < DM; ++d) s += ur[d] * (float)H2[(size_t)tok * DM + d];
        const float cref = fg * 0.5f * s * (1.f + erff(s * 0.70710678f)); const float fc = DC[(size_t)tok * 128 + t];
        chk(flags, 12, fc, cref, 2e-3f, 1e-2f); fcoef[t] = fc; }
    __syncthreads();
    float x2[4]; float ss = 0.f;
    for (int q = 0; q < 4; ++q) { const int c = t + 256 * q; float o = 0.f; for (int k = 0; k < 128; ++k) o += fcoef[k] * expert_up[(size_t)fidx[k] * DM + c];
        x2[q] = snap[(size_t)j * DM + c] + mod[b * NMOD + 5 * DM + c] * o; ss += x2[q] * x2[q]; }
    red[t] = ss; __syncthreads();
    for (int o = 128; o > 0; o >>= 1) { if (t < o) red[t] += red[t + o]; __syncthreads(); }
    const float rstd = rsqrtf(red[0] / DM + EPS);
    for (int q = 0; q < 4; ++q) { const int c = t + 256 * q; chk(flags, 13, args.out[(size_t)tok * DM + c], x2[q] * rstd * g_final[c], 2e-2f, 1e-2f); }
}
__global__ void dbg_report(Args args) {
    const unsigned* flags = (const unsigned*)(args.ws + WS_FLAGS); int id = 0;
    for (int k = 1; k < 16; ++k) if (flags[k] > ((k == 10 || k == 11) ? 40u : 0u) && !id) id = k;
    if (!id) return; float f = 1.f + 2.f * id; if (id >= 10) { const float fr = (float)flags[id] / 8192.f; f = 1.f + (float)id + 0.9f * (fr > 1.f ? 1.f : fr); }
    for (size_t i = (size_t)blockIdx.x * blockDim.x + threadIdx.x; i < (size_t)M * DM; i += (size_t)gridDim.x * blockDim.x) args.out[i] *= f;
}
#endif
extern "C" void kernel_launch(void* const* d_in, const int* in_sizes, int n_in, void* d_out, int out_size, void* d_ws, size_t ws_size, hipStream_t stream) {
    static int grid = 0;
    if (grid == 0) {
        if (n_in != 19 || out_size != M * DM || ws_size < WS_END) { fprintf(stderr, "kernel_launch: unexpected shapes (n_in %d out %d ws %zu)\n", n_in, out_size, ws_size); grid = -1; return; }
        int dev = 0, cus = 0, per_cu = 0;
        if (hipGetDevice(&dev) != hipSuccess || hipDeviceGetAttribute(&cus, hipDeviceAttributeMultiprocessorCount, dev) != hipSuccess) { grid = -1; return; }
        if (hipFuncSetAttribute((const void*)fwd_kernel, hipFuncAttributeMaxDynamicSharedMemorySize, LDS_BYTES) != hipSuccess) { fprintf(stderr, "kernel_launch: hipFuncSetAttribute failed\n"); grid = -1; return; }
        if (hipOccupancyMaxActiveBlocksPerMultiprocessor(&per_cu, (const void*)fwd_kernel, NTHR, LDS_BYTES) != hipSuccess || per_cu < 1) { fprintf(stderr, "kernel_launch: occupancy query says %d\n", per_cu); }
        (void)hipGetLastError();
        grid = cus;
    }
    if (grid < 0) return;
    (void)hipMemsetAsync((char*)d_ws + WS_CTL, 0, CTL_ZERO_BYTES, stream);
    Args a{};
    for (int i = 0; i < 19; ++i) a.in[i] = (const float*)d_in[i];
    a.out = (float*)d_out; a.ws = (unsigned char*)d_ws;
    if (N_LAUNCHES == 1) {
        a.ph_lo = 0; a.ph_hi = N_PHASES;
        void* kargs[] = {&a};
        hipError_t e = hipLaunchCooperativeKernel((const void*)fwd_kernel, dim3(grid), dim3(NTHR), kargs, LDS_BYTES, stream);
        if (e != hipSuccess) fprintf(stderr, "kernel_launch: cooperative launch failed: %s (grid %d)\n", hipGetErrorString(e), grid);
    } else {
        for (int p = 0; p < N_PHASES; ++p) { a.ph_lo = p; a.ph_hi = p + 1; hipLaunchKernelGGL(fwd_kernel, dim3(grid), dim3(NTHR), LDS_BYTES, stream, a);
#if defined(DBG_CHECK)
            if (p >= 1 && p <= 6) hipLaunchKernelGGL(dbg_check, dim3(1024), dim3(256), 0, stream, a, p);
            if (p == 0) hipLaunchKernelGGL(dbg_check, dim3(1024), dim3(256), 0, stream, a, 8);
            if (p == 6) hipLaunchKernelGGL(dbg_check, dim3(1024), dim3(256), 0, stream, a, 7);
            if (p == 7) { hipLaunchKernelGGL(dbg_check_peer, dim3(NSAMP_TOK), dim3(256), 0, stream, a); hipLaunchKernelGGL(dbg_report, dim3(1024), dim3(256), 0, stream, a); }
#endif
        }
    }
}
```
